# Optimizing an MI355X kernel written in HIP

```python
import math
import jax, jax.numpy as jnp
from jax import lax
import numpy as np

D_MODEL = 4096
BATCH = 2
SEQ = 8192
DEPTH = 4

N_A = DEPTH // 2
N_B = DEPTH - N_A
MAIN_WIDTH = 3 * D_MODEL // 4
LRU_BLOCK_W = 256
LRU_BLOCKS = MAIN_WIDTH // LRU_BLOCK_W
LRU_C = 8.0
CONV_W = 4
SB_HEAD_DIM = 128
SB_HEADS = MAIN_WIDTH // SB_HEAD_DIM
SB_BLOCK = 128
MEM_TOKENS = 256
MEM_HEADS = 4
MEM_HEAD_DIM = 256
MEM_WIDTH = MEM_HEADS * MEM_HEAD_DIM
IN_COLS = 2 * MAIN_WIDTH + 2 * MEM_WIDTH
MIX_WIDTH = MAIN_WIDTH + MEM_WIDTH
EPS = 1e-6

kernel_name = "yoco_rglru_stickbreaking_memory_trunk"


def rms_norm(x, g):
    xf = x.astype(jnp.float32)
    y = xf * lax.rsqrt(jnp.mean(xf * xf, axis=-1, keepdims=True) + EPS)
    return (y * g.astype(jnp.float32)).astype(x.dtype)


def causal_depthwise_conv(u, w, b):
    S = u.shape[1]
    up = jnp.pad(u, ((0, 0), (CONV_W - 1, 0), (0, 0)))
    out = b
    for k in range(CONV_W):
        out = out + up[:, k:k + S] * w[k]
    return out


def rg_lru(u, gate_a_w, gate_a_b, gate_x_w, gate_x_b, lam):
    B, S, W = u.shape
    ub = u.reshape(B, S, LRU_BLOCKS, LRU_BLOCK_W)
    r = jax.nn.sigmoid(jnp.einsum('bsni,nij->bsnj', ub, gate_a_w).reshape(B, S, W) + gate_a_b)
    i = jax.nn.sigmoid(jnp.einsum('bsni,nij->bsnj', ub, gate_x_w).reshape(B, S, W) + gate_x_b)
    log_a = -LRU_C * r.astype(jnp.float32) * jax.nn.softplus(-lam.astype(jnp.float32))
    a = jnp.exp(log_a)
    b = jnp.sqrt(-jnp.expm1(2.0 * log_a)) * (i * u).astype(jnp.float32)

    def combine(left, right):
        a1, b1 = left
        a2, b2 = right
        return a1 * a2, a2 * b1 + b2

    _, h = lax.associative_scan(combine, (a, b), axis=1)
    return h.astype(u.dtype)


def stick_breaking_attention(q, k, v):
    S = q.shape[1]
    scale = 1.0 / math.sqrt(q.shape[-1])
    outs = []
    for start in range(0, S, SB_BLOCK):
        end = start + SB_BLOCK
        qb = q[:, start:end]
        kb = k[:, :end]
        vb = v[:, :end]
        z = jnp.einsum('bqhd,bkhd->bhqk', qb, kb).astype(jnp.float32) * scale
        t_idx = start + jnp.arange(SB_BLOCK)[:, None]
        s_idx = jnp.arange(end)[None, :]
        causal = s_idx < t_idx
        log_beta = jax.nn.log_sigmoid(z)
        log_1m_beta = jnp.where(causal, log_beta - z, 0.0)
        tail = lax.cumsum(log_1m_beta, axis=3, reverse=True) - log_1m_beta
        w = jnp.where(causal, jnp.exp(log_beta + tail), 0.0)
        outs.append(jnp.einsum('bhqk,bkhd->bqhd', w.astype(vb.dtype), vb))
    return jnp.concatenate(outs, axis=1)


def memory_cross_attention(mq, mem_kv):
    B, S, _ = mq.shape
    M = mem_kv.shape[1]
    q = mq.reshape(B, S, MEM_HEADS, MEM_HEAD_DIM)
    mk, mv = jnp.split(mem_kv, 2, axis=-1)
    mk = mk.reshape(B, M, MEM_HEADS, MEM_HEAD_DIM)
    mv = mv.reshape(B, M, MEM_HEADS, MEM_HEAD_DIM)
    s = jnp.einsum('bshd,bmhd->bhsm', q, mk).astype(jnp.float32) / math.sqrt(MEM_HEAD_DIM)
    p = jax.nn.softmax(s, axis=-1).astype(mv.dtype)
    return jnp.einsum('bhsm,bmhd->bshd', p, mv).reshape(B, S, MEM_WIDTH)


def setup_inputs(seed: int = 0) -> dict:
    key = jax.random.key(seed)
    ks = jax.random.split(key, 20)
    f32 = jnp.float32
    x = jax.random.normal(ks[0], (BATCH, SEQ, D_MODEL), f32)
    mem = jax.random.normal(ks[1], (BATCH, MEM_TOKENS, D_MODEL), f32)
    pre_gain = 1.0 + 0.05 * jax.random.normal(ks[2], (DEPTH, D_MODEL), f32)
    post_gain = 1.0 + 0.05 * jax.random.normal(ks[3], (DEPTH, D_MODEL), f32)
    w_in = jax.random.normal(ks[4], (DEPTH, D_MODEL, IN_COLS), f32) * D_MODEL ** -0.5
    w_out = jax.random.normal(ks[5], (DEPTH, MIX_WIDTH, D_MODEL), f32) * MIX_WIDTH ** -0.5
    w_mem_kv = jax.random.normal(ks[6], (DEPTH, D_MODEL, 2 * MEM_WIDTH), f32) * D_MODEL ** -0.5
    mem_norm_gain = 1.0 + 0.05 * jax.random.normal(ks[7], (D_MODEL,), f32)
    conv_w = jax.random.normal(ks[8], (N_A, CONV_W, MAIN_WIDTH), f32) * CONV_W ** -0.5
    conv_b = 0.02 * jax.random.normal(ks[9], (N_A, MAIN_WIDTH), f32)
    gate_a_w = jax.random.normal(ks[10], (N_A, LRU_BLOCKS, LRU_BLOCK_W, LRU_BLOCK_W), f32) * LRU_BLOCK_W ** -0.5
    gate_a_b = 0.02 * jax.random.normal(ks[11], (N_A, MAIN_WIDTH), f32)
    gate_x_w = jax.random.normal(ks[12], (N_A, LRU_BLOCKS, LRU_BLOCK_W, LRU_BLOCK_W), f32) * LRU_BLOCK_W ** -0.5
    gate_x_b = 0.02 * jax.random.normal(ks[13], (N_A, MAIN_WIDTH), f32)
    a_c = jax.random.uniform(ks[14], (N_A, MAIN_WIDTH), f32, 0.9, 0.999)
    base = a_c ** (1.0 / LRU_C)
    lru_lambda = jnp.log(base) - jnp.log1p(-base)
    kv_norm_gain = 1.0 + 0.05 * jax.random.normal(ks[15], (D_MODEL,), f32)
    w_kv = jax.random.normal(ks[16], (D_MODEL, 2 * MAIN_WIDTH), f32) * D_MODEL ** -0.5
    return {"x": x, "mem": mem, "pre_gain": pre_gain, "post_gain": post_gain,
            "w_in": w_in, "w_out": w_out, "w_mem_kv": w_mem_kv, "mem_norm_gain": mem_norm_gain,
            "conv_w": conv_w, "conv_b": conv_b, "gate_a_w": gate_a_w, "gate_a_b": gate_a_b,
            "gate_x_w": gate_x_w, "gate_x_b": gate_x_b, "lru_lambda": lru_lambda,
            "kv_norm_gain": kv_norm_gain, "w_kv": w_kv}


def reference(x, mem, pre_gain, post_gain, w_in, w_out, w_mem_kv, mem_norm_gain,
              conv_w, conv_b, gate_a_w, gate_a_b, gate_x_w, gate_x_b, lru_lambda,
              kv_norm_gain, w_kv):
    B, S, _ = x.shape
    mem_n = rms_norm(mem, mem_norm_gain)
    h = x
    k_shared = None
    v_shared = None
    for layer in range(DEPTH):
        y = rms_norm(h, pre_gain[layer])
        proj = y @ w_in[layer]
        br = proj[..., :MAIN_WIDTH]
        br_gate = proj[..., MAIN_WIDTH:2 * MAIN_WIDTH]
        mq = proj[..., 2 * MAIN_WIDTH:2 * MAIN_WIDTH + MEM_WIDTH]
        m_gate = proj[..., 2 * MAIN_WIDTH + MEM_WIDTH:]
        if layer < N_A:
            u = causal_depthwise_conv(br, conv_w[layer], conv_b[layer])
            br_out = rg_lru(u, gate_a_w[layer], gate_a_b[layer], gate_x_w[layer],
                            gate_x_b[layer], lru_lambda[layer])
        else:
            q = br.reshape(B, S, SB_HEADS, SB_HEAD_DIM)
            br_out = stick_breaking_attention(q, k_shared, v_shared).reshape(B, S, MAIN_WIDTH)
        m_out = memory_cross_attention(mq, mem_n @ w_mem_kv[layer])
        mix = jnp.concatenate([br_out * jax.nn.silu(br_gate), m_out * jax.nn.silu(m_gate)], axis=-1)
        h = h + rms_norm(mix @ w_out[layer], post_gain[layer])
        if layer == N_A - 1:
            kv = rms_norm(h, kv_norm_gain) @ w_kv
            k_shared = kv[..., :MAIN_WIDTH].reshape(B, S, SB_HEADS, SB_HEAD_DIM)
            v_shared = kv[..., MAIN_WIDTH:].reshape(B, S, SB_HEADS, SB_HEAD_DIM)
    return h
```

```cpp
#include <hip/hip_runtime.h>
#include <cstdio>
#include <cstdint>
namespace pg8 {
#define PG8_LAS __attribute__((address_space(3)))
typedef unsigned short bf16_t;
typedef short bf16x8 __attribute__((ext_vector_type(8)));
typedef float f32x4 __attribute__((ext_vector_type(4)));
typedef unsigned u32x4 __attribute__((ext_vector_type(4)));
constexpr int BM = 256, BK = 64, HALF = 128, HTB = HALF * BK * 2  , STAGE_BYTES = 8 * HTB, NXCD = 8, WGM = 8;

__host__ __device__ __forceinline__ int lds_byte(int r, int c) { const int st = (r >> 4) * 2 + (c >> 5), rr = r & 15, cc = c & 31, ob = rr * 64 + cc * 2; return st * 1024 + (ob ^ (((ob >> 9) & 1) << 5)); }
__host__ __device__ __forceinline__ void stage_rc(int b, int& R, int& C) { const int st = b / 1024, sb = b % 1024, swz = sb ^ (((sb >> 9) & 1) << 5); R = (st >> 1) * 16 + swz / 64; C = (st & 1) * 32 + (swz % 64) / 2; }
__host__ __device__ __forceinline__ int perm32(int rho) { const int n = rho >> 4, i = rho & 15; return 8 * (i >> 2) + 4 * n + (i & 3); }

struct Unit { int pm, pn; };
struct Gemm { const bf16_t* A; const bf16_t* Bt; int M, N, K; };

struct StaticOrder {
    int nM, nN, nwg, G, c;
    __host__ __device__ void init(int M, int N, int G_, int c_) { nM = M / BM; nN = N / BM; nwg = nM * nN; G = G_; c = c_; }
    __host__ __device__ bool next(int i, Unit& u) const {
        const long L = (long)i * G + c; if (L >= nwg) return false;
        int wgid = (int)L; { const int q = nwg / NXCD, r = nwg % NXCD, xcd = wgid % NXCD, off = wgid / NXCD; wgid = (xcd < r ? xcd * (q + 1) : r * (q + 1) + (xcd - r) * q) + off; }
        const int nig = WGM * nN, gid = wgid / nig, fm = gid * WGM, gsz = (nM - fm) < WGM ? (nM - fm) : WGM;
        u.pm = fm + ((wgid % nig) % gsz); u.pn = (wgid % nig) / gsz; return true;
    }
    __device__ __forceinline__ void a_ready(const Unit&) const {}
    __device__ __forceinline__ void done(const Unit&) const {}
};

__device__ __forceinline__ unsigned cvt_pk_bf16(float lo, float hi) { unsigned r; asm volatile("v_cvt_pk_bf16_f32 %0, %1, %2" : "=v"(r) : "v"(lo), "v"(hi)); return r; }

struct EpiBf16 {
    static constexpr bool PERM = true, AFTER_DRAIN = false;
    bf16_t* O; int ldc; int split_col; bf16_t* O2; int ldc2;
    __device__ __forceinline__ void operator()(const f32x4 (&acc)[2][2][4][2], const Unit& u, int wr, int wc, int fr, int fq) const {
        const int row0 = u.pm * BM + wr * 64 + fr; int colt = u.pn * BM; bf16_t* base = O; int ld = ldc;
        if (colt >= split_col) { base = O2; ld = ldc2; colt -= split_col; }
        const int col0 = colt + wc * 32 + 8 * fq;
#pragma unroll
        for (int ai = 0; ai < 2; ++ai)
#pragma unroll
            for (int m = 0; m < 4; ++m) { bf16_t* rowp = base + (size_t)(row0 + ai * HALF + m * 16) * ld + col0;
#pragma unroll
                for (int bj = 0; bj < 2; ++bj) { const f32x4 v0 = acc[ai][bj][m][0], v1 = acc[ai][bj][m][1];
                    u32x4 w; w.x = cvt_pk_bf16(v0[0], v0[1]); w.y = cvt_pk_bf16(v0[2], v0[3]); w.z = cvt_pk_bf16(v1[0], v1[1]); w.w = cvt_pk_bf16(v1[2], v1[3]);
                    *(u32x4*)(rowp + bj * HALF) = w; } }
    }
};
struct EpiBf16SS {
    static constexpr bool PERM = true, AFTER_DRAIN = false;
    bf16_t* O; int ldc; float* part;
    __device__ __forceinline__ void operator()(const f32x4 (&acc)[2][2][4][2], const Unit& u, int wr, int wc, int fr, int fq) const {
        const int row0 = u.pm * BM + wr * 64 + fr; const int col0 = u.pn * BM + wc * 32 + 8 * fq;
#pragma unroll
        for (int ai = 0; ai < 2; ++ai)
#pragma unroll
            for (int m = 0; m < 4; ++m) { const int row = row0 + ai * HALF + m * 16; bf16_t* rowp = O + (size_t)row * ldc + col0; float ss = 0.f;
#pragma unroll
                for (int bj = 0; bj < 2; ++bj) { const f32x4 v0 = acc[ai][bj][m][0], v1 = acc[ai][bj][m][1];
                    ss += (v0[0] * v0[0] + v0[1] * v0[1]) + (v0[2] * v0[2] + v0[3] * v0[3]) + (v1[0] * v1[0] + v1[1] * v1[1]) + (v1[2] * v1[2] + v1[3] * v1[3]);
                    u32x4 w; w.x = cvt_pk_bf16(v0[0], v0[1]); w.y = cvt_pk_bf16(v0[2], v0[3]); w.z = cvt_pk_bf16(v1[0], v1[1]); w.w = cvt_pk_bf16(v1[2], v1[3]);
                    *(u32x4*)(rowp + bj * HALF) = w; }
                ss += __shfl_xor(ss, 16); ss += __shfl_xor(ss, 32);
                if (fq == 0) part[(size_t)row * 64 + u.pn * 4 + wc] = ss; }
    }
};

template <class Epi, class Sched, bool ALIGN_EPI = false, bool SP2 = false>
__device__ __forceinline__ void gemm_phase(PG8_LAS unsigned char* lds, const Gemm g, const Sched& S, const Epi& E) {
    int tid_l = threadIdx.x; asm volatile("" : "+v"(tid_l));
    const int tid = tid_l, wid = __builtin_amdgcn_readfirstlane(tid >> 6), lane = tid & 63, wr = wid >> 2, wc = wid & 3, fr = lane & 15, fq = lane >> 4;
    const int K = g.K, nt = K / BK;
    unsigned voffA[2], voffB[2];
#pragma unroll
    for (int i = 0; i < 2; ++i) { int R, C; stage_rc(tid * 16 + i * 8192, R, C); const int Rb = Epi::PERM ? ((R & ~31) + perm32(R & 31)) : R;
        voffA[i] = (unsigned)(R * K + C) * 2u; voffB[i] = (unsigned)(Rb * K + C) * 2u; }
    const size_t kstep = (size_t)(BK * 2);
    const size_t hstep = (size_t)HALF * K * 2;
    const size_t tstep = 2 * hstep;
    const unsigned ldsw = (unsigned)wid * 1024u;
    const int aoff = lds_byte(wr * 64 + fr, fq * 8), boff = lds_byte(wc * 32 + fr, fq * 8);
#define PG8_SA(b, h) (((b) * 2 + (h)) * HTB)
#define PG8_SB(b, h) ((4 + (b) * 2 + (h)) * HTB)
#define PG8_STAGE(bufoff, gbase, voff) do { _Pragma("unroll") for (int _i = 0; _i < 2; ++_i) \
        __builtin_amdgcn_global_load_lds((const unsigned*)((const char*)(gbase) + (voff)[_i]), (PG8_LAS unsigned*)(lds + (bufoff) + ldsw + _i * 8192), 16, 0, 0); } while (0)
#define PG8_LDA(dst, b, h) do { _Pragma("unroll") for (int m = 0; m < 4; ++m) _Pragma("unroll") for (int k = 0; k < 2; ++k) dst[m][k] = *(const PG8_LAS bf16x8*)(lds + PG8_SA(b, h) + aoff + m * 2048 + k * 1024); } while (0)
#define PG8_LDB(dst, b, h) do { _Pragma("unroll") for (int n = 0; n < 2; ++n) _Pragma("unroll") for (int k = 0; k < 2; ++k) dst[n][k] = *(const PG8_LAS bf16x8*)(lds + PG8_SB(b, h) + boff + n * 2048 + k * 1024); } while (0)
#define PG8_MMA(ai, bj, At, Bt) do { __builtin_amdgcn_s_setprio(1); _Pragma("unroll") for (int m = 0; m < 4; ++m) _Pragma("unroll") for (int n = 0; n < 2; ++n) _Pragma("unroll") for (int k = 0; k < 2; ++k) \
        acc[ai][bj][m][n] = __builtin_amdgcn_mfma_f32_16x16x32_bf16(Bt[n][k], At[m][k], acc[ai][bj][m][n], 0, 0, 0); __builtin_amdgcn_s_setprio(0); } while (0)
#define PG8_WAIT_V(n) asm volatile("s_waitcnt vmcnt(" #n ")" ::: "memory")
#define PG8_WAIT_L(n) asm volatile("s_waitcnt lgkmcnt(" #n ")" ::: "memory")
#define PG8_BAR __builtin_amdgcn_s_barrier()
#define PG8_SCHED __builtin_amdgcn_sched_barrier(0)
    Unit cur, nxt; int ui = 0;
    if (!S.next(0, cur)) return;
    f32x4 acc[2][2][4][2];
#pragma unroll
    for (int a = 0; a < 2; ++a)
#pragma unroll
        for (int b = 0; b < 2; ++b)
#pragma unroll
            for (int m = 0; m < 4; ++m)
#pragma unroll
                for (int n = 0; n < 2; ++n) acc[a][b][m][n] = (f32x4){0.f, 0.f, 0.f, 0.f};
    bf16x8 At[4][2], B0[2][2], B1[2][2];
    const char* cA = (const char*)g.A + (size_t)cur.pm * tstep; const char* cB = (const char*)g.Bt + (size_t)cur.pn * tstep;
    S.a_ready(cur);
    if constexpr (SP2) {
        PG8_STAGE(PG8_SB(0, 0), cB, voffB); PG8_STAGE(PG8_SB(0, 1), cB + hstep, voffB); PG8_STAGE(PG8_SA(0, 0), cA, voffA); PG8_STAGE(PG8_SA(0, 1), cA + hstep, voffA);
        if (wr == 1) PG8_BAR;
        PG8_WAIT_V(2); PG8_BAR;
        PG8_STAGE(PG8_SB(1, 0), cB + kstep, voffB); PG8_STAGE(PG8_SA(1, 0), cA + kstep, voffA); PG8_STAGE(PG8_SB(1, 1), cB + hstep + kstep, voffB);
        PG8_WAIT_V(6); PG8_BAR;
    } else {
        PG8_STAGE(PG8_SB(0, 0), cB, voffB); PG8_STAGE(PG8_SA(0, 0), cA, voffA); PG8_STAGE(PG8_SB(0, 1), cB + hstep, voffB); PG8_STAGE(PG8_SA(0, 1), cA + hstep, voffA);
        if (wr == 1) PG8_BAR;
        PG8_WAIT_V(4); PG8_BAR;
        PG8_STAGE(PG8_SB(1, 0), cB + kstep, voffB); PG8_STAGE(PG8_SA(1, 0), cA + kstep, voffA); PG8_STAGE(PG8_SB(1, 1), cB + hstep + kstep, voffB);
        PG8_WAIT_V(6); PG8_BAR;
    }
    for (;;) {
        const bool has_next = S.next(ui + 1, nxt);
        const char* nA = has_next ? (const char*)g.A + (size_t)nxt.pm * tstep : cA; const char* nB = has_next ? (const char*)g.Bt + (size_t)nxt.pn * tstep : cB;
        for (int t = 0; t < nt; t += 2) {
            const bool last = (t == nt - 2);
            const char* a1 = cA + (size_t)(t + 1) * kstep;
            const char* a2 = last ? nA : cA + (size_t)(t + 2) * kstep; const char* b2 = last ? nB : cB + (size_t)(t + 2) * kstep;
            const char* a3 = a2 + kstep; const char* b3 = b2 + kstep;
            if (last && has_next) S.a_ready(nxt);
            if constexpr (SP2) {
            PG8_LDB(B0, 0, 0); PG8_LDB(B1, 0, 1); PG8_SCHED; PG8_LDA(At, 0, 0); PG8_STAGE(PG8_SA(1, 1), a1 + hstep, voffA);
            PG8_WAIT_V(8); PG8_WAIT_L(0); PG8_BAR; PG8_MMA(0, 0, At, B0); PG8_MMA(0, 1, At, B1); PG8_BAR; PG8_SCHED;
            PG8_LDA(At, 0, 1); PG8_STAGE(PG8_SB(0, 0), b2, voffB); PG8_STAGE(PG8_SB(0, 1), b2 + hstep, voffB); PG8_STAGE(PG8_SA(0, 0), a2, voffA);
            PG8_WAIT_V(8); PG8_WAIT_L(0); PG8_BAR; PG8_MMA(1, 0, At, B0); PG8_MMA(1, 1, At, B1); PG8_BAR; PG8_SCHED;
            PG8_LDB(B0, 1, 0); PG8_LDB(B1, 1, 1); PG8_SCHED; PG8_LDA(At, 1, 0); PG8_STAGE(PG8_SA(0, 1), a2 + hstep, voffA);
            PG8_WAIT_V(8); PG8_WAIT_L(0); PG8_BAR; PG8_MMA(0, 0, At, B0); PG8_MMA(0, 1, At, B1); PG8_BAR; PG8_SCHED;
            PG8_LDA(At, 1, 1); PG8_STAGE(PG8_SB(1, 0), b3, voffB); PG8_STAGE(PG8_SB(1, 1), b3 + hstep, voffB); PG8_STAGE(PG8_SA(1, 0), a3, voffA);
            PG8_WAIT_V(8); PG8_WAIT_L(0); PG8_BAR; PG8_MMA(1, 0, At, B0); PG8_MMA(1, 1, At, B1); PG8_BAR; PG8_SCHED;
            } else {
            PG8_LDB(B0, 0, 0); PG8_SCHED; PG8_LDA(At, 0, 0); PG8_STAGE(PG8_SA(1, 1), a1 + hstep, voffA);
            PG8_WAIT_L(8); PG8_BAR; PG8_WAIT_L(0); PG8_MMA(0, 0, At, B0); PG8_BAR; PG8_SCHED;
            PG8_LDB(B1, 0, 1); PG8_STAGE(PG8_SB(0, 0), b2, voffB);
            PG8_BAR; PG8_WAIT_L(0); PG8_MMA(0, 1, At, B1); PG8_BAR;
            PG8_LDA(At, 0, 1); PG8_STAGE(PG8_SA(0, 0), a2, voffA);
            PG8_BAR; PG8_WAIT_L(0); PG8_MMA(1, 0, At, B0); PG8_BAR; PG8_SCHED;
            PG8_STAGE(PG8_SB(0, 1), b2 + hstep, voffB);
            PG8_WAIT_V(6); PG8_BAR; PG8_MMA(1, 1, At, B1); PG8_BAR;
            PG8_LDB(B0, 1, 0); PG8_SCHED; PG8_LDA(At, 1, 0); PG8_STAGE(PG8_SA(0, 1), a2 + hstep, voffA);
            PG8_WAIT_L(8); PG8_BAR; PG8_WAIT_L(0); PG8_MMA(0, 0, At, B0); PG8_BAR; PG8_SCHED;
            PG8_LDB(B1, 1, 1); PG8_STAGE(PG8_SB(1, 0), b3, voffB);
            PG8_BAR; PG8_WAIT_L(0); PG8_MMA(0, 1, At, B1); PG8_BAR;
            PG8_LDA(At, 1, 1); PG8_STAGE(PG8_SA(1, 0), a3, voffA);
            PG8_BAR; PG8_WAIT_L(0); PG8_MMA(1, 0, At, B0); PG8_BAR; PG8_SCHED;
            PG8_STAGE(PG8_SB(1, 1), b3 + hstep, voffB);
            PG8_WAIT_V(6); PG8_BAR; PG8_MMA(1, 1, At, B1); PG8_BAR;
            }
        }
        if constexpr (ALIGN_EPI) { if (wr == 0) PG8_BAR; }
        if constexpr (!Epi::AFTER_DRAIN) { E(acc, cur, wr, wc, fr, fq); S.done(cur); }
        if (!has_next) break;
#pragma unroll
        for (int a = 0; a < 2; ++a)
#pragma unroll
            for (int b = 0; b < 2; ++b)
#pragma unroll
                for (int m = 0; m < 4; ++m)
#pragma unroll
                    for (int n = 0; n < 2; ++n) acc[a][b][m][n] = (f32x4){0.f, 0.f, 0.f, 0.f};
        cur = nxt; cA = nA; cB = nB; ++ui;
        if constexpr (ALIGN_EPI) { if (wr == 1) PG8_BAR; }
    }
    PG8_WAIT_V(0);
    if constexpr (!ALIGN_EPI) { if (wr == 0) PG8_BAR; }
    PG8_BAR;
    if constexpr (Epi::AFTER_DRAIN) { E.fused(acc, cur, wr, wc, fr, fq, lds, wid, lane); S.done(cur); }
#undef PG8_SA
#undef PG8_SB
#undef PG8_STAGE
#undef PG8_LDA
#undef PG8_LDB
#undef PG8_MMA
#undef PG8_WAIT_V
#undef PG8_WAIT_L
#undef PG8_BAR
#undef PG8_SCHED
}
}
constexpr int BATCH = 2, SEQ = 8192, DM = 4096, M = BATCH * SEQ, DEPTH = 4, N_A = 2;
constexpr int MAINW = 3072, MEMW = 1024, INC = 8192, MIXW = 4096, KVW = 6144;
constexpr int LRU_NB = 12, SB_H = 24, MEM_T = 256, MEM_H = 4;
constexpr float EPS = 1e-6f;
constexpr int NWAVES = 8;
constexpr int LRU_T = 128, LRU_NC = SEQ / LRU_T;

constexpr size_t MiB = 1u << 20;
constexpr size_t WS_CTL = 0, CTL_ZERO_BYTES = 64 * 1024;
constexpr size_t WS_WIN0 = 16 * MiB, WS_WKV = 272 * MiB;
constexpr size_t WS_WOUT = 320 * MiB;
constexpr size_t WS_WMK = 448 * MiB, WS_WMV = 480 * MiB;
constexpr size_t WS_WG = 512 * MiB;
constexpr size_t WS_HB = 520 * MiB;
constexpr size_t WS_MEMB = 648 * MiB;
constexpr size_t WS_MEMK = 652 * MiB;
constexpr size_t WS_MEMVT = 656 * MiB;
constexpr size_t WS_PROJ = 660 * MiB;
constexpr size_t WS_KB = 916 * MiB;
constexpr size_t WS_VT = 1012 * MiB;
constexpr size_t WS_MIX = 1108 * MiB;
constexpr size_t WS_OB = 1236 * MiB;
constexpr size_t WS_PART = 1364 * MiB;
constexpr size_t WS_AGG = 1368 * MiB;
constexpr size_t WS_END = 1372 * MiB;
constexpr int CW_BAR = 4096;

constexpr int RING_OFF = 0, RING_BYTES = 131072;
constexpr int LDSCTL_OFF = RING_BYTES, MISC_OFF = LDSCTL_OFF + 320;
constexpr int LDS_BYTES = 147456;
constexpr int UT_PITCH = 264;

#define GAS __attribute__((address_space(1)))
#define LAS __attribute__((address_space(3)))
typedef unsigned short bf16;
typedef unsigned v4u __attribute__((ext_vector_type(4)));
typedef unsigned v2u __attribute__((ext_vector_type(2)));
typedef float f32x4 __attribute__((ext_vector_type(4)));
typedef short bf16x8 __attribute__((ext_vector_type(8)));
typedef short bf16x4 __attribute__((ext_vector_type(4)));
typedef float f32x2 __attribute__((ext_vector_type(2)));
typedef GAS unsigned gu32;
#define LDS_WAIT() asm volatile("s_waitcnt lgkmcnt(0)" ::: "memory")
#define VM_WAIT() asm volatile("s_waitcnt vmcnt(0)" ::: "memory")
#define MFMA16(a, b, c) __builtin_amdgcn_mfma_f32_16x16x32_bf16((a), (b), (c), 0, 0, 0)
__device__ __forceinline__ unsigned f2bf(float f) { unsigned u = __builtin_bit_cast(unsigned, f); return (u + 0x7fffu + ((u >> 16) & 1u)) >> 16; }
__device__ __forceinline__ unsigned pk2(float lo, float hi) { return f2bf(lo) | (f2bf(hi) << 16); }
__device__ __forceinline__ float bf2f(unsigned short h) { return __builtin_bit_cast(float, (unsigned)h << 16); }
__device__ __forceinline__ float bflo(unsigned w) { return __builtin_bit_cast(float, w << 16); }
__device__ __forceinline__ float bfhi(unsigned w) { return __builtin_bit_cast(float, w & 0xffff0000u); }
__device__ __forceinline__ float wave_sum(float v) {
#pragma unroll
    for (int o = 1; o < 64; o <<= 1) v += __shfl_xor(v, o);
    return v;
}
__device__ __forceinline__ float fast_exp(float x) { return __builtin_amdgcn_exp2f(x * 1.44269504089f); }
__device__ __forceinline__ float fast_sigmoid(float x) { return __builtin_amdgcn_rcpf(1.0f + fast_exp(-x)); }
__device__ __forceinline__ float silu_f(float x) { return x * fast_sigmoid(x); }
__device__ __forceinline__ float softplus_f(float z) { return fmaxf(z, 0.f) + __builtin_amdgcn_logf(1.0f + fast_exp(-fabsf(z))) * 0.69314718056f; }

#define XB_TMO      128
#define XB_XCNT(j)  (256  + 64 * (j))
#define XB_XSUB(j)  (1280 + 64 * (j))
#define XB_XGEN(j)  (2304 + 64 * (j))
#define XB_TOP      3328
#define XB_TOPGEN   3392
#define XCD_BAR_WORDS 3456
#define XB_SPIN_CAP (1u << 18)
__device__ __forceinline__ unsigned xb_ld(unsigned* p)              { return __hip_atomic_load(p, __ATOMIC_RELAXED, __HIP_MEMORY_SCOPE_AGENT); }
__device__ __forceinline__ unsigned xb_add(unsigned* p, unsigned v) { return __hip_atomic_fetch_add(p, v, __ATOMIC_RELAXED, __HIP_MEMORY_SCOPE_AGENT); }
__device__ __forceinline__ unsigned xb_xcc_id() { return (unsigned)__builtin_amdgcn_s_getreg((3 << 11) | 20) & 0xFu; }
#define XB_SPIN(cond, bar) do { unsigned _sp = 0; while (cond) { __builtin_amdgcn_s_sleep(1); \
    if ((++_sp & 255u) == 0u) { if (xb_ld(&(bar)[XB_TMO])) break; if (_sp > XB_SPIN_CAP) { atomicAdd(&(bar)[XB_TMO], 1u); break; } } } } while (0)
struct XcdBarrier { unsigned* bar; unsigned x; volatile LAS unsigned* st; };
__device__ __forceinline__ XcdBarrier xcd_barrier_post(unsigned* bar, volatile LAS unsigned* st) {
    XcdBarrier b; b.bar = bar; b.x = xb_xcc_id(); b.st = st;
    if (threadIdx.x == 0) (void)xb_add(&bar[XB_XCNT(b.x)], 1u);
    return b;
}
__device__ __forceinline__ void xcd_barrier_complete(unsigned* bar, unsigned x, unsigned& nloc, unsigned& nx) {
    const unsigned G = gridDim.x * gridDim.y * gridDim.z;
    unsigned sum, cnt, mine, sp = 0u;
    for (;;) {
        sum = 0u; cnt = 0u; mine = 0u;
#pragma unroll
        for (unsigned j = 0; j < 16; ++j) { const unsigned c = xb_ld(&bar[XB_XCNT(j)]); sum += c; cnt += (c > 0u) ? 1u : 0u; mine = (j == x) ? c : mine; }
        if (sum == G) break;
        __builtin_amdgcn_s_sleep(1);
        if ((++sp & 255u) == 0u) { if (xb_ld(&bar[XB_TMO])) break; if (sp > XB_SPIN_CAP) { atomicAdd(&bar[XB_TMO], 1u); break; } }
    }
    nloc = mine > 0u ? mine : 1u; nx = cnt > 0u ? cnt : 1u;
}
__device__ __forceinline__ void xcd_barrier(const XcdBarrier& b) {
    asm volatile("s_waitcnt vmcnt(0)" ::: "memory");
    __syncthreads();
    if (threadIdx.x == 0) {
        unsigned* bar = b.bar;
        __builtin_amdgcn_s_waitcnt(0);
        unsigned nloc = b.st[0], nx = b.st[1];
        if (nloc == 0u) { xcd_barrier_complete(bar, b.x, nloc, nx); b.st[0] = nloc; b.st[1] = nx; }
        const unsigned old = xb_add(&bar[XB_XSUB(b.x)], 1u);
        const unsigned gen = old / nloc;
        if (old + 1u == (gen + 1u) * nloc) {
            __builtin_amdgcn_fence(__ATOMIC_RELEASE, "agent");
            asm volatile("s_waitcnt vmcnt(0)" ::: "memory");
            const unsigned og = xb_add(&bar[XB_TOP], 1u);
            const unsigned tg = og / nx;
            if (og + 1u == (tg + 1u) * nx) xb_add(&bar[XB_TOPGEN], 1u);
            else XB_SPIN(xb_ld(&bar[XB_TOPGEN]) == tg, bar);
            __builtin_amdgcn_fence(__ATOMIC_ACQUIRE, "agent");
            xb_add(&bar[XB_XGEN(b.x)], 1u);
            asm volatile("s_waitcnt vmcnt(0)" ::: "memory");
        } else {
            XB_SPIN(xb_ld(&bar[XB_XGEN(b.x)]) == gen, bar);
            __builtin_amdgcn_fence(__ATOMIC_ACQUIRE, "agent");
            asm volatile("s_waitcnt vmcnt(0)" ::: "memory");
        }
    }
    __syncthreads();
}

struct Frame {
    LAS unsigned char* lds;
    int tid, lane, wave, vcu, G;
    float* out;
    unsigned char* ws;
};
#define LAUNDER_S(p) asm volatile("" : "+s"(p))
enum { I_X = 0, I_MEM, I_PRE_GAIN, I_POST_GAIN, I_W_IN, I_W_OUT, I_W_MEM_KV, I_MEM_GAIN, I_CONV_W, I_CONV_B, I_GATE_A_W, I_GATE_A_B, I_GATE_X_W, I_GATE_X_B, I_LAM, I_KV_GAIN, I_W_KV, I_NIN };
constexpr int PTR_OFF = LDSCTL_OFF + 512;
__device__ __forceinline__ const float* inp(const Frame& F, int i) {
    const unsigned long long v = ((const LAS unsigned long long*)(F.lds + PTR_OFF))[i];
    const unsigned lo = __builtin_amdgcn_readfirstlane((unsigned)v), hi = __builtin_amdgcn_readfirstlane((unsigned)(v >> 32));
    return (const float*)(((unsigned long long)hi << 32) | lo);
}
__device__ __forceinline__ bf16* win_ptr(unsigned char* ws, int l) { return (bf16*)(ws + WS_WIN0) + (size_t)l * INC * DM; }

__device__ __forceinline__ void p0_transpose_item(const float* W, int K, int N, bf16* WT, const float* gain, LAS float* scr, int kb, int nb, int dst_row0, int lane) {
    const int k0 = 64 * kb, n0 = 32 * nb;
#pragma unroll 8
    for (int i = 0; i < 32; ++i) { const int kk = 2 * i + (lane >> 5); float v = W[(size_t)(k0 + kk) * N + n0 + (lane & 31)]; if (gain) v *= gain[k0 + kk]; scr[kk * 33 + (lane & 31)] = v; }
    LDS_WAIT(); asm volatile("" ::: "memory");
    const int c = lane & 7;
#pragma unroll
    for (int j = 0; j < 4; ++j) { const int n = (lane >> 3) + 8 * j; const LAS float* s = scr + (8 * c) * 33 + n;
        v4u o; o.x = pk2(s[0 * 33], s[1 * 33]); o.y = pk2(s[2 * 33], s[3 * 33]); o.z = pk2(s[4 * 33], s[5 * 33]); o.w = pk2(s[6 * 33], s[7 * 33]);
        *(GAS v4u*)(WT + (size_t)(dst_row0 + n) * K + k0 + 8 * c) = o; }
    LDS_WAIT(); asm volatile("" ::: "memory");
}
__device__ __forceinline__ void rms_row_to_bf16(const float* xrow, bf16* orow, int lane) {
    const GAS f32x4* xr = (const GAS f32x4*)xrow + lane;
    f32x4 v[16]; float s = 0.f;
#pragma unroll
    for (int j = 0; j < 16; ++j) { v[j] = xr[64 * j]; s += (v[j].x * v[j].x + v[j].y * v[j].y) + (v[j].z * v[j].z + v[j].w * v[j].w); }
    const float rstd = 1.0f / sqrtf(wave_sum(s) * (1.0f / DM) + EPS);
    GAS unsigned long long* o8 = (GAS unsigned long long*)orow + lane;
#pragma unroll
    for (int j = 0; j < 16; ++j) o8[64 * j] = (unsigned long long)pk2(v[j].x * rstd, v[j].y * rstd) | ((unsigned long long)pk2(v[j].z * rstd, v[j].w * rstd) << 32);
}
__device__ __forceinline__ void p0_prologue(Frame& F) {
    const float* const w_in = inp(F, I_W_IN); const float* const pre_gain = inp(F, I_PRE_GAIN); const float* const w_kv = inp(F, I_W_KV); const float* const kv_gain = inp(F, I_KV_GAIN);
    const float* const w_out = inp(F, I_W_OUT); const float* const w_mem_kv = inp(F, I_W_MEM_KV); const float* const mem_gain = inp(F, I_MEM_GAIN);
    const float* const gate_a_w = inp(F, I_GATE_A_W); const float* const gate_x_w = inp(F, I_GATE_X_W); const float* const xin = inp(F, I_X); const float* const mem = inp(F, I_MEM);
    LAS float* scr = (LAS float*)(F.lds + RING_OFF + F.wave * 16384);
    const int gw = F.vcu * NWAVES + F.wave, NGW = F.G * NWAVES;
    constexpr int I_IN = 4 * 64 * 256, I_KV = 64 * 192, I_OUT = 4 * 64 * 128, I_MKV = 4 * 64 * 64, I_G = 48 * 32;
    constexpr int NITEMS = I_IN + I_KV + I_OUT + I_MKV + I_G;
    for (int it = gw; it < NITEMS; it += NGW) {
        int r = it;
        if (r < I_IN) { const int l = r / 16384, rr = r % 16384, kb = rr / 256, nb = rr % 256;
            p0_transpose_item(w_in + (size_t)l * DM * INC, DM, INC, win_ptr(F.ws, l), pre_gain + l * DM, scr, kb, nb, 32 * nb, F.lane); continue; } r -= I_IN;
        if (r < I_KV) { const int kb = r / 192, nb = r % 192;
            p0_transpose_item(w_kv, DM, KVW, (bf16*)(F.ws + WS_WKV), kv_gain, scr, kb, nb, 32 * nb, F.lane); continue; } r -= I_KV;
        if (r < I_OUT) { const int l = r / 8192, rr = r % 8192, kb = rr / 128, nb = rr % 128;
            p0_transpose_item(w_out + (size_t)l * MIXW * DM, MIXW, DM, (bf16*)(F.ws + WS_WOUT) + (size_t)l * DM * MIXW, nullptr, scr, kb, nb, 32 * nb, F.lane); continue; } r -= I_OUT;
        if (r < I_MKV) { const int l = r / 4096, rr = r % 4096, kb = rr / 64, nb = rr % 64; const int n0 = 32 * nb;
            bf16* dst = (bf16*)(F.ws + (n0 < MEMW ? WS_WMK : WS_WMV)); const int row0 = l * MEMW + (n0 < MEMW ? n0 : n0 - MEMW);
            p0_transpose_item(w_mem_kv + (size_t)l * DM * 2 * MEMW, DM, 2 * MEMW, dst, mem_gain, scr, kb, nb, row0, F.lane); continue; } r -= I_MKV;
        { const int mat = r / 32, rr = r % 32, kb = rr / 8, nb = rr % 8; const int ln = mat / 2, ga = mat % 2;
            p0_transpose_item((ga ? gate_x_w : gate_a_w) + (size_t)ln * 65536, 256, 256, (bf16*)(F.ws + WS_WG) + (size_t)ln * 512 * 256, nullptr, scr, kb, nb, ga * 256 + 32 * nb, F.lane); }
    }
    for (int m = gw; m < M; m += NGW) rms_row_to_bf16(xin + (size_t)m * DM, (bf16*)(F.ws + WS_HB) + (size_t)m * DM, F.lane);
    for (int m = gw; m < BATCH * MEM_T; m += NGW) rms_row_to_bf16(mem + (size_t)m * DM, (bf16*)(F.ws + WS_MEMB) + (size_t)m * DM, F.lane);
}

__device__ __forceinline__ void nr_phase(Frame& F, int layer) {
    const int gw = F.vcu * NWAVES + F.wave, NGW = F.G * NWAVES, lane = F.lane;
    const float* hsrc = layer == 0 ? inp(F, I_X) : F.out;
    const bf16* ob = (const bf16*)(F.ws + WS_OB); const float* part = (const float*)(F.ws + WS_PART); bf16* hb = (bf16*)(F.ws + WS_HB);
    const GAS f32x4* pg = (const GAS f32x4*)(inp(F, I_POST_GAIN) + layer * DM) + lane;
    for (int m = gw; m < M; m += NGW) {
        const float sso = wave_sum(part[(size_t)m * 64 + lane]);
        const float rs = 1.0f / sqrtf(sso * (1.0f / DM) + EPS);
        const GAS f32x4* hr = (const GAS f32x4*)(hsrc + (size_t)m * DM) + lane;
        const GAS v2u* orow = (const GAS v2u*)(ob + (size_t)m * DM) + lane;
        GAS f32x4* outr = (GAS f32x4*)(F.out + (size_t)m * DM) + lane;
        f32x4 v[16]; float s = 0.f;
#pragma unroll
        for (int j = 0; j < 16; ++j) { const f32x4 h = hr[64 * j]; const v2u o = orow[64 * j]; const f32x4 g = pg[64 * j];
            f32x4 r; r.x = h.x + bflo(o.x) * rs * g.x; r.y = h.y + bfhi(o.x) * rs * g.y; r.z = h.z + bflo(o.y) * rs * g.z; r.w = h.w + bfhi(o.y) * rs * g.w;
            v[j] = r; outr[64 * j] = r; s += (r.x * r.x + r.y * r.y) + (r.z * r.z + r.w * r.w); }
        if (layer < DEPTH - 1) {
            const float rstd = 1.0f / sqrtf(wave_sum(s) * (1.0f / DM) + EPS);
            GAS unsigned long long* o8 = (GAS unsigned long long*)(hb + (size_t)m * DM) + lane;
#pragma unroll
            for (int j = 0; j < 16; ++j) o8[64 * j] = (unsigned long long)pk2(v[j].x * rstd, v[j].y * rstd) | ((unsigned long long)pk2(v[j].z * rstd, v[j].w * rstd) << 32);
        }
    }
}

__device__ __forceinline__ bf16x8 pack8(float a0, float a1, float a2, float a3, float a4, float a5, float a6, float a7) {
    v4u p; p.x = pk2(a0, a1); p.y = pk2(a2, a3); p.z = pk2(a4, a5); p.w = pk2(a6, a7); return __builtin_bit_cast(bf16x8, p);
}
__device__ __forceinline__ void sb_attn_unit(const bf16* proj, const bf16* KB, const bf16* VT, bf16* mix, int b, int hd, int qt, int lane) {
    const int c = lane & 15, g = lane >> 4;
    const int t0 = qt * 16, tq = t0 + c;
    const size_t mrow = (size_t)b * SEQ;
    const float scale = 0.08838834764831845f;
    bf16x8 qf[4];
    { const bf16* qp = proj + (mrow + t0 + c) * INC + hd * 128 + 8 * g;
#pragma unroll
      for (int kk = 0; kk < 4; ++kk) qf[kk] = *(const GAS bf16x8*)(qp + 32 * kk); }
    f32x4 ot[8];
#pragma unroll
    for (int md = 0; md < 8; ++md) ot[md] = (f32x4){0.f, 0.f, 0.f, 0.f};
    float R = 0.f;
    for (int kb0 = t0 - 48; kb0 + 63 >= 0; kb0 -= 64) {
        f32x4 zt[4];
#pragma unroll
        for (int f = 0; f < 4; ++f) { int key = kb0 + 16 * f + c; key = key < 0 ? 0 : key;
            const bf16* kp = KB + (mrow + key) * MAINW + hd * 128 + 8 * g;
            f32x4 acc = (f32x4){0.f, 0.f, 0.f, 0.f};
#pragma unroll
            for (int kk = 0; kk < 4; ++kk) { const bf16x8 kf = *(const GAS bf16x8*)(kp + 32 * kk); acc = MFMA16(kf, qf[kk], acc); }
            zt[f] = acc; }
        float lb[4][4], sfx[4][4], Sf[4];
#pragma unroll
        for (int f = 0; f < 4; ++f) {
            float x[4];
#pragma unroll
            for (int r = 0; r < 4; ++r) { const int key = kb0 + 16 * f + 4 * g + r; const bool valid = (key >= 0) && (key < tq);
                const float z = zt[f][r] * scale; const float l1m = valid ? -softplus_f(z) : 0.f;
                x[r] = l1m; lb[f][r] = valid ? (z + l1m) : -1.0e30f; }
            sfx[f][3] = 0.f; sfx[f][2] = x[3]; sfx[f][1] = x[3] + x[2]; sfx[f][0] = x[3] + x[2] + x[1]; Sf[f] = sfx[f][0] + x[0];
        }
        float Facc = 0.f; float w[4][4];
#pragma unroll
        for (int f = 3; f >= 0; --f) {
            float v = Sf[f];
            float t = __shfl_down(v, 16); if (g < 3) v += t;
            t = __shfl_down(v, 32); if (g < 2) v += t;
            const float G = v - Sf[f];
            const float Tf = __shfl(v, c);
            const float base = R + Facc + G;
#pragma unroll
            for (int r = 0; r < 4; ++r) w[f][r] = fast_exp(lb[f][r] + base + sfx[f][r]);
            Facc += Tf;
        }
        R += Facc;
#pragma unroll
        for (int p = 0; p < 2; ++p) {
            const bf16x8 wf = pack8(w[2 * p][0], w[2 * p][1], w[2 * p][2], w[2 * p][3], w[2 * p + 1][0], w[2 * p + 1][1], w[2 * p + 1][2], w[2 * p + 1][3]);
            int k1 = kb0 + 32 * p + 4 * g, k2 = k1 + 16; k1 = k1 < 0 ? 0 : k1; k2 = k2 < 0 ? 0 : k2;
#pragma unroll
            for (int md = 0; md < 8; ++md) { const bf16* vp = VT + (size_t)(hd * 128 + 16 * md + c) * M + mrow;
                const v2u lo = *(const GAS v2u*)(vp + k1), hi = *(const GAS v2u*)(vp + k2);
                v4u vv; vv.x = lo.x; vv.y = lo.y; vv.z = hi.x; vv.w = hi.y;
                ot[md] = MFMA16(__builtin_bit_cast(bf16x8, vv), wf, ot[md]); }
        }
        if (__all(R < -104.0f)) break;
    }
    const size_t row = mrow + t0 + c;
#pragma unroll
    for (int md = 0; md < 8; ++md) { const int d0 = hd * 128 + 16 * md + 4 * g;
        const v2u gt = *(const GAS v2u*)(proj + row * INC + MAINW + d0);
        v2u o; o.x = pk2(ot[md][0] * silu_f(bflo(gt.x)), ot[md][1] * silu_f(bfhi(gt.x))); o.y = pk2(ot[md][2] * silu_f(bflo(gt.y)), ot[md][3] * silu_f(bfhi(gt.y)));
        *(GAS v2u*)(mix + row * MIXW + d0) = o; }
}

__device__ __forceinline__ void mem_attn_unit(const bf16* proj, const bf16* memk, const bf16* memvt, bf16* mix, int layer, int mh, int qt, int lane) {
    const int c = lane & 15, g = lane >> 4;
    const size_t row = (size_t)qt * 16 + c;
    const int b = (qt * 16) / SEQ;
    const int fbase = layer * MEMW + mh * 256;
    f32x4 st[16];
    {
        bf16x8 qf[8];
        const bf16* qp = proj + row * INC + 2 * MAINW + mh * 256 + 8 * g;
#pragma unroll
        for (int kk = 0; kk < 8; ++kk) qf[kk] = *(const GAS bf16x8*)(qp + 32 * kk);
#pragma unroll
        for (int f = 0; f < 16; ++f) { const bf16* kp = memk + (size_t)(b * MEM_T + 16 * f + c) * (DEPTH * MEMW) + fbase + 8 * g;
            f32x4 acc = (f32x4){0.f, 0.f, 0.f, 0.f};
#pragma unroll
            for (int kk = 0; kk < 8; ++kk) { const bf16x8 kf = *(const GAS bf16x8*)(kp + 32 * kk); acc = MFMA16(kf, qf[kk], acc); }
            st[f] = acc; }
    }
    float mx = -3.0e38f;
#pragma unroll
    for (int f = 0; f < 16; ++f)
#pragma unroll
        for (int r = 0; r < 4; ++r) mx = fmaxf(mx, st[f][r]);
    mx = fmaxf(mx, __shfl_xor(mx, 16)); mx = fmaxf(mx, __shfl_xor(mx, 32));
    float den = 0.f;
#pragma unroll
    for (int f = 0; f < 16; ++f)
#pragma unroll
        for (int r = 0; r < 4; ++r) { const float p = fast_exp((st[f][r] - mx) * 0.0625f); st[f][r] = p; den += p; }
    den += __shfl_xor(den, 16); den += __shfl_xor(den, 32);
    const float inv = 1.0f / den;
    bf16x8 pf[8];
#pragma unroll
    for (int p = 0; p < 8; ++p) pf[p] = pack8(st[2 * p][0], st[2 * p][1], st[2 * p][2], st[2 * p][3], st[2 * p + 1][0], st[2 * p + 1][1], st[2 * p + 1][2], st[2 * p + 1][3]);
#pragma unroll
    for (int half = 0; half < 2; ++half) {
        f32x4 ot[8];
#pragma unroll
        for (int md = 0; md < 8; ++md) ot[md] = (f32x4){0.f, 0.f, 0.f, 0.f};
#pragma unroll
        for (int md = 0; md < 8; ++md) { const bf16* vp = memvt + (size_t)(fbase + 128 * half + 16 * md + c) * (BATCH * MEM_T) + b * MEM_T + 4 * g;
#pragma unroll
            for (int p = 0; p < 8; ++p) { const v2u lo = *(const GAS v2u*)(vp + 32 * p), hi = *(const GAS v2u*)(vp + 32 * p + 16);
                v4u vv; vv.x = lo.x; vv.y = lo.y; vv.z = hi.x; vv.w = hi.y;
                ot[md] = MFMA16(__builtin_bit_cast(bf16x8, vv), pf[p], ot[md]); } }
#pragma unroll
        for (int md = 0; md < 8; ++md) { const int d0 = mh * 256 + 128 * half + 16 * md + 4 * g;
            const v2u gt = *(const GAS v2u*)(proj + row * INC + 2 * MAINW + MEMW + d0);
            v2u o; o.x = pk2(ot[md][0] * inv * silu_f(bflo(gt.x)), ot[md][1] * inv * silu_f(bfhi(gt.x))); o.y = pk2(ot[md][2] * inv * silu_f(bflo(gt.y)), ot[md][3] * inv * silu_f(bfhi(gt.y)));
            *(GAS v2u*)(mix + row * MIXW + MAINW + d0) = o; }
    }
}

template <bool FINAL>
__device__ __forceinline__ void lru_unit(Frame& F, int layer, int b, int n, int ch) {
    const int tid = F.tid, lane = F.lane, wave = F.wave, c = lane & 15, g = lane >> 4;
    const bf16* proj = (const bf16*)(F.ws + WS_PROJ);
    const float* const conv_w = inp(F, I_CONV_W); const float* const conv_b = inp(F, I_CONV_B);
    LAS bf16* ut = (LAS bf16*)(F.lds + RING_OFF);
    const int t0 = ch * LRU_T; const size_t mrow = (size_t)b * SEQ;
    {
        const int cg = tid & 31, rg = tid >> 5;
        const int col = 256 * n + 8 * cg;
        float cw[4][8], cb[8];
#pragma unroll
        for (int k = 0; k < 4; ++k) { const f32x4 a = *(const GAS f32x4*)(conv_w + ((size_t)layer * 4 + k) * MAINW + col), bb = *(const GAS f32x4*)(conv_w + ((size_t)layer * 4 + k) * MAINW + col + 4);
            cw[k][0] = a.x; cw[k][1] = a.y; cw[k][2] = a.z; cw[k][3] = a.w; cw[k][4] = bb.x; cw[k][5] = bb.y; cw[k][6] = bb.z; cw[k][7] = bb.w; }
        { const f32x4 a = *(const GAS f32x4*)(conv_b + (size_t)layer * MAINW + col), bb = *(const GAS f32x4*)(conv_b + (size_t)layer * MAINW + col + 4);
            cb[0] = a.x; cb[1] = a.y; cb[2] = a.z; cb[3] = a.w; cb[4] = bb.x; cb[5] = bb.y; cb[6] = bb.z; cb[7] = bb.w; }
        float xr[11][8];
#pragma unroll
        for (int i = 0; i < 11; ++i) { const int t = t0 + rg * 8 - 3 + i;
            v4u raw = (v4u){0u, 0u, 0u, 0u};
            if (t >= 0) raw = *(const GAS v4u*)(proj + (mrow + t) * INC + col);
            xr[i][0] = bflo(raw.x); xr[i][1] = bfhi(raw.x); xr[i][2] = bflo(raw.y); xr[i][3] = bfhi(raw.y); xr[i][4] = bflo(raw.z); xr[i][5] = bfhi(raw.z); xr[i][6] = bflo(raw.w); xr[i][7] = bfhi(raw.w); }
#pragma unroll
        for (int tt = 0; tt < 8; ++tt) { float u[8];
#pragma unroll
            for (int e = 0; e < 8; ++e) u[e] = cb[e] + cw[0][e] * xr[tt][e] + cw[1][e] * xr[tt + 1][e] + cw[2][e] * xr[tt + 2][e] + cw[3][e] * xr[tt + 3][e];
            v4u o; o.x = pk2(u[0], u[1]); o.y = pk2(u[2], u[3]); o.z = pk2(u[4], u[5]); o.w = pk2(u[6], u[7]);
            *(LAS v4u*)(ut + (rg * 8 + tt) * UT_PITCH + 8 * cg) = o; }
    }
    __syncthreads();
    float* agg = (float*)(F.ws + WS_AGG);
    const bf16* wg = (const bf16*)(F.ws + WS_WG) + (size_t)(layer * LRU_NB + n) * 512 * 256;
#pragma unroll 1
    for (int nf = 0; nf < 2; ++nf) {
        const int chl = 32 * wave + 16 * nf + c;
        const int chn = 256 * n + chl;
        const bf16* const gbase = proj + (mrow + t0) * INC + MAINW + 256 * n;
        bf16* const obase = (bf16*)(F.ws + WS_MIX) + (mrow + t0) * MIXW + 256 * n;
        const int goff = (4 * g) * INC + chl, ooff = (4 * g) * MIXW + chl;
        unsigned short gtv[8][4];
        if (FINAL) {
#pragma unroll
            for (int mf = 0; mf < 8; ++mf)
#pragma unroll
                for (int r = 0; r < 4; ++r) gtv[mf][r] = *(const GAS bf16*)(gbase + (16 * mf + r) * INC + goff);
        }
        f32x4 acc[8][2];
#pragma unroll
        for (int mf = 0; mf < 8; ++mf) { acc[mf][0] = (f32x4){0.f, 0.f, 0.f, 0.f}; acc[mf][1] = (f32x4){0.f, 0.f, 0.f, 0.f}; }
#pragma unroll 2
        for (int kk = 0; kk < 8; ++kk) {
            bf16x8 bfr[2], afr[8];
#pragma unroll
            for (int ga = 0; ga < 2; ++ga) bfr[ga] = *(const GAS bf16x8*)(wg + (size_t)(ga * 256 + chl) * 256 + 32 * kk + 8 * g);
#pragma unroll
            for (int mf = 0; mf < 8; ++mf) afr[mf] = *(const LAS bf16x8*)(ut + (16 * mf + c) * UT_PITCH + 32 * kk + 8 * g);
#pragma unroll
            for (int mf = 0; mf < 8; ++mf) { acc[mf][0] = MFMA16(afr[mf], bfr[0], acc[mf][0]); acc[mf][1] = MFMA16(afr[mf], bfr[1], acc[mf][1]); }
        }
        {
            const float ba = inp(F, I_GATE_A_B)[(size_t)layer * MAINW + chn], bx = inp(F, I_GATE_X_B)[(size_t)layer * MAINW + chn];
            const float c8 = -8.0f * softplus_f(-inp(F, I_LAM)[(size_t)layer * MAINW + chn]);
#pragma unroll
            for (int mf = 0; mf < 8; ++mf)
#pragma unroll
                for (int r = 0; r < 4; ++r) {
                    const float rr = fast_sigmoid(acc[mf][0][r] + ba), ii = fast_sigmoid(acc[mf][1][r] + bx);
                    const float a = fast_exp(c8 * rr);
                    const float uval = bf2f(ut[(16 * mf + 4 * g + r) * UT_PITCH + chl]);
                    const float om = fmaxf(1.0f - a * a, 0.f);
                    acc[mf][0][r] = a; acc[mf][1][r] = sqrtf(om) * (ii * uval);
                }
        }
        float hc = 0.f;
        float PT = 1.f;
        if (FINAL) {
            for (int cc = 0; cc < ch; ++cc) { const f32x2 ag = *(const GAS f32x2*)(agg + ((size_t)(b * LRU_NC + cc) * MAINW + chn) * 2); hc = ag.x * hc + ag.y; }
        }
#pragma unroll
        for (int mf = 0; mf < 8; ++mf) {
            float A = 1.f, B = 0.f;
#pragma unroll
            for (int r = 0; r < 4; ++r) { const float a = acc[mf][0][r]; A *= a; B = a * B + acc[mf][1][r]; }
            float Ai = A, Bi = B;
            { const float Ap = __shfl_up(Ai, 16), Bp = __shfl_up(Bi, 16); if (g >= 1) { Bi = Ai * Bp + Bi; Ai = Ap * Ai; } }
            { const float Ap = __shfl_up(Ai, 32), Bp = __shfl_up(Bi, 32); if (g >= 2) { Bi = Ai * Bp + Bi; Ai = Ap * Ai; } }
            const float Af = __shfl(Ai, 48 + c), Bf = __shfl(Bi, 48 + c);
            if (FINAL) {
                float Ae = __shfl_up(Ai, 16), Be = __shfl_up(Bi, 16); if (g == 0) { Ae = 1.f; Be = 0.f; }
                float h = Ae * hc + Be;
#pragma unroll
                for (int r = 0; r < 4; ++r) { h = acc[mf][0][r] * h + acc[mf][1][r];
                    const float gt = bf2f(gtv[mf][r]);
                    *(GAS bf16*)(obase + (16 * mf + r) * MIXW + ooff) = (bf16)f2bf(h * silu_f(gt)); }
                hc = Af * hc + Bf;
            } else { hc = Af * hc + Bf; PT *= Af; }
        }
        if (!FINAL && g == 0) { f32x2 o; o.x = PT; o.y = hc; *(GAS f32x2*)(agg + ((size_t)(b * LRU_NC + ch) * MAINW + chn) * 2) = o; }
    }
    __syncthreads();
}

#ifndef MK_ONE_LAUNCH
#define MK_ONE_LAUNCH 1
#endif
constexpr int NPHASES = 2 + 5 * DEPTH;
struct Args { const float* in[17]; float* out; unsigned char* ws; int ph_lo, ph_hi; };
__global__ void __launch_bounds__(NWAVES * 64, 2) yoco_fwd(Args args) {
    extern __shared__ __attribute__((aligned(16))) unsigned char lds[];
    Frame F;
    F.lds = (LAS unsigned char*)lds;
    volatile LAS unsigned* MISC = (volatile LAS unsigned*)(F.lds + MISC_OFF);
    F.tid = threadIdx.x; F.lane = F.tid & 63; F.wave = __builtin_amdgcn_readfirstlane(F.tid >> 6);
    F.G = gridDim.x; { const int bx = blockIdx.x; F.vcu = (F.G % 8 == 0) ? (bx % 8) * (F.G / 8) + bx / 8 : bx; }
    F.out = args.out; F.ws = args.ws;
    unsigned* ctl = (unsigned*)(F.ws + WS_CTL);
    for (int u = F.tid; u < (LDS_BYTES - LDSCTL_OFF) / 4; u += NWAVES * 64) ((LAS unsigned*)(F.lds + LDSCTL_OFF))[u] = 0u;
    __syncthreads();
    if (F.tid < I_NIN) ((LAS unsigned long long*)(F.lds + PTR_OFF))[F.tid] = (unsigned long long)args.in[F.tid];
    __syncthreads();
    const int lo = args.ph_lo, hi = args.ph_hi;
    XcdBarrier bar; bar.bar = ctl + CW_BAR; bar.x = 0; bar.st = nullptr;
    if (hi - lo > 1) bar = xcd_barrier_post(ctl + CW_BAR, MISC + 8);
#define IN(k) (lo <= (k) && (k) < hi)
#define SEAM(k) do { if (IN(k) && IN((k) + 1)) xcd_barrier(bar); } while (0)

#define PHASE_PTRS() Frame P = F; P.ws = args.ws; LAUNDER_S(P.ws); P.out = args.out; LAUNDER_S(P.out); \
    { int t_ = threadIdx.x; asm volatile("" : "+v"(t_)); P.tid = t_; P.lane = t_ & 63; P.wave = __builtin_amdgcn_readfirstlane(t_ >> 6); } \
    const int gw = P.vcu * NWAVES + P.wave, NGW = P.G * NWAVES; (void)gw; (void)NGW; \
    bf16* const HB = (bf16*)(P.ws + WS_HB); bf16* const PROJ = (bf16*)(P.ws + WS_PROJ); bf16* const KB = (bf16*)(P.ws + WS_KB); bf16* const VT = (bf16*)(P.ws + WS_VT); \
    bf16* const MIX = (bf16*)(P.ws + WS_MIX); bf16* const OB = (bf16*)(P.ws + WS_OB); bf16* const MEMB = (bf16*)(P.ws + WS_MEMB); bf16* const MEMK = (bf16*)(P.ws + WS_MEMK); bf16* const MEMVT = (bf16*)(P.ws + WS_MEMVT); \
    (void)HB; (void)PROJ; (void)KB; (void)VT; (void)MIX; (void)OB; (void)MEMB; (void)MEMK; (void)MEMVT;

    if (IN(0)) { PHASE_PTRS();
#ifndef DIS_P0
 p0_prologue(P);
#endif
 }
    SEAM(0);
    if (IN(1)) { PHASE_PTRS();
#ifndef DIS_GMEM
        { pg8::Gemm g{MEMB, (const bf16*)(P.ws + WS_WMK), BATCH * MEM_T, DEPTH * MEMW, DM}; pg8::StaticOrder S; S.init(BATCH * MEM_T, DEPTH * MEMW, F.G, (int)blockIdx.x);
          pg8::EpiBf16 E{MEMK, DEPTH * MEMW, 1 << 30, nullptr, 0};
          pg8::gemm_phase<pg8::EpiBf16, pg8::StaticOrder, true, true>(F.lds + RING_OFF, g, S, E); }
        { pg8::Gemm g{(const bf16*)(P.ws + WS_WMV), MEMB, DEPTH * MEMW, BATCH * MEM_T, DM}; pg8::StaticOrder S; S.init(DEPTH * MEMW, BATCH * MEM_T, F.G, (int)((blockIdx.x + F.G / 2) % F.G));
          pg8::EpiBf16 E{MEMVT, BATCH * MEM_T, 1 << 30, nullptr, 0};
          pg8::gemm_phase<pg8::EpiBf16, pg8::StaticOrder, true, true>(F.lds + RING_OFF, g, S, E); }
#endif
    }
    SEAM(1);
    { constexpr int l = 0;
        const int pb = 2 + 5 * l;
        if (IN(pb)) { PHASE_PTRS();
            { pg8::Gemm g{HB, win_ptr(P.ws, l), M, INC, DM}; pg8::StaticOrder S; S.init(M, INC, F.G, (int)blockIdx.x);
              pg8::EpiBf16 E{PROJ, INC, 1 << 30, nullptr, 0};
              pg8::gemm_phase<pg8::EpiBf16, pg8::StaticOrder, true, true>(F.lds + RING_OFF, g, S, E); }
#ifndef DIS_GVT
            if (l == N_A) {
              { pg8::Gemm g{HB, (const bf16*)(P.ws + WS_WKV), M, MAINW, DM}; pg8::StaticOrder S; S.init(M, MAINW, F.G, (int)blockIdx.x);
                pg8::EpiBf16 E{KB, MAINW, 1 << 30, nullptr, 0};
                pg8::gemm_phase<pg8::EpiBf16, pg8::StaticOrder, true, true>(F.lds + RING_OFF, g, S, E); }
              { pg8::Gemm g{(const bf16*)(P.ws + WS_WKV) + (size_t)MAINW * DM, HB, MAINW, M, DM}; pg8::StaticOrder S; S.init(MAINW, M, F.G, (int)blockIdx.x);
                pg8::EpiBf16 E{VT, M, 1 << 30, nullptr, 0};
                pg8::gemm_phase<pg8::EpiBf16, pg8::StaticOrder, true, true>(F.lds + RING_OFF, g, S, E); }
            }
#endif
        }
        SEAM(pb);
        if (IN(pb + 1)) { PHASE_PTRS();
#ifndef DIS_LRU
            if (l < N_A) { for (int u = P.vcu; u < BATCH * LRU_NB * LRU_NC; u += P.G) lru_unit<false>(P, l, u / (LRU_NB * LRU_NC), (u / LRU_NC) % LRU_NB, u % LRU_NC); }
#endif
#ifndef DIS_SB
            if (l >= N_A) { for (int u = gw; u < BATCH * SB_H * (SEQ / 16); u += NGW) sb_attn_unit(PROJ, KB, VT, MIX, u / (SB_H * (SEQ / 16)), (u / (SEQ / 16)) % SB_H, u % (SEQ / 16), P.lane); }
#endif
#ifndef DIS_MEM
            for (int u = gw; u < MEM_H * (M / 16); u += NGW) mem_attn_unit(PROJ, MEMK, MEMVT, MIX, l, u / (M / 16), u % (M / 16), P.lane);
#endif
        }
        SEAM(pb + 1);
        if (IN(pb + 2)) { PHASE_PTRS();
#ifndef DIS_LRU
            if (l < N_A) { for (int u = P.vcu; u < BATCH * LRU_NB * LRU_NC; u += P.G) lru_unit<true>(P, l, u / (LRU_NB * LRU_NC), (u / LRU_NC) % LRU_NB, u % LRU_NC); }
#endif
        }
        if (l < N_A) SEAM(pb + 2);
        if (IN(pb + 3)) { PHASE_PTRS();
#ifndef DIS_G2
            pg8::Gemm g{MIX, (const bf16*)(P.ws + WS_WOUT) + (size_t)l * DM * MIXW, M, DM, MIXW}; pg8::StaticOrder S; S.init(M, DM, F.G, (int)blockIdx.x);
            pg8::EpiBf16SS E{OB, DM, (float*)(P.ws + WS_PART)};
            pg8::gemm_phase<pg8::EpiBf16SS, pg8::StaticOrder, true, true>(F.lds + RING_OFF, g, S, E);
#endif
        }
        SEAM(pb + 3);
#ifndef DIS_NR
        if (IN(pb + 4)) { PHASE_PTRS(); nr_phase(P, l); }
#endif
        SEAM(pb + 4);
    }
    { constexpr int l = 1;
        const int pb = 2 + 5 * l;
        if (IN(pb)) { PHASE_PTRS();
            { pg8::Gemm g{HB, win_ptr(P.ws, l), M, INC, DM}; pg8::StaticOrder S; S.init(M, INC, F.G, (int)blockIdx.x);
              pg8::EpiBf16 E{PROJ, INC, 1 << 30, nullptr, 0};
              pg8::gemm_phase<pg8::EpiBf16, pg8::StaticOrder, true, true>(F.lds + RING_OFF, g, S, E); }
#ifndef DIS_GVT
            if (l == N_A) {
              { pg8::Gemm g{HB, (const bf16*)(P.ws + WS_WKV), M, MAINW, DM}; pg8::StaticOrder S; S.init(M, MAINW, F.G, (int)blockIdx.x);
                pg8::EpiBf16 E{KB, MAINW, 1 << 30, nullptr, 0};
                pg8::gemm_phase<pg8::EpiBf16, pg8::StaticOrder, true, true>(F.lds + RING_OFF, g, S, E); }
              { pg8::Gemm g{(const bf16*)(P.ws + WS_WKV) + (size_t)MAINW * DM, HB, MAINW, M, DM}; pg8::StaticOrder S; S.init(MAINW, M, F.G, (int)blockIdx.x);
                pg8::EpiBf16 E{VT, M, 1 << 30, nullptr, 0};
                pg8::gemm_phase<pg8::EpiBf16, pg8::StaticOrder, true, true>(F.lds + RING_OFF, g, S, E); }
            }
#endif
        }
        SEAM(pb);
        if (IN(pb + 1)) { PHASE_PTRS();
#ifndef DIS_LRU
            if (l < N_A) { for (int u = P.vcu; u < BATCH * LRU_NB * LRU_NC; u += P.G) lru_unit<false>(P, l, u / (LRU_NB * LRU_NC), (u / LRU_NC) % LRU_NB, u % LRU_NC); }
#endif
#ifndef DIS_SB
            if (l >= N_A) { for (int u = gw; u < BATCH * SB_H * (SEQ / 16); u += NGW) sb_attn_unit(PROJ, KB, VT, MIX, u / (SB_H * (SEQ / 16)), (u / (SEQ / 16)) % SB_H, u % (SEQ / 16), P.lane); }
#endif
#ifndef DIS_MEM
            for (int u = gw; u < MEM_H * (M / 16); u += NGW) mem_attn_unit(PROJ, MEMK, MEMVT, MIX, l, u / (M / 16), u % (M / 16), P.lane);
#endif
        }
        SEAM(pb + 1);
        if (IN(pb + 2)) { PHASE_PTRS();
#ifndef DIS_LRU
            if (l < N_A) { for (int u = P.vcu; u < BATCH * LRU_NB * LRU_NC; u += P.G) lru_unit<true>(P, l, u / (LRU_NB * LRU_NC), (u / LRU_NC) % LRU_NB, u % LRU_NC); }
#endif
        }
        if (l < N_A) SEAM(pb + 2);
        if (IN(pb + 3)) { PHASE_PTRS();
#ifndef DIS_G2
            pg8::Gemm g{MIX, (const bf16*)(P.ws + WS_WOUT) + (size_t)l * DM * MIXW, M, DM, MIXW}; pg8::StaticOrder S; S.init(M, DM, F.G, (int)blockIdx.x);
            pg8::EpiBf16SS E{OB, DM, (float*)(P.ws + WS_PART)};
            pg8::gemm_phase<pg8::EpiBf16SS, pg8::StaticOrder, true, true>(F.lds + RING_OFF, g, S, E);
#endif
        }
        SEAM(pb + 3);
#ifndef DIS_NR
        if (IN(pb + 4)) { PHASE_PTRS(); nr_phase(P, l); }
#endif
        SEAM(pb + 4);
    }
    { constexpr int l = 2;
        const int pb = 2 + 5 * l;
        if (IN(pb)) { PHASE_PTRS();
            { pg8::Gemm g{HB, win_ptr(P.ws, l), M, INC, DM}; pg8::StaticOrder S; S.init(M, INC, F.G, (int)blockIdx.x);
              pg8::EpiBf16 E{PROJ, INC, 1 << 30, nullptr, 0};
              pg8::gemm_phase<pg8::EpiBf16, pg8::StaticOrder, true, true>(F.lds + RING_OFF, g, S, E); }
#ifndef DIS_GVT
            if (l == N_A) {
              { pg8::Gemm g{HB, (const bf16*)(P.ws + WS_WKV), M, MAINW, DM}; pg8::StaticOrder S; S.init(M, MAINW, F.G, (int)blockIdx.x);
                pg8::EpiBf16 E{KB, MAINW, 1 << 30, nullptr, 0};
                pg8::gemm_phase<pg8::EpiBf16, pg8::StaticOrder, true, true>(F.lds + RING_OFF, g, S, E); }
              { pg8::Gemm g{(const bf16*)(P.ws + WS_WKV) + (size_t)MAINW * DM, HB, MAINW, M, DM}; pg8::StaticOrder S; S.init(MAINW, M, F.G, (int)blockIdx.x);
                pg8::EpiBf16 E{VT, M, 1 << 30, nullptr, 0};
                pg8::gemm_phase<pg8::EpiBf16, pg8::StaticOrder, true, true>(F.lds + RING_OFF, g, S, E); }
            }
#endif
        }
        SEAM(pb);
        if (IN(pb + 1)) { PHASE_PTRS();
#ifndef DIS_LRU
            if (l < N_A) { for (int u = P.vcu; u < BATCH * LRU_NB * LRU_NC; u += P.G) lru_unit<false>(P, l, u / (LRU_NB * LRU_NC), (u / LRU_NC) % LRU_NB, u % LRU_NC); }
#endif
#ifndef DIS_SB
            if (l >= N_A) { for (int u = gw; u < BATCH * SB_H * (SEQ / 16); u += NGW) sb_attn_unit(PROJ, KB, VT, MIX, u / (SB_H * (SEQ / 16)), (u / (SEQ / 16)) % SB_H, u % (SEQ / 16), P.lane); }
#endif
#ifndef DIS_MEM
            for (int u = gw; u < MEM_H * (M / 16); u += NGW) mem_attn_unit(PROJ, MEMK, MEMVT, MIX, l, u / (M / 16), u % (M / 16), P.lane);
#endif
        }
        SEAM(pb + 1);
        if (IN(pb + 2)) { PHASE_PTRS();
#ifndef DIS_LRU
            if (l < N_A) { for (int u = P.vcu; u < BATCH * LRU_NB * LRU_NC; u += P.G) lru_unit<true>(P, l, u / (LRU_NB * LRU_NC), (u / LRU_NC) % LRU_NB, u % LRU_NC); }
#endif
        }
        if (l < N_A) SEAM(pb + 2);
        if (IN(pb + 3)) { PHASE_PTRS();
#ifndef DIS_G2
            pg8::Gemm g{MIX, (const bf16*)(P.ws + WS_WOUT) + (size_t)l * DM * MIXW, M, DM, MIXW}; pg8::StaticOrder S; S.init(M, DM, F.G, (int)blockIdx.x);
            pg8::EpiBf16SS E{OB, DM, (float*)(P.ws + WS_PART)};
            pg8::gemm_phase<pg8::EpiBf16SS, pg8::StaticOrder, true, true>(F.lds + RING_OFF, g, S, E);
#endif
        }
        SEAM(pb + 3);
#ifndef DIS_NR
        if (IN(pb + 4)) { PHASE_PTRS(); nr_phase(P, l); }
#endif
        SEAM(pb + 4);
    }
    { constexpr int l = 3;
        const int pb = 2 + 5 * l;
        if (IN(pb)) { PHASE_PTRS();
            { pg8::Gemm g{HB, win_ptr(P.ws, l), M, INC, DM}; pg8::StaticOrder S; S.init(M, INC, F.G, (int)blockIdx.x);
              pg8::EpiBf16 E{PROJ, INC, 1 << 30, nullptr, 0};
              pg8::gemm_phase<pg8::EpiBf16, pg8::StaticOrder, true, true>(F.lds + RING_OFF, g, S, E); }
#ifndef DIS_GVT
            if (l == N_A) {
              { pg8::Gemm g{HB, (const bf16*)(P.ws + WS_WKV), M, MAINW, DM}; pg8::StaticOrder S; S.init(M, MAINW, F.G, (int)blockIdx.x);
                pg8::EpiBf16 E{KB, MAINW, 1 << 30, nullptr, 0};
                pg8::gemm_phase<pg8::EpiBf16, pg8::StaticOrder, true, true>(F.lds + RING_OFF, g, S, E); }
              { pg8::Gemm g{(const bf16*)(P.ws + WS_WKV) + (size_t)MAINW * DM, HB, MAINW, M, DM}; pg8::StaticOrder S; S.init(MAINW, M, F.G, (int)blockIdx.x);
                pg8::EpiBf16 E{VT, M, 1 << 30, nullptr, 0};
                pg8::gemm_phase<pg8::EpiBf16, pg8::StaticOrder, true, true>(F.lds + RING_OFF, g, S, E); }
            }
#endif
        }
        SEAM(pb);
        if (IN(pb + 1)) { PHASE_PTRS();
#ifndef DIS_LRU
            if (l < N_A) { for (int u = P.vcu; u < BATCH * LRU_NB * LRU_NC; u += P.G) lru_unit<false>(P, l, u / (LRU_NB * LRU_NC), (u / LRU_NC) % LRU_NB, u % LRU_NC); }
#endif
#ifndef DIS_SB
            if (l >= N_A) { for (int u = gw; u < BATCH * SB_H * (SEQ / 16); u += NGW) sb_attn_unit(PROJ, KB, VT, MIX, u / (SB_H * (SEQ / 16)), (u / (SEQ / 16)) % SB_H, u % (SEQ / 16), P.lane); }
#endif
#ifndef DIS_MEM
            for (int u = gw; u < MEM_H * (M / 16); u += NGW) mem_attn_unit(PROJ, MEMK, MEMVT, MIX, l, u / (M / 16), u % (M / 16), P.lane);
#endif
        }
        SEAM(pb + 1);
        if (IN(pb + 2)) { PHASE_PTRS();
#ifndef DIS_LRU
            if (l < N_A) { for (int u = P.vcu; u < BATCH * LRU_NB * LRU_NC; u += P.G) lru_unit<true>(P, l, u / (LRU_NB * LRU_NC), (u / LRU_NC) % LRU_NB, u % LRU_NC); }
#endif
        }
        if (l < N_A) SEAM(pb + 2);
        if (IN(pb + 3)) { PHASE_PTRS();
#ifndef DIS_G2
            pg8::Gemm g{MIX, (const bf16*)(P.ws + WS_WOUT) + (size_t)l * DM * MIXW, M, DM, MIXW}; pg8::StaticOrder S; S.init(M, DM, F.G, (int)blockIdx.x);
            pg8::EpiBf16SS E{OB, DM, (float*)(P.ws + WS_PART)};
            pg8::gemm_phase<pg8::EpiBf16SS, pg8::StaticOrder, true, true>(F.lds + RING_OFF, g, S, E);
#endif
        }
        SEAM(pb + 3);
#ifndef DIS_NR
        if (IN(pb + 4)) { PHASE_PTRS(); nr_phase(P, l); }
#endif
        SEAM(pb + 4);
    }
#undef IN
#undef SEAM
}

extern "C" void kernel_launch(void* const* d_in, const int* in_sizes, int n_in, void* d_out, int out_size, void* d_ws, size_t ws_size, hipStream_t stream) {
    static int grid = 0;
    if (grid == 0) {
        if (n_in != 17 || in_sizes[0] != M * DM || out_size != M * DM || ws_size < WS_END) { fprintf(stderr, "kernel_launch: unexpected shapes (n_in %d, in0 %d, out %d, ws %zu); nothing launched\n", n_in, n_in > 0 ? in_sizes[0] : -1, out_size, ws_size); grid = -1; return; }
        int dev = 0, cus = 0, per_cu = 0;
        if (hipGetDevice(&dev) != hipSuccess || hipDeviceGetAttribute(&cus, hipDeviceAttributeMultiprocessorCount, dev) != hipSuccess) { grid = -1; return; }
        if (hipFuncSetAttribute((const void*)yoco_fwd, hipFuncAttributeMaxDynamicSharedMemorySize, LDS_BYTES) != hipSuccess) { fprintf(stderr, "kernel_launch: hipFuncSetAttribute failed\n"); grid = -1; return; }
        if (hipOccupancyMaxActiveBlocksPerMultiprocessor(&per_cu, (const void*)yoco_fwd, NWAVES * 64, LDS_BYTES) != hipSuccess || per_cu < 1)
            fprintf(stderr, "kernel_launch: note: occupancy query reports %d workgroups per CU\n", per_cu);
        (void)hipGetLastError();
        grid = cus;
    }
    if (grid < 0) return;
    if (hipMemsetAsync((char*)d_ws + WS_CTL, 0, CTL_ZERO_BYTES, stream) != hipSuccess) return;
    Args a{};
    for (int i = 0; i < 17; ++i) a.in[i] = (const float*)d_in[i];
    a.out = (float*)d_out; a.ws = (unsigned char*)d_ws;
#if MK_ONE_LAUNCH
    a.ph_lo = 0; a.ph_hi = NPHASES;
    hipLaunchKernelGGL(yoco_fwd, dim3(grid), dim3(NWAVES * 64), LDS_BYTES, stream, a);
#else
    for (int ph = 0; ph < NPHASES; ++ph) {
        if (ph >= 2 && (ph - 2) % 5 == 2 && (ph - 2) / 5 >= N_A) continue;
        a.ph_lo = ph; a.ph_hi = ph + 1;
        hipLaunchKernelGGL(yoco_fwd, dim3(grid), dim3(NWAVES * 64), LDS_BYTES, stream, a);
    }
#endif
}
```

```cpp
#include <hip/hip_runtime.h>
#include <cstdio>
#include <cstdint>
namespace pg8 {
#define PG8_LAS __attribute__((address_space(3)))
typedef unsigned short bf16_t;
typedef short bf16x8 __attribute__((ext_vector_type(8)));
typedef float f32x4 __attribute__((ext_vector_type(4)));
typedef unsigned u32x4 __attribute__((ext_vector_type(4)));
constexpr int BM = 256, BK = 64, HALF = 128, HTB = HALF * BK * 2  , STAGE_BYTES = 8 * HTB, NXCD = 8, WGM = 8;

__host__ __device__ __forceinline__ int lds_byte(int r, int c) { const int st = (r >> 4) * 2 + (c >> 5), rr = r & 15, cc = c & 31, ob = rr * 64 + cc * 2; return st * 1024 + (ob ^ (((ob >> 9) & 1) << 5)); }
__host__ __device__ __forceinline__ void stage_rc(int b, int& R, int& C) { const int st = b / 1024, sb = b % 1024, swz = sb ^ (((sb >> 9) & 1) << 5); R = (st >> 1) * 16 + swz / 64; C = (st & 1) * 32 + (swz % 64) / 2; }
__host__ __device__ __forceinline__ int perm32(int rho) { const int n = rho >> 4, i = rho & 15; return 8 * (i >> 2) + 4 * n + (i & 3); }

struct Unit { int pm, pn; };
struct Gemm { const bf16_t* A; const bf16_t* Bt; int M, N, K; };

struct StaticOrder {
    int nM, nN, nwg, G, c;
    __host__ __device__ void init(int M, int N, int G_, int c_) { nM = M / BM; nN = N / BM; nwg = nM * nN; G = G_; c = c_; }
    __host__ __device__ bool next(int i, Unit& u) const {
        const long L = (long)i * G + c; if (L >= nwg) return false;
        int wgid = (int)L; { const int q = nwg / NXCD, r = nwg % NXCD, xcd = wgid % NXCD, off = wgid / NXCD; wgid = (xcd < r ? xcd * (q + 1) : r * (q + 1) + (xcd - r) * q) + off; }
        const int nig = WGM * nN, gid = wgid / nig, fm = gid * WGM, gsz = (nM - fm) < WGM ? (nM - fm) : WGM;
        u.pm = fm + ((wgid % nig) % gsz); u.pn = (wgid % nig) / gsz; return true;
    }
    __device__ __forceinline__ void a_ready(const Unit&) const {}
    __device__ __forceinline__ void done(const Unit&) const {}
};

__device__ __forceinline__ unsigned cvt_pk_bf16(float lo, float hi) { unsigned r; asm volatile("v_cvt_pk_bf16_f32 %0, %1, %2" : "=v"(r) : "v"(lo), "v"(hi)); return r; }

struct EpiBf16 {
    static constexpr bool PERM = true, AFTER_DRAIN = false;
    bf16_t* O; int ldc; int split_col; bf16_t* O2; int ldc2;
    __device__ __forceinline__ void operator()(const f32x4 (&acc)[2][2][4][2], const Unit& u, int wr, int wc, int fr, int fq) const {
        const int row0 = u.pm * BM + wr * 64 + fr; int colt = u.pn * BM; bf16_t* base = O; int ld = ldc;
        if (colt >= split_col) { base = O2; ld = ldc2; colt -= split_col; }
        const int col0 = colt + wc * 32 + 8 * fq;
#pragma unroll
        for (int ai = 0; ai < 2; ++ai)
#pragma unroll
            for (int m = 0; m < 4; ++m) { bf16_t* rowp = base + (size_t)(row0 + ai * HALF + m * 16) * ld + col0;
#pragma unroll
                for (int bj = 0; bj < 2; ++bj) { const f32x4 v0 = acc[ai][bj][m][0], v1 = acc[ai][bj][m][1];
                    u32x4 w; w.x = cvt_pk_bf16(v0[0], v0[1]); w.y = cvt_pk_bf16(v0[2], v0[3]); w.z = cvt_pk_bf16(v1[0], v1[1]); w.w = cvt_pk_bf16(v1[2], v1[3]);
                    *(u32x4*)(rowp + bj * HALF) = w; } }
    }
};
struct EpiBf16SS {
    static constexpr bool PERM = true, AFTER_DRAIN = false;
    bf16_t* O; int ldc; float* part;
    __device__ __forceinline__ void operator()(const f32x4 (&acc)[2][2][4][2], const Unit& u, int wr, int wc, int fr, int fq) const {
        const int row0 = u.pm * BM + wr * 64 + fr; const int col0 = u.pn * BM + wc * 32 + 8 * fq;
#pragma unroll
        for (int ai = 0; ai < 2; ++ai)
#pragma unroll
            for (int m = 0; m < 4; ++m) { const int row = row0 + ai * HALF + m * 16; bf16_t* rowp = O + (size_t)row * ldc + col0; float ss = 0.f;
#pragma unroll
                for (int bj = 0; bj < 2; ++bj) { const f32x4 v0 = acc[ai][bj][m][0], v1 = acc[ai][bj][m][1];
                    ss += (v0[0] * v0[0] + v0[1] * v0[1]) + (v0[2] * v0[2] + v0[3] * v0[3]) + (v1[0] * v1[0] + v1[1] * v1[1]) + (v1[2] * v1[2] + v1[3] * v1[3]);
                    u32x4 w; w.x = cvt_pk_bf16(v0[0], v0[1]); w.y = cvt_pk_bf16(v0[2], v0[3]); w.z = cvt_pk_bf16(v1[0], v1[1]); w.w = cvt_pk_bf16(v1[2], v1[3]);
                    *(u32x4*)(rowp + bj * HALF) = w; }
                ss += __shfl_xor(ss, 16); ss += __shfl_xor(ss, 32);
                if (fq == 0) part[(size_t)row * 64 + u.pn * 4 + wc] = ss; }
    }
};

template <class Epi, class Sched, bool ALIGN_EPI = false, bool SP2 = false>
__device__ __forceinline__ void gemm_phase(PG8_LAS unsigned char* lds, const Gemm g, const Sched& S, const Epi& E) {
    int tid_l = threadIdx.x; asm volatile("" : "+v"(tid_l));
    const int tid = tid_l, wid = __builtin_amdgcn_readfirstlane(tid >> 6), lane = tid & 63, wr = wid >> 2, wc = wid & 3, fr = lane & 15, fq = lane >> 4;
    const int K = g.K, nt = K / BK;
    unsigned voffA[2], voffB[2];
#pragma unroll
    for (int i = 0; i < 2; ++i) { int R, C; stage_rc(tid * 16 + i * 8192, R, C); const int Rb = Epi::PERM ? ((R & ~31) + perm32(R & 31)) : R;
        voffA[i] = (unsigned)(R * K + C) * 2u; voffB[i] = (unsigned)(Rb * K + C) * 2u; }
    const size_t kstep = (size_t)(BK * 2);
    const size_t hstep = (size_t)HALF * K * 2;
    const size_t tstep = 2 * hstep;
    const unsigned ldsw = (unsigned)wid * 1024u;
    const int aoff = lds_byte(wr * 64 + fr, fq * 8), boff = lds_byte(wc * 32 + fr, fq * 8);
#define PG8_SA(b, h) (((b) * 2 + (h)) * HTB)
#define PG8_SB(b, h) ((4 + (b) * 2 + (h)) * HTB)
#define PG8_STAGE(bufoff, gbase, voff) do { _Pragma("unroll") for (int _i = 0; _i < 2; ++_i) \
        __builtin_amdgcn_global_load_lds((const unsigned*)((const char*)(gbase) + (voff)[_i]), (PG8_LAS unsigned*)(lds + (bufoff) + ldsw + _i * 8192), 16, 0, 0); } while (0)
#define PG8_LDA(dst, b, h) do { _Pragma("unroll") for (int m = 0; m < 4; ++m) _Pragma("unroll") for (int k = 0; k < 2; ++k) dst[m][k] = *(const PG8_LAS bf16x8*)(lds + PG8_SA(b, h) + aoff + m * 2048 + k * 1024); } while (0)
#define PG8_LDB(dst, b, h) do { _Pragma("unroll") for (int n = 0; n < 2; ++n) _Pragma("unroll") for (int k = 0; k < 2; ++k) dst[n][k] = *(const PG8_LAS bf16x8*)(lds + PG8_SB(b, h) + boff + n * 2048 + k * 1024); } while (0)
#define PG8_MMA(ai, bj, At, Bt) do { __builtin_amdgcn_s_setprio(1); _Pragma("unroll") for (int m = 0; m < 4; ++m) _Pragma("unroll") for (int n = 0; n < 2; ++n) _Pragma("unroll") for (int k = 0; k < 2; ++k) \
        acc[ai][bj][m][n] = __builtin_amdgcn_mfma_f32_16x16x32_bf16(Bt[n][k], At[m][k], acc[ai][bj][m][n], 0, 0, 0); __builtin_amdgcn_s_setprio(0); } while (0)
#define PG8_WAIT_V(n) asm volatile("s_waitcnt vmcnt(" #n ")" ::: "memory")
#define PG8_WAIT_L(n) asm volatile("s_waitcnt lgkmcnt(" #n ")" ::: "memory")
#define PG8_BAR __builtin_amdgcn_s_barrier()
#define PG8_SCHED __builtin_amdgcn_sched_barrier(0)
    Unit cur, nxt; int ui = 0;
    if (!S.next(0, cur)) return;
    f32x4 acc[2][2][4][2];
#pragma unroll
    for (int a = 0; a < 2; ++a)
#pragma unroll
        for (int b = 0; b < 2; ++b)
#pragma unroll
            for (int m = 0; m < 4; ++m)
#pragma unroll
                for (int n = 0; n < 2; ++n) acc[a][b][m][n] = (f32x4){0.f, 0.f, 0.f, 0.f};
    bf16x8 At[4][2], B0[2][2], B1[2][2];
    const char* cA = (const char*)g.A + (size_t)cur.pm * tstep; const char* cB = (const char*)g.Bt + (size_t)cur.pn * tstep;
    S.a_ready(cur);
    if constexpr (SP2) {
        PG8_STAGE(PG8_SB(0, 0), cB, voffB); PG8_STAGE(PG8_SB(0, 1), cB + hstep, voffB); PG8_STAGE(PG8_SA(0, 0), cA, voffA); PG8_STAGE(PG8_SA(0, 1), cA + hstep, voffA);
        if (wr == 1) PG8_BAR;
        PG8_WAIT_V(2); PG8_BAR;
        PG8_STAGE(PG8_SB(1, 0), cB + kstep, voffB); PG8_STAGE(PG8_SA(1, 0), cA + kstep, voffA); PG8_STAGE(PG8_SB(1, 1), cB + hstep + kstep, voffB);
        PG8_WAIT_V(6); PG8_BAR;
    } else {
        PG8_STAGE(PG8_SB(0, 0), cB, voffB); PG8_STAGE(PG8_SA(0, 0), cA, voffA); PG8_STAGE(PG8_SB(0, 1), cB + hstep, voffB); PG8_STAGE(PG8_SA(0, 1), cA + hstep, voffA);
        if (wr == 1) PG8_BAR;
        PG8_WAIT_V(4); PG8_BAR;
        PG8_STAGE(PG8_SB(1, 0), cB + kstep, voffB); PG8_STAGE(PG8_SA(1, 0), cA + kstep, voffA); PG8_STAGE(PG8_SB(1, 1), cB + hstep + kstep, voffB);
        PG8_WAIT_V(6); PG8_BAR;
    }
    for (;;) {
        const bool has_next = S.next(ui + 1, nxt);
        const char* nA = has_next ? (const char*)g.A + (size_t)nxt.pm * tstep : cA; const char* nB = has_next ? (const char*)g.Bt + (size_t)nxt.pn * tstep : cB;
        for (int t = 0; t < nt; t += 2) {
            const bool last = (t == nt - 2);
            const char* a1 = cA + (size_t)(t + 1) * kstep;
            const char* a2 = last ? nA : cA + (size_t)(t + 2) * kstep; const char* b2 = last ? nB : cB + (size_t)(t + 2) * kstep;
            const char* a3 = a2 + kstep; const char* b3 = b2 + kstep;
            if (last && has_next) S.a_ready(nxt);
            if constexpr (SP2) {
            PG8_LDB(B0, 0, 0); PG8_LDB(B1, 0, 1); PG8_SCHED; PG8_LDA(At, 0, 0); PG8_STAGE(PG8_SA(1, 1), a1 + hstep, voffA);
            PG8_WAIT_V(8); PG8_WAIT_L(0); PG8_BAR; PG8_MMA(0, 0, At, B0); PG8_MMA(0, 1, At, B1); PG8_BAR; PG8_SCHED;
            PG8_LDA(At, 0, 1); PG8_STAGE(PG8_SB(0, 0), b2, voffB); PG8_STAGE(PG8_SB(0, 1), b2 + hstep, voffB); PG8_STAGE(PG8_SA(0, 0), a2, voffA);
            PG8_WAIT_V(8); PG8_WAIT_L(0); PG8_BAR; PG8_MMA(1, 0, At, B0); PG8_MMA(1, 1, At, B1); PG8_BAR; PG8_SCHED;
            PG8_LDB(B0, 1, 0); PG8_LDB(B1, 1, 1); PG8_SCHED; PG8_LDA(At, 1, 0); PG8_STAGE(PG8_SA(0, 1), a2 + hstep, voffA);
            PG8_WAIT_V(8); PG8_WAIT_L(0); PG8_BAR; PG8_MMA(0, 0, At, B0); PG8_MMA(0, 1, At, B1); PG8_BAR; PG8_SCHED;
            PG8_LDA(At, 1, 1); PG8_STAGE(PG8_SB(1, 0), b3, voffB); PG8_STAGE(PG8_SB(1, 1), b3 + hstep, voffB); PG8_STAGE(PG8_SA(1, 0), a3, voffA);
            PG8_WAIT_V(8); PG8_WAIT_L(0); PG8_BAR; PG8_MMA(1, 0, At, B0); PG8_MMA(1, 1, At, B1); PG8_BAR; PG8_SCHED;
            } else {
            PG8_LDB(B0, 0, 0); PG8_SCHED; PG8_LDA(At, 0, 0); PG8_STAGE(PG8_SA(1, 1), a1 + hstep, voffA);
            PG8_WAIT_L(8); PG8_BAR; PG8_WAIT_L(0); PG8_MMA(0, 0, At, B0); PG8_BAR; PG8_SCHED;
            PG8_LDB(B1, 0, 1); PG8_STAGE(PG8_SB(0, 0), b2, voffB);
            PG8_BAR; PG8_WAIT_L(0); PG8_MMA(0, 1, At, B1); PG8_BAR;
            PG8_LDA(At, 0, 1); PG8_STAGE(PG8_SA(0, 0), a2, voffA);
            PG8_BAR; PG8_WAIT_L(0); PG8_MMA(1, 0, At, B0); PG8_BAR; PG8_SCHED;
            PG8_STAGE(PG8_SB(0, 1), b2 + hstep, voffB);
            PG8_WAIT_V(6); PG8_BAR; PG8_MMA(1, 1, At, B1); PG8_BAR;
            PG8_LDB(B0, 1, 0); PG8_SCHED; PG8_LDA(At, 1, 0); PG8_STAGE(PG8_SA(0, 1), a2 + hstep, voffA);
            PG8_WAIT_L(8); PG8_BAR; PG8_WAIT_L(0); PG8_MMA(0, 0, At, B0); PG8_BAR; PG8_SCHED;
            PG8_LDB(B1, 1, 1); PG8_STAGE(PG8_SB(1, 0), b3, voffB);
            PG8_BAR; PG8_WAIT_L(0); PG8_MMA(0, 1, At, B1); PG8_BAR;
            PG8_LDA(At, 1, 1); PG8_STAGE(PG8_SA(1, 0), a3, voffA);
            PG8_BAR; PG8_WAIT_L(0); PG8_MMA(1, 0, At, B0); PG8_BAR; PG8_SCHED;
            PG8_STAGE(PG8_SB(1, 1), b3 + hstep, voffB);
            PG8_WAIT_V(6); PG8_BAR; PG8_MMA(1, 1, At, B1); PG8_BAR;
            }
        }
        if constexpr (ALIGN_EPI) { if (wr == 0) PG8_BAR; }
        if constexpr (!Epi::AFTER_DRAIN) { E(acc, cur, wr, wc, fr, fq); S.done(cur); }
        if (!has_next) break;
#pragma unroll
        for (int a = 0; a < 2; ++a)
#pragma unroll
            for (int b = 0; b < 2; ++b)
#pragma unroll
                for (int m = 0; m < 4; ++m)
#pragma unroll
                    for (int n = 0; n < 2; ++n) acc[a][b][m][n] = (f32x4){0.f, 0.f, 0.f, 0.f};
        cur = nxt; cA = nA; cB = nB; ++ui;
        if constexpr (ALIGN_EPI) { if (wr == 1) PG8_BAR; }
    }
    PG8_WAIT_V(0);
    if constexpr (!ALIGN_EPI) { if (wr == 0) PG8_BAR; }
    PG8_BAR;
    if constexpr (Epi::AFTER_DRAIN) { E.fused(acc, cur, wr, wc, fr, fq, lds, wid, lane); S.done(cur); }
#undef PG8_SA
#undef PG8_SB
#undef PG8_STAGE
#undef PG8_LDA
#undef PG8_LDB
#undef PG8_MMA
#undef PG8_WAIT_V
#undef PG8_WAIT_L
#undef PG8_BAR
#undef PG8_SCHED
}
}
constexpr int BATCH = 2, SEQ = 8192, DM = 4096, M = BATCH * SEQ, DEPTH = 4, N_A = 2;
constexpr int MAINW = 3072, MEMW = 1024, INC = 8192, MIXW = 4096, KVW = 6144;
constexpr int LRU_NB = 12, SB_H = 24, MEM_T = 256, MEM_H = 4;
constexpr float EPS = 1e-6f;
constexpr int NWAVES = 8;
constexpr int LRU_T = 128, LRU_NC = SEQ / LRU_T;

constexpr size_t MiB = 1u << 20;
constexpr size_t WS_CTL = 0, CTL_ZERO_BYTES = 64 * 1024;
constexpr size_t WS_WIN0 = 16 * MiB, WS_WKV = 272 * MiB;
constexpr size_t WS_WOUT = 320 * MiB;
constexpr size_t WS_WMK = 448 * MiB, WS_WMV = 480 * MiB;
constexpr size_t WS_WG = 512 * MiB;
constexpr size_t WS_HB = 520 * MiB;
constexpr size_t WS_MEMB = 648 * MiB;
constexpr size_t WS_MEMK = 652 * MiB;
constexpr size_t WS_MEMVT = 656 * MiB;
constexpr size_t WS_PROJ = 660 * MiB;
constexpr size_t WS_KB = 916 * MiB;
constexpr size_t WS_VT = 1012 * MiB;
constexpr size_t WS_MIX = 1108 * MiB;
constexpr size_t WS_OB = 1236 * MiB;
constexpr size_t WS_PART = 1364 * MiB;
constexpr size_t WS_AGG = 1368 * MiB;
constexpr size_t WS_CARRY = 1371 * MiB;
constexpr size_t WS_END = 1373 * MiB;
constexpr int CW_BAR = 4096;

constexpr int RING_OFF = 0, RING_BYTES = 131072;
constexpr int LDSCTL_OFF = RING_BYTES, MISC_OFF = LDSCTL_OFF + 320;
constexpr int LDS_BYTES = 147456;
constexpr int UT_PITCH = 264;

#define GAS __attribute__((address_space(1)))
#define LAS __attribute__((address_space(3)))
typedef unsigned short bf16;
typedef unsigned v4u __attribute__((ext_vector_type(4)));
typedef unsigned v2u __attribute__((ext_vector_type(2)));
typedef float f32x4 __attribute__((ext_vector_type(4)));
typedef short bf16x8 __attribute__((ext_vector_type(8)));
typedef short bf16x4 __attribute__((ext_vector_type(4)));
typedef float f32x2 __attribute__((ext_vector_type(2)));
typedef GAS unsigned gu32;
#define LDS_WAIT() asm volatile("s_waitcnt lgkmcnt(0)" ::: "memory")
#define VM_WAIT() asm volatile("s_waitcnt vmcnt(0)" ::: "memory")
#define MFMA16(a, b, c) __builtin_amdgcn_mfma_f32_16x16x32_bf16((a), (b), (c), 0, 0, 0)
__device__ __forceinline__ unsigned f2bf(float f) { unsigned u = __builtin_bit_cast(unsigned, f); return (u + 0x7fffu + ((u >> 16) & 1u)) >> 16; }
__device__ __forceinline__ unsigned pk2(float lo, float hi) { return f2bf(lo) | (f2bf(hi) << 16); }
__device__ __forceinline__ float bf2f(unsigned short h) { return __builtin_bit_cast(float, (unsigned)h << 16); }
__device__ __forceinline__ float bflo(unsigned w) { return __builtin_bit_cast(float, w << 16); }
__device__ __forceinline__ float bfhi(unsigned w) { return __builtin_bit_cast(float, w & 0xffff0000u); }
__device__ __forceinline__ float wave_sum(float v) {
#pragma unroll
    for (int o = 1; o < 64; o <<= 1) v += __shfl_xor(v, o);
    return v;
}
__device__ __forceinline__ float fast_exp(float x) { return __builtin_amdgcn_exp2f(x * 1.44269504089f); }
__device__ __forceinline__ float fast_sigmoid(float x) { return __builtin_amdgcn_rcpf(1.0f + fast_exp(-x)); }
__device__ __forceinline__ float silu_f(float x) { return x * fast_sigmoid(x); }
__device__ __forceinline__ float softplus_f(float z) { return fmaxf(z, 0.f) + __builtin_amdgcn_logf(1.0f + fast_exp(-fabsf(z))) * 0.69314718056f; }

#define XB_TMO      128
#define XB_XCNT(j)  (256  + 64 * (j))
#define XB_XSUB(j)  (1280 + 64 * (j))
#define XB_XGEN(j)  (2304 + 64 * (j))
#define XB_TOP      3328
#define XB_TOPGEN   3392
#define XCD_BAR_WORDS 3456
#define XB_SPIN_CAP (1u << 18)
__device__ __forceinline__ unsigned xb_ld(unsigned* p)              { return __hip_atomic_load(p, __ATOMIC_RELAXED, __HIP_MEMORY_SCOPE_AGENT); }
__device__ __forceinline__ unsigned xb_add(unsigned* p, unsigned v) { return __hip_atomic_fetch_add(p, v, __ATOMIC_RELAXED, __HIP_MEMORY_SCOPE_AGENT); }
__device__ __forceinline__ unsigned xb_xcc_id() { return (unsigned)__builtin_amdgcn_s_getreg((3 << 11) | 20) & 0xFu; }
#define XB_SPIN(cond, bar) do { unsigned _sp = 0; while (cond) { __builtin_amdgcn_s_sleep(1); \
    if ((++_sp & 255u) == 0u) { if (xb_ld(&(bar)[XB_TMO])) break; if (_sp > XB_SPIN_CAP) { atomicAdd(&(bar)[XB_TMO], 1u); break; } } } } while (0)
struct XcdBarrier { unsigned* bar; unsigned x; volatile LAS unsigned* st; };
__device__ __forceinline__ XcdBarrier xcd_barrier_post(unsigned* bar, volatile LAS unsigned* st) {
    XcdBarrier b; b.bar = bar; b.x = xb_xcc_id(); b.st = st;
    if (threadIdx.x == 0) (void)xb_add(&bar[XB_XCNT(b.x)], 1u);
    return b;
}
__device__ __forceinline__ void xcd_barrier_complete(unsigned* bar, unsigned x, unsigned& nloc, unsigned& nx) {
    const unsigned G = gridDim.x * gridDim.y * gridDim.z;
    unsigned sum, cnt, mine, sp = 0u;
    for (;;) {
        sum = 0u; cnt = 0u; mine = 0u;
#pragma unroll
        for (unsigned j = 0; j < 16; ++j) { const unsigned c = xb_ld(&bar[XB_XCNT(j)]); sum += c; cnt += (c > 0u) ? 1u : 0u; mine = (j == x) ? c : mine; }
        if (sum == G) break;
        __builtin_amdgcn_s_sleep(1);
        if ((++sp & 255u) == 0u) { if (xb_ld(&bar[XB_TMO])) break; if (sp > XB_SPIN_CAP) { atomicAdd(&bar[XB_TMO], 1u); break; } }
    }
    nloc = mine > 0u ? mine : 1u; nx = cnt > 0u ? cnt : 1u;
}
__device__ __forceinline__ void xcd_barrier(const XcdBarrier& b) {
    asm volatile("s_waitcnt vmcnt(0)" ::: "memory");
    __syncthreads();
    if (threadIdx.x == 0) {
        unsigned* bar = b.bar;
        __builtin_amdgcn_s_waitcnt(0);
        unsigned nloc = b.st[0], nx = b.st[1];
        if (nloc == 0u) { xcd_barrier_complete(bar, b.x, nloc, nx); b.st[0] = nloc; b.st[1] = nx; }
        const unsigned old = xb_add(&bar[XB_XSUB(b.x)], 1u);
        const unsigned gen = old / nloc;
        if (old + 1u == (gen + 1u) * nloc) {
            __builtin_amdgcn_fence(__ATOMIC_RELEASE, "agent");
            asm volatile("s_waitcnt vmcnt(0)" ::: "memory");
            const unsigned og = xb_add(&bar[XB_TOP], 1u);
            const unsigned tg = og / nx;
            if (og + 1u == (tg + 1u) * nx) xb_add(&bar[XB_TOPGEN], 1u);
            else XB_SPIN(xb_ld(&bar[XB_TOPGEN]) == tg, bar);
            __builtin_amdgcn_fence(__ATOMIC_ACQUIRE, "agent");
            xb_add(&bar[XB_XGEN(b.x)], 1u);
            asm volatile("s_waitcnt vmcnt(0)" ::: "memory");
        } else {
            XB_SPIN(xb_ld(&bar[XB_XGEN(b.x)]) == gen, bar);
            __builtin_amdgcn_fence(__ATOMIC_ACQUIRE, "agent");
            asm volatile("s_waitcnt vmcnt(0)" ::: "memory");
        }
    }
    __syncthreads();
}

struct Frame {
    LAS unsigned char* lds;
    int tid, lane, wave, vcu, G;
    float* out;
    unsigned char* ws;
};
#define LAUNDER_S(p) asm volatile("" : "+s"(p))
enum { I_X = 0, I_MEM, I_PRE_GAIN, I_POST_GAIN, I_W_IN, I_W_OUT, I_W_MEM_KV, I_MEM_GAIN, I_CONV_W, I_CONV_B, I_GATE_A_W, I_GATE_A_B, I_GATE_X_W, I_GATE_X_B, I_LAM, I_KV_GAIN, I_W_KV, I_NIN };
constexpr int PTR_OFF = LDSCTL_OFF + 512;
__device__ __forceinline__ const float* inp(const Frame& F, int i) {
    const unsigned long long v = ((const LAS unsigned long long*)(F.lds + PTR_OFF))[i];
    const unsigned lo = __builtin_amdgcn_readfirstlane((unsigned)v), hi = __builtin_amdgcn_readfirstlane((unsigned)(v >> 32));
    return (const float*)(((unsigned long long)hi << 32) | lo);
}
__device__ __forceinline__ bf16* win_ptr(unsigned char* ws, int l) { return (bf16*)(ws + WS_WIN0) + (size_t)l * INC * DM; }

__device__ __forceinline__ void p0_transpose_item(const float* W, int K, int N, bf16* WT, const float* gain, LAS bf16* scr, int kb, int nb, int dst_row0, int lane) {
    const int k0 = 64 * kb, n0 = 64 * nb;
    const int lr = lane >> 4, lc = lane & 15;
    f32x4 v[16];
#pragma unroll
    for (int i = 0; i < 16; ++i) v[i] = __builtin_nontemporal_load((const GAS f32x4*)(W + (size_t)(k0 + 4 * i + lr) * N + n0 + 4 * lc));
    if (gain) {
#pragma unroll
        for (int i = 0; i < 16; ++i) v[i] = v[i] * gain[k0 + 4 * i + lr];
    }
#pragma unroll
    for (int i = 0; i < 16; ++i) { LAS bf16* d = scr + (4 * i + lr) * 66 + 4 * lc;
        *(LAS unsigned*)(d) = pk2(v[i].x, v[i].y); *(LAS unsigned*)(d + 2) = pk2(v[i].z, v[i].w); }
    LDS_WAIT(); asm volatile("" ::: "memory");
    const int kc = lane & 7, nr = lane >> 3;
#pragma unroll
    for (int j = 0; j < 8; ++j) { const LAS bf16* sp = scr + (8 * kc) * 66 + 8 * j + nr;
        v4u o; o.x = (unsigned)sp[0] | ((unsigned)sp[66] << 16); o.y = (unsigned)sp[2 * 66] | ((unsigned)sp[3 * 66] << 16);
        o.z = (unsigned)sp[4 * 66] | ((unsigned)sp[5 * 66] << 16); o.w = (unsigned)sp[6 * 66] | ((unsigned)sp[7 * 66] << 16);
        *(GAS v4u*)(WT + (size_t)(dst_row0 + 8 * j + nr) * K + k0 + 8 * kc) = o; }
    LDS_WAIT(); asm volatile("" ::: "memory");
}
__device__ __forceinline__ void rms_row_to_bf16(const float* xrow, bf16* orow, int lane) {
    const GAS f32x4* xr = (const GAS f32x4*)xrow + lane;
    f32x4 v[16]; float s = 0.f;
#pragma unroll
    for (int j = 0; j < 16; ++j) { v[j] = xr[64 * j]; s += (v[j].x * v[j].x + v[j].y * v[j].y) + (v[j].z * v[j].z + v[j].w * v[j].w); }
    const float rstd = 1.0f / sqrtf(wave_sum(s) * (1.0f / DM) + EPS);
    GAS unsigned long long* o8 = (GAS unsigned long long*)orow + lane;
#pragma unroll
    for (int j = 0; j < 16; ++j) o8[64 * j] = (unsigned long long)pk2(v[j].x * rstd, v[j].y * rstd) | ((unsigned long long)pk2(v[j].z * rstd, v[j].w * rstd) << 32);
}
__device__ __forceinline__ void p0_prologue(Frame& F) {
    const float* const w_in = inp(F, I_W_IN); const float* const pre_gain = inp(F, I_PRE_GAIN); const float* const w_kv = inp(F, I_W_KV); const float* const kv_gain = inp(F, I_KV_GAIN);
    const float* const w_out = inp(F, I_W_OUT); const float* const w_mem_kv = inp(F, I_W_MEM_KV); const float* const mem_gain = inp(F, I_MEM_GAIN);
    const float* const gate_a_w = inp(F, I_GATE_A_W); const float* const gate_x_w = inp(F, I_GATE_X_W); const float* const xin = inp(F, I_X); const float* const mem = inp(F, I_MEM);
    LAS bf16* scr = (LAS bf16*)(F.lds + RING_OFF + F.wave * 16384);
    const int gw = F.vcu * NWAVES + F.wave, NGW = F.G * NWAVES;
    constexpr int I_IN = 4 * 64 * 128, I_KV = 64 * 96, I_OUT = 4 * 64 * 64, I_MKV = 4 * 64 * 32, I_G = 48 * 16;
    constexpr int NITEMS = I_IN + I_KV + I_OUT + I_MKV + I_G;
    for (int it = gw; it < NITEMS; it += NGW) {
        int r = it;
        if (r < I_IN) { const int l = r / 8192, rr = r % 8192, kb = rr / 128, nb = rr % 128;
            p0_transpose_item(w_in + (size_t)l * DM * INC, DM, INC, win_ptr(F.ws, l), pre_gain + l * DM, scr, kb, nb, 64 * nb, F.lane); continue; } r -= I_IN;
        if (r < I_KV) { const int kb = r / 96, nb = r % 96;
            p0_transpose_item(w_kv, DM, KVW, (bf16*)(F.ws + WS_WKV), kv_gain, scr, kb, nb, 64 * nb, F.lane); continue; } r -= I_KV;
        if (r < I_OUT) { const int l = r / 4096, rr = r % 4096, kb = rr / 64, nb = rr % 64;
            p0_transpose_item(w_out + (size_t)l * MIXW * DM, MIXW, DM, (bf16*)(F.ws + WS_WOUT) + (size_t)l * DM * MIXW, nullptr, scr, kb, nb, 64 * nb, F.lane); continue; } r -= I_OUT;
        if (r < I_MKV) { const int l = r / 2048, rr = r % 2048, kb = rr / 32, nb = rr % 32; const int n0 = 64 * nb;
            bf16* dst = (bf16*)(F.ws + (n0 < MEMW ? WS_WMK : WS_WMV)); const int row0 = l * MEMW + (n0 < MEMW ? n0 : n0 - MEMW);
            p0_transpose_item(w_mem_kv + (size_t)l * DM * 2 * MEMW, DM, 2 * MEMW, dst, mem_gain, scr, kb, nb, row0, F.lane); continue; } r -= I_MKV;
        { const int mat = r / 16, rr = r % 16, kb = rr / 4, nb = rr % 4; const int ln = mat / 2, ga = mat % 2;
            p0_transpose_item((ga ? gate_x_w : gate_a_w) + (size_t)ln * 65536, 256, 256, (bf16*)(F.ws + WS_WG) + (size_t)ln * 512 * 256, nullptr, scr, kb, nb, ga * 256 + 64 * nb, F.lane); }
    }
    for (int m = gw; m < M; m += NGW) rms_row_to_bf16(xin + (size_t)m * DM, (bf16*)(F.ws + WS_HB) + (size_t)m * DM, F.lane);
    for (int m = gw; m < BATCH * MEM_T; m += NGW) rms_row_to_bf16(mem + (size_t)m * DM, (bf16*)(F.ws + WS_MEMB) + (size_t)m * DM, F.lane);
}

__device__ __forceinline__ void nr_phase(Frame& F, int layer) {
    const int gw = F.vcu * NWAVES + F.wave, NGW = F.G * NWAVES, lane = F.lane;
    const float* hsrc = layer == 0 ? inp(F, I_X) : F.out;
    const bf16* ob = (const bf16*)(F.ws + WS_OB); const float* part = (const float*)(F.ws + WS_PART); bf16* hb = (bf16*)(F.ws + WS_HB);
    const GAS f32x4* pg = (const GAS f32x4*)(inp(F, I_POST_GAIN) + layer * DM) + lane;
    for (int m = gw; m < M; m += NGW) {
        const float sso = wave_sum(part[(size_t)m * 64 + lane]);
        const float rs = 1.0f / sqrtf(sso * (1.0f / DM) + EPS);
        const GAS f32x4* hr = (const GAS f32x4*)(hsrc + (size_t)m * DM) + lane;
        const GAS v2u* orow = (const GAS v2u*)(ob + (size_t)m * DM) + lane;
        GAS f32x4* outr = (GAS f32x4*)(F.out + (size_t)m * DM) + lane;
        f32x4 v[16]; float s = 0.f;
#pragma unroll
        for (int j = 0; j < 16; ++j) { const f32x4 h = hr[64 * j]; const v2u o = orow[64 * j]; const f32x4 g = pg[64 * j];
            f32x4 r; r.x = h.x + bflo(o.x) * rs * g.x; r.y = h.y + bfhi(o.x) * rs * g.y; r.z = h.z + bflo(o.y) * rs * g.z; r.w = h.w + bfhi(o.y) * rs * g.w;
            v[j] = r; outr[64 * j] = r; s += (r.x * r.x + r.y * r.y) + (r.z * r.z + r.w * r.w); }
        if (layer < DEPTH - 1) {
            const float rstd = 1.0f / sqrtf(wave_sum(s) * (1.0f / DM) + EPS);
            GAS unsigned long long* o8 = (GAS unsigned long long*)(hb + (size_t)m * DM) + lane;
#pragma unroll
            for (int j = 0; j < 16; ++j) o8[64 * j] = (unsigned long long)pk2(v[j].x * rstd, v[j].y * rstd) | ((unsigned long long)pk2(v[j].z * rstd, v[j].w * rstd) << 32);
        }
    }
}

__device__ __forceinline__ bf16x8 pack8(float a0, float a1, float a2, float a3, float a4, float a5, float a6, float a7) {
    v4u p; p.x = pk2(a0, a1); p.y = pk2(a2, a3); p.z = pk2(a4, a5); p.w = pk2(a6, a7); return __builtin_bit_cast(bf16x8, p);
}
__device__ __forceinline__ void glds16(const bf16* g, LAS unsigned char* l) { __builtin_amdgcn_global_load_lds((const unsigned*)g, (LAS unsigned*)l, 16, 0, 0); }
#define WG_BAR() do { asm volatile("s_waitcnt vmcnt(0) lgkmcnt(0)" ::: "memory"); __builtin_amdgcn_s_barrier(); asm volatile("" ::: "memory"); } while (0)

__device__ __forceinline__ void sb_attn_wg(Frame& F, int b, int hd, int qb) {
    const int tid = F.tid, lane = F.lane, wave = F.wave, c = lane & 15, g = lane >> 4;
    LAS unsigned char* const lds = F.lds + RING_OFF;
    const bf16* const proj = (const bf16*)(F.ws + WS_PROJ); const bf16* const KBp = (const bf16*)(F.ws + WS_KB); const bf16* const VTp = (const bf16*)(F.ws + WS_VT); bf16* const mix = (bf16*)(F.ws + WS_MIX);
    const int t0 = qb * 128, tw = t0 + 16 * wave, tq = tw + c;
    const size_t mrow = (size_t)b * SEQ;
    const float scale = 0.08838834764831845f;
    int R0, C0, R1, C1; pg8::stage_rc(tid * 16, R0, C0); pg8::stage_rc(tid * 16 + 8192, R1, C1);
    const bf16* const ksrc = KBp + (mrow + R0) * MAINW + hd * 128 + C0;
    const bf16* const vsrc0 = VTp + (size_t)(hd * 128 + R0) * M + mrow + C0;
    const bf16* const vsrc1 = VTp + (size_t)(hd * 128 + R1) * M + mrow + C1;
    const unsigned ldsw = (unsigned)wave * 1024u;
#define SB_STAGE(s, kt) do { LAS unsigned char* d_ = lds + (s) * 32768 + ldsw; glds16(ksrc + (size_t)(kt) * MAINW, d_); glds16(ksrc + (size_t)(kt) * MAINW + 64, d_ + 8192); \
        glds16(vsrc0 + (kt), d_ + 16384); glds16(vsrc1 + (kt), d_ + 24576); } while (0)
    volatile LAS unsigned* const flg = (volatile LAS unsigned*)(lds + 65536);
    bf16x8 qf[4];
    { const bf16* qp = proj + (mrow + tq) * INC + hd * 128 + 8 * g;
#pragma unroll
      for (int kk = 0; kk < 4; ++kk) qf[kk] = *(const GAS bf16x8*)(qp + 32 * kk); }
    f32x4 ot[8];
#pragma unroll
    for (int md = 0; md < 8; ++md) ot[md] = (f32x4){0.f, 0.f, 0.f, 0.f};
    float R = 0.f;
    bool done = false;
    const int krow = 8 * (c >> 2) + (c & 3);
    int kt = t0 + 64, s = 0;
    SB_STAGE(0, kt);
    for (int j = 0; ; ++j) {
        WG_BAR();
        if (j > 0) { unsigned nd = 0;
#pragma unroll
            for (int w = 0; w < 8; ++w) nd += flg[(j & 1) * 8 + w];
            if (nd == 8u) break; }
        if (kt < 0) break;
        const int ktn = kt - 64;
        if (ktn >= 0) SB_STAGE(s ^ 1, ktn);
        if (!done && kt < tw + 15) {
            LAS unsigned char* const kb_ = lds + s * 32768; LAS unsigned char* const vb_ = kb_ + 16384;
            f32x4 zt[4];
#pragma unroll
            for (int f = 0; f < 4; ++f) { const int row = 32 * (f >> 1) + 4 * (f & 1) + krow;
                f32x4 acc = (f32x4){0.f, 0.f, 0.f, 0.f};
#pragma unroll
                for (int kk = 0; kk < 4; ++kk) { const bf16x8 kf = *(const LAS bf16x8*)(kb_ + (kk >> 1) * 8192 + pg8::lds_byte(row, 32 * (kk & 1) + 8 * g)); acc = MFMA16(kf, qf[kk], acc); }
                zt[f] = acc; }
            float lb[2][8], sfx[2][8], Sp[2];
#pragma unroll
            for (int p = 0; p < 2; ++p) {
                float x[8];
#pragma unroll
                for (int jj = 0; jj < 8; ++jj) { const int key = kt + 32 * p + 8 * g + jj; const bool valid = key < tq;
                    const float z = zt[2 * p + (jj >> 2)][jj & 3] * scale; const float l1m = valid ? -softplus_f(z) : 0.f;
                    x[jj] = l1m; lb[p][jj] = valid ? (z + l1m) : -1.0e30f; }
                sfx[p][7] = 0.f;
#pragma unroll
                for (int jj = 6; jj >= 0; --jj) sfx[p][jj] = sfx[p][jj + 1] + x[jj + 1];
                Sp[p] = sfx[p][0] + x[0];
            }
            float Facc = 0.f; float w[2][8];
#pragma unroll
            for (int p = 1; p >= 0; --p) {
                float v = Sp[p];
                float t = __shfl_down(v, 16); if (g < 3) v += t;
                t = __shfl_down(v, 32); if (g < 2) v += t;
                const float G = v - Sp[p];
                const float Tp = __shfl(v, c);
                const float base = R + Facc + G;
#pragma unroll
                for (int jj = 0; jj < 8; ++jj) w[p][jj] = fast_exp(lb[p][jj] + base + sfx[p][jj]);
                Facc += Tp;
            }
            R += Facc;
#pragma unroll
            for (int p = 0; p < 2; ++p) {
                const bf16x8 wf = pack8(w[p][0], w[p][1], w[p][2], w[p][3], w[p][4], w[p][5], w[p][6], w[p][7]);
#pragma unroll
                for (int md = 0; md < 8; ++md) { const bf16x8 vf = *(const LAS bf16x8*)(vb_ + pg8::lds_byte(16 * md + c, 32 * p + 8 * g)); ot[md] = MFMA16(vf, wf, ot[md]); }
            }
            if (__all(R < -104.0f)) done = true;
        }
        if (lane == 0) flg[((j + 1) & 1) * 8 + wave] = done ? 1u : 0u;
        kt = ktn; s ^= 1;
    }
#undef SB_STAGE
    const size_t row = mrow + tq;
#pragma unroll
    for (int md = 0; md < 8; ++md) { const int d0 = hd * 128 + 16 * md + 4 * g;
        const v2u gt = *(const GAS v2u*)(proj + row * INC + MAINW + d0);
        v2u o; o.x = pk2(ot[md][0] * silu_f(bflo(gt.x)), ot[md][1] * silu_f(bfhi(gt.x))); o.y = pk2(ot[md][2] * silu_f(bflo(gt.y)), ot[md][3] * silu_f(bfhi(gt.y)));
        *(GAS v2u*)(mix + row * MIXW + d0) = o; }
    WG_BAR();
}

__device__ __forceinline__ void mem_attn_wg(Frame& F, int layer, int b, int mh, int qb) {
    const int tid = F.tid, lane = F.lane, wave = F.wave, c = lane & 15, g = lane >> 4;
    LAS unsigned char* const lds = F.lds + RING_OFF;
    const bf16* const proj = (const bf16*)(F.ws + WS_PROJ); const bf16* const memk = (const bf16*)(F.ws + WS_MEMK); const bf16* const memvt = (const bf16*)(F.ws + WS_MEMVT); bf16* const mix = (bf16*)(F.ws + WS_MIX);
    const size_t row = (size_t)b * SEQ + qb * 128 + 16 * wave + c;
    const int fbase = layer * MEMW + mh * 256;
    const unsigned ldsw = (unsigned)wave * 1024u;
    int Rr[2], Cc[2]; pg8::stage_rc(tid * 16, Rr[0], Cc[0]); pg8::stage_rc(tid * 16 + 8192, Rr[1], Cc[1]);
#pragma unroll
    for (int kh = 0; kh < 2; ++kh)
#pragma unroll
        for (int dq = 0; dq < 4; ++dq)
#pragma unroll
            for (int i = 0; i < 2; ++i) glds16(memk + (size_t)(b * MEM_T + 128 * kh + Rr[i]) * (DEPTH * MEMW) + fbase + 64 * dq + Cc[i], lds + kh * 65536 + dq * 16384 + i * 8192 + ldsw);
    bf16x8 qf[8];
    { const bf16* qp = proj + row * INC + 2 * MAINW + mh * 256 + 8 * g;
#pragma unroll
      for (int kk = 0; kk < 8; ++kk) qf[kk] = *(const GAS bf16x8*)(qp + 32 * kk); }
    WG_BAR();
    f32x4 st[16];
    const int krow = 8 * (c >> 2) + (c & 3);
#pragma unroll
    for (int fg = 0; fg < 16; ++fg) { const int kh = fg >> 3, f = fg & 7; const int rowk = 32 * (f >> 1) + 4 * (f & 1) + krow;
        f32x4 acc = (f32x4){0.f, 0.f, 0.f, 0.f};
#pragma unroll
        for (int kk = 0; kk < 8; ++kk) { const bf16x8 kf = *(const LAS bf16x8*)(lds + kh * 65536 + (kk >> 1) * 16384 + pg8::lds_byte(rowk, 32 * (kk & 1) + 8 * g)); acc = MFMA16(kf, qf[kk], acc); }
        st[fg] = acc; }
    float mx = -3.0e38f;
#pragma unroll
    for (int f = 0; f < 16; ++f)
#pragma unroll
        for (int r = 0; r < 4; ++r) mx = fmaxf(mx, st[f][r]);
    mx = fmaxf(mx, __shfl_xor(mx, 16)); mx = fmaxf(mx, __shfl_xor(mx, 32));
    float den = 0.f;
#pragma unroll
    for (int f = 0; f < 16; ++f)
#pragma unroll
        for (int r = 0; r < 4; ++r) { const float p = fast_exp((st[f][r] - mx) * 0.0625f); st[f][r] = p; den += p; }
    den += __shfl_xor(den, 16); den += __shfl_xor(den, 32);
    const float inv = 1.0f / den;
    bf16x8 pf[8];
#pragma unroll
    for (int pg = 0; pg < 8; ++pg) { const int fa = 8 * (pg >> 2) + 2 * (pg & 3); pf[pg] = pack8(st[fa][0], st[fa][1], st[fa][2], st[fa][3], st[fa + 1][0], st[fa + 1][1], st[fa + 1][2], st[fa + 1][3]); }
    WG_BAR();
#pragma unroll
    for (int kh = 0; kh < 2; ++kh)
#pragma unroll
        for (int dh = 0; dh < 2; ++dh)
#pragma unroll
            for (int kq = 0; kq < 2; ++kq)
#pragma unroll
                for (int i = 0; i < 2; ++i) glds16(memvt + (size_t)(fbase + 128 * dh + Rr[i]) * (BATCH * MEM_T) + b * MEM_T + 128 * kh + 64 * kq + Cc[i], lds + kh * 65536 + (dh * 2 + kq) * 16384 + i * 8192 + ldsw);
    WG_BAR();
#pragma unroll
    for (int half = 0; half < 2; ++half) {
        f32x4 ot[8];
#pragma unroll
        for (int md = 0; md < 8; ++md) ot[md] = (f32x4){0.f, 0.f, 0.f, 0.f};
#pragma unroll
        for (int pg = 0; pg < 8; ++pg) { const int kh = pg >> 2, p = pg & 3;
#pragma unroll
            for (int md = 0; md < 8; ++md) { const bf16x8 vf = *(const LAS bf16x8*)(lds + kh * 65536 + (half * 2 + (p >> 1)) * 16384 + pg8::lds_byte(16 * md + c, 32 * (p & 1) + 8 * g)); ot[md] = MFMA16(vf, pf[pg], ot[md]); } }
#pragma unroll
        for (int md = 0; md < 8; ++md) { const int d0 = mh * 256 + 128 * half + 16 * md + 4 * g;
            const v2u gt = *(const GAS v2u*)(proj + row * INC + 2 * MAINW + MEMW + d0);
            v2u o; o.x = pk2(ot[md][0] * inv * silu_f(bflo(gt.x)), ot[md][1] * inv * silu_f(bfhi(gt.x))); o.y = pk2(ot[md][2] * inv * silu_f(bflo(gt.y)), ot[md][3] * inv * silu_f(bfhi(gt.y)));
            *(GAS v2u*)(mix + row * MIXW + MAINW + d0) = o; }
    }
    WG_BAR();
}

__device__ __forceinline__ void lru_carry_phase(Frame& F) {
    const int gw = F.vcu * NWAVES + F.wave, NGW = F.G * NWAVES;
    const float* agg = (const float*)(F.ws + WS_AGG); float* carry = (float*)(F.ws + WS_CARRY);
    for (int u = gw; u < BATCH * (MAINW / 64); u += NGW) {
        const int b = u / (MAINW / 64), chn = (u % (MAINW / 64)) * 64 + F.lane;
        float hc = 0.f;
#pragma unroll 1
        for (int c0 = 0; c0 < LRU_NC; c0 += 16) {
            f32x2 ag[16];
#pragma unroll
            for (int i = 0; i < 16; ++i) ag[i] = *(const GAS f32x2*)(agg + ((size_t)(b * LRU_NC + c0 + i) * MAINW + chn) * 2);
#pragma unroll
            for (int i = 0; i < 16; ++i) { *(GAS float*)(carry + (size_t)(b * LRU_NC + c0 + i) * MAINW + chn) = hc; hc = ag[i].x * hc + ag[i].y; }
        }
    }
}

template <bool FINAL>
__device__ __forceinline__ void lru_unit(Frame& F, int layer, int b, int n, int ch) {
    const int tid = F.tid, lane = F.lane, wave = F.wave, c = lane & 15, g = lane >> 4;
    const bf16* proj = (const bf16*)(F.ws + WS_PROJ);
    const float* const conv_w = inp(F, I_CONV_W); const float* const conv_b = inp(F, I_CONV_B);
    LAS bf16* ut = (LAS bf16*)(F.lds + RING_OFF);
    const int t0 = ch * LRU_T; const size_t mrow = (size_t)b * SEQ;
    {
        const int cg = tid & 31, rg = tid >> 5;
        const int col = 256 * n + 8 * cg;
        float cw[4][8], cb[8];
#pragma unroll
        for (int k = 0; k < 4; ++k) { const f32x4 a = *(const GAS f32x4*)(conv_w + ((size_t)layer * 4 + k) * MAINW + col), bb = *(const GAS f32x4*)(conv_w + ((size_t)layer * 4 + k) * MAINW + col + 4);
            cw[k][0] = a.x; cw[k][1] = a.y; cw[k][2] = a.z; cw[k][3] = a.w; cw[k][4] = bb.x; cw[k][5] = bb.y; cw[k][6] = bb.z; cw[k][7] = bb.w; }
        { const f32x4 a = *(const GAS f32x4*)(conv_b + (size_t)layer * MAINW + col), bb = *(const GAS f32x4*)(conv_b + (size_t)layer * MAINW + col + 4);
            cb[0] = a.x; cb[1] = a.y; cb[2] = a.z; cb[3] = a.w; cb[4] = bb.x; cb[5] = bb.y; cb[6] = bb.z; cb[7] = bb.w; }
        float xr[11][8];
#pragma unroll
        for (int i = 0; i < 11; ++i) { const int t = t0 + rg * 8 - 3 + i;
            v4u raw = (v4u){0u, 0u, 0u, 0u};
            if (t >= 0) raw = *(const GAS v4u*)(proj + (mrow + t) * INC + col);
            xr[i][0] = bflo(raw.x); xr[i][1] = bfhi(raw.x); xr[i][2] = bflo(raw.y); xr[i][3] = bfhi(raw.y); xr[i][4] = bflo(raw.z); xr[i][5] = bfhi(raw.z); xr[i][6] = bflo(raw.w); xr[i][7] = bfhi(raw.w); }
#pragma unroll
        for (int tt = 0; tt < 8; ++tt) { float u[8];
#pragma unroll
            for (int e = 0; e < 8; ++e) u[e] = cb[e] + cw[0][e] * xr[tt][e] + cw[1][e] * xr[tt + 1][e] + cw[2][e] * xr[tt + 2][e] + cw[3][e] * xr[tt + 3][e];
            v4u o; o.x = pk2(u[0], u[1]); o.y = pk2(u[2], u[3]); o.z = pk2(u[4], u[5]); o.w = pk2(u[6], u[7]);
            *(LAS v4u*)(ut + (rg * 8 + tt) * UT_PITCH + 8 * cg) = o; }
    }
    __syncthreads();
    float* agg = (float*)(F.ws + WS_AGG);
    const bf16* wg = (const bf16*)(F.ws + WS_WG) + (size_t)(layer * LRU_NB + n) * 512 * 256;
#pragma unroll 1
    for (int nf = 0; nf < 2; ++nf) {
        const int chl = 32 * wave + 16 * nf + c;
        const int chn = 256 * n + chl;
        const bf16* const gbase = proj + (mrow + t0) * INC + MAINW + 256 * n;
        bf16* const obase = (bf16*)(F.ws + WS_MIX) + (mrow + t0) * MIXW + 256 * n;
        const int goff = (4 * g) * INC + chl, ooff = (4 * g) * MIXW + chl;
        unsigned short gtv[8][4];
        if (FINAL) {
#pragma unroll
            for (int mf = 0; mf < 8; ++mf)
#pragma unroll
                for (int r = 0; r < 4; ++r) gtv[mf][r] = *(const GAS bf16*)(gbase + (16 * mf + r) * INC + goff);
        }
        f32x4 acc[8][2];
#pragma unroll
        for (int mf = 0; mf < 8; ++mf) { acc[mf][0] = (f32x4){0.f, 0.f, 0.f, 0.f}; acc[mf][1] = (f32x4){0.f, 0.f, 0.f, 0.f}; }
        bf16x8 bfr[8][2];
#pragma unroll
        for (int kk = 0; kk < 8; ++kk)
#pragma unroll
            for (int ga = 0; ga < 2; ++ga) bfr[kk][ga] = *(const GAS bf16x8*)(wg + (size_t)(ga * 256 + chl) * 256 + 32 * kk + 8 * g);
#pragma unroll
        for (int kk = 0; kk < 8; ++kk) {
            bf16x8 afr[8];
#pragma unroll
            for (int mf = 0; mf < 8; ++mf) afr[mf] = *(const LAS bf16x8*)(ut + (16 * mf + c) * UT_PITCH + 32 * kk + 8 * g);
#pragma unroll
            for (int mf = 0; mf < 8; ++mf) { acc[mf][0] = MFMA16(afr[mf], bfr[kk][0], acc[mf][0]); acc[mf][1] = MFMA16(afr[mf], bfr[kk][1], acc[mf][1]); }
            asm volatile("" ::: "memory");
        }
        {
            const float ba = inp(F, I_GATE_A_B)[(size_t)layer * MAINW + chn], bx = inp(F, I_GATE_X_B)[(size_t)layer * MAINW + chn];
            const float c8 = -8.0f * softplus_f(-inp(F, I_LAM)[(size_t)layer * MAINW + chn]);
#pragma unroll
            for (int mf = 0; mf < 8; ++mf)
#pragma unroll
                for (int r = 0; r < 4; ++r) {
                    const float rr = fast_sigmoid(acc[mf][0][r] + ba), ii = fast_sigmoid(acc[mf][1][r] + bx);
                    const float a = fast_exp(c8 * rr);
                    const float uval = bf2f(ut[(16 * mf + 4 * g + r) * UT_PITCH + chl]);
                    const float om = fmaxf(1.0f - a * a, 0.f);
                    acc[mf][0][r] = a; acc[mf][1][r] = sqrtf(om) * (ii * uval);
                }
        }
        float hc = 0.f;
        float PT = 1.f;
        if (FINAL) {
            hc = *(const GAS float*)((const float*)(F.ws + WS_CARRY) + (size_t)(b * LRU_NC + ch) * MAINW + chn);
        }
#pragma unroll
        for (int mf = 0; mf < 8; ++mf) {
            float A = 1.f, B = 0.f;
#pragma unroll
            for (int r = 0; r < 4; ++r) { const float a = acc[mf][0][r]; A *= a; B = a * B + acc[mf][1][r]; }
            float Ai = A, Bi = B;
            { const float Ap = __shfl_up(Ai, 16), Bp = __shfl_up(Bi, 16); if (g >= 1) { Bi = Ai * Bp + Bi; Ai = Ap * Ai; } }
            { const float Ap = __shfl_up(Ai, 32), Bp = __shfl_up(Bi, 32); if (g >= 2) { Bi = Ai * Bp + Bi; Ai = Ap * Ai; } }
            const float Af = __shfl(Ai, 48 + c), Bf = __shfl(Bi, 48 + c);
            if (FINAL) {
                float Ae = __shfl_up(Ai, 16), Be = __shfl_up(Bi, 16); if (g == 0) { Ae = 1.f; Be = 0.f; }
                float h = Ae * hc + Be;
#pragma unroll
                for (int r = 0; r < 4; ++r) { h = acc[mf][0][r] * h + acc[mf][1][r];
                    const float gt = bf2f(gtv[mf][r]);
                    *(GAS bf16*)(obase + (16 * mf + r) * MIXW + ooff) = (bf16)f2bf(h * silu_f(gt)); }
                hc = Af * hc + Bf;
            } else { hc = Af * hc + Bf; PT *= Af; }
        }
        if (!FINAL && g == 0) { f32x2 o; o.x = PT; o.y = hc; *(GAS f32x2*)(agg + ((size_t)(b * LRU_NC + ch) * MAINW + chn) * 2) = o; }
    }
    __syncthreads();
}

#ifndef PROBE_MASK
#define PROBE_MASK 0
#endif
#ifndef MK_ONE_LAUNCH
#define MK_ONE_LAUNCH 1
#endif
constexpr int NPHASES = 2 + 6 * DEPTH;
struct Args { const float* in[17]; float* out; unsigned char* ws; int ph_lo, ph_hi; };
__global__ void __launch_bounds__(NWAVES * 64, 2) yoco_fwd(Args args) {
    extern __shared__ __attribute__((aligned(16))) unsigned char lds[];
    Frame F;
    F.lds = (LAS unsigned char*)lds;
    volatile LAS unsigned* MISC = (volatile LAS unsigned*)(F.lds + MISC_OFF);
    F.tid = threadIdx.x; F.lane = F.tid & 63; F.wave = __builtin_amdgcn_readfirstlane(F.tid >> 6);
    F.G = gridDim.x; { const int bx = blockIdx.x; F.vcu = (F.G % 8 == 0) ? (bx % 8) * (F.G / 8) + bx / 8 : bx; }
    F.out = args.out; F.ws = args.ws;
    unsigned* ctl = (unsigned*)(F.ws + WS_CTL);
    for (int u = F.tid; u < (LDS_BYTES - LDSCTL_OFF) / 4; u += NWAVES * 64) ((LAS unsigned*)(F.lds + LDSCTL_OFF))[u] = 0u;
    __syncthreads();
    if (F.tid < I_NIN) ((LAS unsigned long long*)(F.lds + PTR_OFF))[F.tid] = (unsigned long long)args.in[F.tid];
    __syncthreads();
    const int lo = args.ph_lo, hi = args.ph_hi;
    XcdBarrier bar; bar.bar = ctl + CW_BAR; bar.x = 0; bar.st = nullptr;
    if (hi - lo > 1) bar = xcd_barrier_post(ctl + CW_BAR, MISC + 8);
#define IN(k) (lo <= (k) && (k) < hi)
#define SEAM(k) do { if (IN(k) && IN((k) + 1)) xcd_barrier(bar); } while (0)

#define PHASE_PTRS() Frame P = F; P.ws = args.ws; LAUNDER_S(P.ws); P.out = args.out; LAUNDER_S(P.out); \
    { int t_ = threadIdx.x; asm volatile("" : "+v"(t_)); P.tid = t_; P.lane = t_ & 63; P.wave = __builtin_amdgcn_readfirstlane(t_ >> 6); } \
    const int gw = P.vcu * NWAVES + P.wave, NGW = P.G * NWAVES; (void)gw; (void)NGW; \
    bf16* const HB = (bf16*)(P.ws + WS_HB); bf16* const PROJ = (bf16*)(P.ws + WS_PROJ); bf16* const KB = (bf16*)(P.ws + WS_KB); bf16* const VT = (bf16*)(P.ws + WS_VT); \
    bf16* const MIX = (bf16*)(P.ws + WS_MIX); bf16* const OB = (bf16*)(P.ws + WS_OB); bf16* const MEMB = (bf16*)(P.ws + WS_MEMB); bf16* const MEMK = (bf16*)(P.ws + WS_MEMK); bf16* const MEMVT = (bf16*)(P.ws + WS_MEMVT); \
    (void)HB; (void)PROJ; (void)KB; (void)VT; (void)MIX; (void)OB; (void)MEMB; (void)MEMK; (void)MEMVT;

    if (IN(0)) { PHASE_PTRS();
#ifndef DIS_P0
 p0_prologue(P);
#endif
 }
    SEAM(0);
    if (IN(1)) { PHASE_PTRS();
#ifndef DIS_GMEM
        { pg8::Gemm g{MEMB, (const bf16*)(P.ws + WS_WMK), BATCH * MEM_T, DEPTH * MEMW, DM}; pg8::StaticOrder S; S.init(BATCH * MEM_T, DEPTH * MEMW, F.G, (int)blockIdx.x);
          pg8::EpiBf16 E{MEMK, DEPTH * MEMW, 1 << 30, nullptr, 0};
          pg8::gemm_phase<pg8::EpiBf16, pg8::StaticOrder, true, true>(F.lds + RING_OFF, g, S, E); }
        { pg8::Gemm g{(const bf16*)(P.ws + WS_WMV), MEMB, DEPTH * MEMW, BATCH * MEM_T, DM}; pg8::StaticOrder S; S.init(DEPTH * MEMW, BATCH * MEM_T, F.G, (int)((blockIdx.x + F.G / 2) % F.G));
          pg8::EpiBf16 E{MEMVT, BATCH * MEM_T, 1 << 30, nullptr, 0};
          pg8::gemm_phase<pg8::EpiBf16, pg8::StaticOrder, true, true>(F.lds + RING_OFF, g, S, E); }
#endif
    }
    SEAM(1);
    { constexpr int l = 0;
        const int pb = 2 + 6 * l;
        if (IN(pb)) { PHASE_PTRS();
            { pg8::Gemm g{HB, win_ptr(P.ws, l), M, INC, DM}; pg8::StaticOrder S; S.init(M, INC, F.G, (int)blockIdx.x);
              pg8::EpiBf16 E{PROJ, INC, 1 << 30, nullptr, 0};
              pg8::gemm_phase<pg8::EpiBf16, pg8::StaticOrder, true, true>(F.lds + RING_OFF, g, S, E); }
#ifndef DIS_GVT
            if (l == N_A) {
              { pg8::Gemm g{HB, (const bf16*)(P.ws + WS_WKV), M, MAINW, DM}; pg8::StaticOrder S; S.init(M, MAINW, F.G, (int)blockIdx.x);
                pg8::EpiBf16 E{KB, MAINW, 1 << 30, nullptr, 0};
                pg8::gemm_phase<pg8::EpiBf16, pg8::StaticOrder, true, true>(F.lds + RING_OFF, g, S, E); }
              { pg8::Gemm g{(const bf16*)(P.ws + WS_WKV) + (size_t)MAINW * DM, HB, MAINW, M, DM}; pg8::StaticOrder S; S.init(MAINW, M, F.G, (int)blockIdx.x);
                pg8::EpiBf16 E{VT, M, 1 << 30, nullptr, 0};
                pg8::gemm_phase<pg8::EpiBf16, pg8::StaticOrder, true, true>(F.lds + RING_OFF, g, S, E); }
            }
#endif
        }
        SEAM(pb);
        if (IN(pb + 1)) { PHASE_PTRS();
#ifndef DIS_LRU
            if (l < N_A) { for (int u = P.vcu; u < BATCH * LRU_NB * LRU_NC; u += P.G) lru_unit<false>(P, l, u / (LRU_NB * LRU_NC), (u / LRU_NC) % LRU_NB, u % LRU_NC); }
#endif
#ifndef DIS_SB
            if (l >= N_A) { for (int u = P.vcu; u < BATCH * SB_H * (SEQ / 128); u += P.G) sb_attn_wg(P, u / (SB_H * (SEQ / 128)), (u / (SEQ / 128)) % SB_H, u % (SEQ / 128)); }
#endif
#ifndef DIS_MEM
            for (int u = P.vcu; u < BATCH * MEM_H * (SEQ / 128); u += P.G) mem_attn_wg(P, l, u / (MEM_H * (SEQ / 128)), (u / (SEQ / 128)) % MEM_H, u % (SEQ / 128));
#endif
        }
        SEAM(pb + 1);
        if (l < N_A) { if (IN(pb + 2)) { PHASE_PTRS(); lru_carry_phase(P); } SEAM(pb + 2); }
        if (IN(pb + 3)) { PHASE_PTRS();
#ifndef DIS_LRU
            if (l < N_A) { for (int u = P.vcu; u < BATCH * LRU_NB * LRU_NC; u += P.G) lru_unit<true>(P, l, u / (LRU_NB * LRU_NC), (u / LRU_NC) % LRU_NB, u % LRU_NC); }
#endif
        }
        if (l < N_A) SEAM(pb + 3);
        if (IN(pb + 4)) { PHASE_PTRS();
#ifndef DIS_G2
            pg8::Gemm g{MIX, (const bf16*)(P.ws + WS_WOUT) + (size_t)l * DM * MIXW, M, DM, MIXW}; pg8::StaticOrder S; S.init(M, DM, F.G, (int)blockIdx.x);
            pg8::EpiBf16SS E{OB, DM, (float*)(P.ws + WS_PART)};
            pg8::gemm_phase<pg8::EpiBf16SS, pg8::StaticOrder, true, true>(F.lds + RING_OFF, g, S, E);
#endif
        }
        SEAM(pb + 4);
#ifndef DIS_NR
        if (IN(pb + 5)) { PHASE_PTRS(); nr_phase(P, l); }
#endif
        SEAM(pb + 5);
    }
    { constexpr int l = 1;
        const int pb = 2 + 6 * l;
        if (IN(pb)) { PHASE_PTRS();
            { pg8::Gemm g{HB, win_ptr(P.ws, l), M, INC, DM}; pg8::StaticOrder S; S.init(M, INC, F.G, (int)blockIdx.x);
              pg8::EpiBf16 E{PROJ, INC, 1 << 30, nullptr, 0};
              pg8::gemm_phase<pg8::EpiBf16, pg8::StaticOrder, true, true>(F.lds + RING_OFF, g, S, E); }
#ifndef DIS_GVT
            if (l == N_A) {
              { pg8::Gemm g{HB, (const bf16*)(P.ws + WS_WKV), M, MAINW, DM}; pg8::StaticOrder S; S.init(M, MAINW, F.G, (int)blockIdx.x);
                pg8::EpiBf16 E{KB, MAINW, 1 << 30, nullptr, 0};
                pg8::gemm_phase<pg8::EpiBf16, pg8::StaticOrder, true, true>(F.lds + RING_OFF, g, S, E); }
              { pg8::Gemm g{(const bf16*)(P.ws + WS_WKV) + (size_t)MAINW * DM, HB, MAINW, M, DM}; pg8::StaticOrder S; S.init(MAINW, M, F.G, (int)blockIdx.x);
                pg8::EpiBf16 E{VT, M, 1 << 30, nullptr, 0};
                pg8::gemm_phase<pg8::EpiBf16, pg8::StaticOrder, true, true>(F.lds + RING_OFF, g, S, E); }
            }
#endif
        }
        SEAM(pb);
        if (IN(pb + 1)) { PHASE_PTRS();
#ifndef DIS_LRU
            if (l < N_A) { for (int u = P.vcu; u < BATCH * LRU_NB * LRU_NC; u += P.G) lru_unit<false>(P, l, u / (LRU_NB * LRU_NC), (u / LRU_NC) % LRU_NB, u % LRU_NC); }
#endif
#ifndef DIS_SB
            if (l >= N_A) { for (int u = P.vcu; u < BATCH * SB_H * (SEQ / 128); u += P.G) sb_attn_wg(P, u / (SB_H * (SEQ / 128)), (u / (SEQ / 128)) % SB_H, u % (SEQ / 128)); }
#endif
#ifndef DIS_MEM
            for (int u = P.vcu; u < BATCH * MEM_H * (SEQ / 128); u += P.G) mem_attn_wg(P, l, u / (MEM_H * (SEQ / 128)), (u / (SEQ / 128)) % MEM_H, u % (SEQ / 128));
#endif
        }
        SEAM(pb + 1);
        if (l < N_A) { if (IN(pb + 2)) { PHASE_PTRS(); lru_carry_phase(P); } SEAM(pb + 2); }
        if (IN(pb + 3)) { PHASE_PTRS();
#ifndef DIS_LRU
            if (l < N_A) { for (int u = P.vcu; u < BATCH * LRU_NB * LRU_NC; u += P.G) lru_unit<true>(P, l, u / (LRU_NB * LRU_NC), (u / LRU_NC) % LRU_NB, u % LRU_NC); }
#endif
        }
        if (l < N_A) SEAM(pb + 3);
        if (IN(pb + 4)) { PHASE_PTRS();
#ifndef DIS_G2
            pg8::Gemm g{MIX, (const bf16*)(P.ws + WS_WOUT) + (size_t)l * DM * MIXW, M, DM, MIXW}; pg8::StaticOrder S; S.init(M, DM, F.G, (int)blockIdx.x);
            pg8::EpiBf16SS E{OB, DM, (float*)(P.ws + WS_PART)};
            pg8::gemm_phase<pg8::EpiBf16SS, pg8::StaticOrder, true, true>(F.lds + RING_OFF, g, S, E);
#endif
        }
        SEAM(pb + 4);
#ifndef DIS_NR
        if (IN(pb + 5)) { PHASE_PTRS(); nr_phase(P, l); }
#endif
        SEAM(pb + 5);
    }
    { constexpr int l = 2;
        const int pb = 2 + 6 * l;
        if (IN(pb)) { PHASE_PTRS();
            { pg8::Gemm g{HB, win_ptr(P.ws, l), M, INC, DM}; pg8::StaticOrder S; S.init(M, INC, F.G, (int)blockIdx.x);
              pg8::EpiBf16 E{PROJ, INC, 1 << 30, nullptr, 0};
              pg8::gemm_phase<pg8::EpiBf16, pg8::StaticOrder, true, true>(F.lds + RING_OFF, g, S, E); }
#ifndef DIS_GVT
            if (l == N_A) {
              { pg8::Gemm g{HB, (const bf16*)(P.ws + WS_WKV), M, MAINW, DM}; pg8::StaticOrder S; S.init(M, MAINW, F.G, (int)blockIdx.x);
                pg8::EpiBf16 E{KB, MAINW, 1 << 30, nullptr, 0};
                pg8::gemm_phase<pg8::EpiBf16, pg8::StaticOrder, true, true>(F.lds + RING_OFF, g, S, E); }
              { pg8::Gemm g{(const bf16*)(P.ws + WS_WKV) + (size_t)MAINW * DM, HB, MAINW, M, DM}; pg8::StaticOrder S; S.init(MAINW, M, F.G, (int)blockIdx.x);
                pg8::EpiBf16 E{VT, M, 1 << 30, nullptr, 0};
                pg8::gemm_phase<pg8::EpiBf16, pg8::StaticOrder, true, true>(F.lds + RING_OFF, g, S, E); }
            }
#endif
        }
        SEAM(pb);
        if (IN(pb + 1)) { PHASE_PTRS();
#ifndef DIS_LRU
            if (l < N_A) { for (int u = P.vcu; u < BATCH * LRU_NB * LRU_NC; u += P.G) lru_unit<false>(P, l, u / (LRU_NB * LRU_NC), (u / LRU_NC) % LRU_NB, u % LRU_NC); }
#endif
#ifndef DIS_SB
            if (l >= N_A) { for (int u = P.vcu; u < BATCH * SB_H * (SEQ / 128); u += P.G) sb_attn_wg(P, u / (SB_H * (SEQ / 128)), (u / (SEQ / 128)) % SB_H, u % (SEQ / 128)); }
#endif
#ifndef DIS_MEM
            for (int u = P.vcu; u < BATCH * MEM_H * (SEQ / 128); u += P.G) mem_attn_wg(P, l, u / (MEM_H * (SEQ / 128)), (u / (SEQ / 128)) % MEM_H, u % (SEQ / 128));
#endif
        }
        SEAM(pb + 1);
        if (l < N_A) { if (IN(pb + 2)) { PHASE_PTRS(); lru_carry_phase(P); } SEAM(pb + 2); }
        if (IN(pb + 3)) { PHASE_PTRS();
#ifndef DIS_LRU
            if (l < N_A) { for (int u = P.vcu; u < BATCH * LRU_NB * LRU_NC; u += P.G) lru_unit<true>(P, l, u / (LRU_NB * LRU_NC), (u / LRU_NC) % LRU_NB, u % LRU_NC); }
#endif
        }
        if (l < N_A) SEAM(pb + 3);
        if (IN(pb + 4)) { PHASE_PTRS();
#ifndef DIS_G2
            pg8::Gemm g{MIX, (const bf16*)(P.ws + WS_WOUT) + (size_t)l * DM * MIXW, M, DM, MIXW}; pg8::StaticOrder S; S.init(M, DM, F.G, (int)blockIdx.x);
            pg8::EpiBf16SS E{OB, DM, (float*)(P.ws + WS_PART)};
            pg8::gemm_phase<pg8::EpiBf16SS, pg8::StaticOrder, true, true>(F.lds + RING_OFF, g, S, E);
#endif
        }
        SEAM(pb + 4);
#ifndef DIS_NR
        if (IN(pb + 5)) { PHASE_PTRS(); nr_phase(P, l); }
#endif
        SEAM(pb + 5);
    }
    { constexpr int l = 3;
        const int pb = 2 + 6 * l;
        if (IN(pb)) { PHASE_PTRS();
            { pg8::Gemm g{HB, win_ptr(P.ws, l), M, INC, DM}; pg8::StaticOrder S; S.init(M, INC, F.G, (int)blockIdx.x);
              pg8::EpiBf16 E{PROJ, INC, 1 << 30, nullptr, 0};
              pg8::gemm_phase<pg8::EpiBf16, pg8::StaticOrder, true, true>(F.lds + RING_OFF, g, S, E); }
#ifndef DIS_GVT
            if (l == N_A) {
              { pg8::Gemm g{HB, (const bf16*)(P.ws + WS_WKV), M, MAINW, DM}; pg8::StaticOrder S; S.init(M, MAINW, F.G, (int)blockIdx.x);
                pg8::EpiBf16 E{KB, MAINW, 1 << 30, nullptr, 0};
                pg8::gemm_phase<pg8::EpiBf16, pg8::StaticOrder, true, true>(F.lds + RING_OFF, g, S, E); }
              { pg8::Gemm g{(const bf16*)(P.ws + WS_WKV) + (size_t)MAINW * DM, HB, MAINW, M, DM}; pg8::StaticOrder S; S.init(MAINW, M, F.G, (int)blockIdx.x);
                pg8::EpiBf16 E{VT, M, 1 << 30, nullptr, 0};
                pg8::gemm_phase<pg8::EpiBf16, pg8::StaticOrder, true, true>(F.lds + RING_OFF, g, S, E); }
            }
#endif
        }
        SEAM(pb);
        if (IN(pb + 1)) { PHASE_PTRS();
#ifndef DIS_LRU
            if (l < N_A) { for (int u = P.vcu; u < BATCH * LRU_NB * LRU_NC; u += P.G) lru_unit<false>(P, l, u / (LRU_NB * LRU_NC), (u / LRU_NC) % LRU_NB, u % LRU_NC); }
#endif
#ifndef DIS_SB
            if (l >= N_A) { for (int u = P.vcu; u < BATCH * SB_H * (SEQ / 128); u += P.G) sb_attn_wg(P, u / (SB_H * (SEQ / 128)), (u / (SEQ / 128)) % SB_H, u % (SEQ / 128)); }
#endif
#ifndef DIS_MEM
            for (int u = P.vcu; u < BATCH * MEM_H * (SEQ / 128); u += P.G) mem_attn_wg(P, l, u / (MEM_H * (SEQ / 128)), (u / (SEQ / 128)) % MEM_H, u % (SEQ / 128));
#endif
        }
        SEAM(pb + 1);
        if (l < N_A) { if (IN(pb + 2)) { PHASE_PTRS(); lru_carry_phase(P); } SEAM(pb + 2); }
        if (IN(pb + 3)) { PHASE_PTRS();
#ifndef DIS_LRU
            if (l < N_A) { for (int u = P.vcu; u < BATCH * LRU_NB * LRU_NC; u += P.G) lru_unit<true>(P, l, u / (LRU_NB * LRU_NC), (u / LRU_NC) % LRU_NB, u % LRU_NC); }
#endif
        }
        if (l < N_A) SEAM(pb + 3);
        if (IN(pb + 4)) { PHASE_PTRS();
#ifndef DIS_G2
            pg8::Gemm g{MIX, (const bf16*)(P.ws + WS_WOUT) + (size_t)l * DM * MIXW, M, DM, MIXW}; pg8::StaticOrder S; S.init(M, DM, F.G, (int)blockIdx.x);
            pg8::EpiBf16SS E{OB, DM, (float*)(P.ws + WS_PART)};
            pg8::gemm_phase<pg8::EpiBf16SS, pg8::StaticOrder, true, true>(F.lds + RING_OFF, g, S, E);
#endif
        }
        SEAM(pb + 4);
#ifndef DIS_NR
        if (IN(pb + 5)) { PHASE_PTRS(); nr_phase(P, l); }
#endif
        SEAM(pb + 5);
    }
#undef IN
#undef SEAM
}

extern "C" void kernel_launch(void* const* d_in, const int* in_sizes, int n_in, void* d_out, int out_size, void* d_ws, size_t ws_size, hipStream_t stream) {
    static int grid = 0;
    if (grid == 0) {
        if (n_in != 17 || in_sizes[0] != M * DM || out_size != M * DM || ws_size < WS_END) { fprintf(stderr, "kernel_launch: unexpected shapes (n_in %d, in0 %d, out %d, ws %zu); nothing launched\n", n_in, n_in > 0 ? in_sizes[0] : -1, out_size, ws_size); grid = -1; return; }
        int dev = 0, cus = 0, per_cu = 0;
        if (hipGetDevice(&dev) != hipSuccess || hipDeviceGetAttribute(&cus, hipDeviceAttributeMultiprocessorCount, dev) != hipSuccess) { grid = -1; return; }
        if (hipFuncSetAttribute((const void*)yoco_fwd, hipFuncAttributeMaxDynamicSharedMemorySize, LDS_BYTES) != hipSuccess) { fprintf(stderr, "kernel_launch: hipFuncSetAttribute failed\n"); grid = -1; return; }
        if (hipOccupancyMaxActiveBlocksPerMultiprocessor(&per_cu, (const void*)yoco_fwd, NWAVES * 64, LDS_BYTES) != hipSuccess || per_cu < 1)
            fprintf(stderr, "kernel_launch: note: occupancy query reports %d workgroups per CU\n", per_cu);
        (void)hipGetLastError();
        grid = cus;
    }
    if (grid < 0) return;
    if (hipMemsetAsync((char*)d_ws + WS_CTL, 0, CTL_ZERO_BYTES, stream) != hipSuccess) return;
    Args a{};
    for (int i = 0; i < 17; ++i) a.in[i] = (const float*)d_in[i];
    a.out = (float*)d_out; a.ws = (unsigned char*)d_ws;
#if MK_ONE_LAUNCH
    a.ph_lo = 0; a.ph_hi = NPHASES;
    hipLaunchKernelGGL(yoco_fwd, dim3(grid), dim3(NWAVES * 64), LDS_BYTES, stream, a);
#else
    for (int ph = 0; ph < NPHASES; ++ph) {
        if (ph >= 2 && ((ph - 2) % 6 == 2 || (ph - 2) % 6 == 3) && (ph - 2) / 6 >= N_A) continue;
        a.ph_lo = ph; a.ph_hi = ph + 1;
        for (int rep = 0; rep < (((PROBE_MASK >> ph) & 1) ? 2 : 1); ++rep)
        hipLaunchKernelGGL(yoco_fwd, dim3(grid), dim3(NWAVES * 64), LDS_BYTES, stream, a);
    }
#endif
}
```

```cpp
#include <hip/hip_runtime.h>
#include <cstdio>
#include <cstdint>
namespace pg8 {
#define PG8_LAS __attribute__((address_space(3)))
typedef unsigned short bf16_t;
typedef short bf16x8 __attribute__((ext_vector_type(8)));
typedef float f32x4 __attribute__((ext_vector_type(4)));
typedef unsigned u32x4 __attribute__((ext_vector_type(4)));
constexpr int BM = 256, BK = 64, HALF = 128, HTB = HALF * BK * 2  , STAGE_BYTES = 8 * HTB, NXCD = 8, WGM = 8;

__host__ __device__ __forceinline__ int lds_byte(int r, int c) { const int st = (r >> 4) * 2 + (c >> 5), rr = r & 15, cc = c & 31, ob = rr * 64 + cc * 2; return st * 1024 + (ob ^ (((ob >> 9) & 1) << 5)); }
__host__ __device__ __forceinline__ void stage_rc(int b, int& R, int& C) { const int st = b / 1024, sb = b % 1024, swz = sb ^ (((sb >> 9) & 1) << 5); R = (st >> 1) * 16 + swz / 64; C = (st & 1) * 32 + (swz % 64) / 2; }
__host__ __device__ __forceinline__ int perm32(int rho) { const int n = rho >> 4, i = rho & 15; return 8 * (i >> 2) + 4 * n + (i & 3); }

struct Unit { int pm, pn; };
struct Gemm { const bf16_t* A; const bf16_t* Bt; int M, N, K; };

struct StaticOrder {
    int nM, nN, nwg, G, c;
    __host__ __device__ void init(int M, int N, int G_, int c_) { nM = M / BM; nN = N / BM; nwg = nM * nN; G = G_; c = c_; }
    __host__ __device__ bool next(int i, Unit& u) const {
        const long L = (long)i * G + c; if (L >= nwg) return false;
        int wgid = (int)L; { const int q = nwg / NXCD, r = nwg % NXCD, xcd = wgid % NXCD, off = wgid / NXCD; wgid = (xcd < r ? xcd * (q + 1) : r * (q + 1) + (xcd - r) * q) + off; }
        const int nig = WGM * nN, gid = wgid / nig, fm = gid * WGM, gsz = (nM - fm) < WGM ? (nM - fm) : WGM;
        u.pm = fm + ((wgid % nig) % gsz); u.pn = (wgid % nig) / gsz; return true;
    }
    __device__ __forceinline__ void a_ready(const Unit&) const {}
    __device__ __forceinline__ void done(const Unit&) const {}
};

__device__ __forceinline__ unsigned cvt_pk_bf16(float lo, float hi) { unsigned r; asm volatile("v_cvt_pk_bf16_f32 %0, %1, %2" : "=v"(r) : "v"(lo), "v"(hi)); return r; }

struct EpiBf16 {
    static constexpr bool PERM = true, AFTER_DRAIN = false;
    bf16_t* O; int ldc; const float* rscale; const float* cscale; float ks;
    __device__ __forceinline__ void operator()(const f32x4 (&acc)[2][2][4][2], const Unit& u, int wr, int wc, int fr, int fq) const {
        const int row0 = u.pm * BM + wr * 64 + fr; const int col0 = u.pn * BM + wc * 32 + 8 * fq;
        f32x4 cs[2][2];
#pragma unroll
        for (int bj = 0; bj < 2; ++bj)
#pragma unroll
            for (int n = 0; n < 2; ++n) cs[bj][n] = cscale ? *(const f32x4*)(cscale + col0 + bj * HALF + 4 * n) : (f32x4){1.f, 1.f, 1.f, 1.f};
#pragma unroll
        for (int ai = 0; ai < 2; ++ai)
#pragma unroll
            for (int m = 0; m < 4; ++m) { const int row = row0 + ai * HALF + m * 16; bf16_t* rowp = O + (size_t)row * ldc + col0; const float rs = (rscale ? rscale[row] : 1.f) * ks;
#pragma unroll
                for (int bj = 0; bj < 2; ++bj) { const f32x4 v0 = acc[ai][bj][m][0] * rs * cs[bj][0], v1 = acc[ai][bj][m][1] * rs * cs[bj][1];
                    u32x4 w; w.x = cvt_pk_bf16(v0[0], v0[1]); w.y = cvt_pk_bf16(v0[2], v0[3]); w.z = cvt_pk_bf16(v1[0], v1[1]); w.w = cvt_pk_bf16(v1[2], v1[3]);
                    *(u32x4*)(rowp + bj * HALF) = w; } }
    }
};
template <int MODE, int M_> struct EpiKVTile {
    static constexpr bool PERM = true, AFTER_DRAIN = false;
    bf16_t* O; const float* scale; float ks;
    __device__ __forceinline__ void operator()(const f32x4 (&acc)[2][2][4][2], const Unit& u, int wr, int wc, int fr, int fq) const {
        const int row0 = u.pm * BM + wr * 64 + fr; const int col0 = u.pn * BM + wc * 32 + 8 * fq;
        f32x4 cs[2][2];
#pragma unroll
        for (int bj = 0; bj < 2; ++bj)
#pragma unroll
            for (int n = 0; n < 2; ++n) cs[bj][n] = (MODE == 1 && scale) ? *(const f32x4*)(scale + col0 + bj * HALF + 4 * n) : (f32x4){1.f, 1.f, 1.f, 1.f};
#pragma unroll
        for (int ai = 0; ai < 2; ++ai)
#pragma unroll
            for (int m = 0; m < 4; ++m) { const int row = row0 + ai * HALF + m * 16; const float rs = ((MODE == 0 && scale) ? scale[row] : 1.f) * ks;
#pragma unroll
                for (int bj = 0; bj < 2; ++bj) { const f32x4 v0 = acc[ai][bj][m][0] * rs * cs[bj][0], v1 = acc[ai][bj][m][1] * rs * cs[bj][1];
                    u32x4 w; w.x = cvt_pk_bf16(v0[0], v0[1]); w.y = cvt_pk_bf16(v0[2], v0[3]); w.z = cvt_pk_bf16(v1[0], v1[1]); w.w = cvt_pk_bf16(v1[2], v1[3]);
                    const int col = col0 + bj * HALF;
                    size_t off;
                    if (MODE == 0) off = ((size_t)(col >> 7) * M_ + row) * 128 + (col & 127);
                    else off = (((size_t)(row >> 7) * (M_ / 64) + (col >> 6)) * 128 + (row & 127)) * 64 + (col & 63);
                    *(u32x4*)(O + off) = w; } }
    }
};
struct EpiBf16SS {
    static constexpr bool PERM = true, AFTER_DRAIN = false;
    bf16_t* O; int ldc; float* part;
    __device__ __forceinline__ void operator()(const f32x4 (&acc)[2][2][4][2], const Unit& u, int wr, int wc, int fr, int fq) const {
        const int row0 = u.pm * BM + wr * 64 + fr; const int col0 = u.pn * BM + wc * 32 + 8 * fq;
#pragma unroll
        for (int ai = 0; ai < 2; ++ai)
#pragma unroll
            for (int m = 0; m < 4; ++m) { const int row = row0 + ai * HALF + m * 16; bf16_t* rowp = O + (size_t)row * ldc + col0; float ss = 0.f;
#pragma unroll
                for (int bj = 0; bj < 2; ++bj) { const f32x4 v0 = acc[ai][bj][m][0], v1 = acc[ai][bj][m][1];
                    ss += (v0[0] * v0[0] + v0[1] * v0[1]) + (v0[2] * v0[2] + v0[3] * v0[3]) + (v1[0] * v1[0] + v1[1] * v1[1]) + (v1[2] * v1[2] + v1[3] * v1[3]);
                    u32x4 w; w.x = cvt_pk_bf16(v0[0], v0[1]); w.y = cvt_pk_bf16(v0[2], v0[3]); w.z = cvt_pk_bf16(v1[0], v1[1]); w.w = cvt_pk_bf16(v1[2], v1[3]);
                    *(u32x4*)(rowp + bj * HALF) = w; }
                ss += __shfl_xor(ss, 16); ss += __shfl_xor(ss, 32);
                if (fq == 0) part[(size_t)row * 64 + u.pn * 4 + wc] = ss; }
    }
};

template <class Epi, class Sched, bool ALIGN_EPI = false, bool SP2 = false>
__device__ __forceinline__ void gemm_phase(PG8_LAS unsigned char* lds, const Gemm g, const Sched& S, const Epi& E) {
    int tid_l = threadIdx.x; asm volatile("" : "+v"(tid_l));
    const int tid = tid_l, wid = __builtin_amdgcn_readfirstlane(tid >> 6), lane = tid & 63, wr = wid >> 2, wc = wid & 3, fr = lane & 15, fq = lane >> 4;
    const int K = g.K, nt = K / BK;
    unsigned voffA[2], voffB[2];
#pragma unroll
    for (int i = 0; i < 2; ++i) { int R, C; stage_rc(tid * 16 + i * 8192, R, C); const int Rb = Epi::PERM ? ((R & ~31) + perm32(R & 31)) : R;
        voffA[i] = (unsigned)(R * K + C) * 2u; voffB[i] = (unsigned)(Rb * K + C) * 2u; }
    const size_t kstep = (size_t)(BK * 2);
    const size_t hstep = (size_t)HALF * K * 2;
    const size_t tstep = 2 * hstep;
    const unsigned ldsw = (unsigned)wid * 1024u;
    const int aoff = lds_byte(wr * 64 + fr, fq * 8), boff = lds_byte(wc * 32 + fr, fq * 8);
#define PG8_SA(b, h) (((b) * 2 + (h)) * HTB)
#define PG8_SB(b, h) ((4 + (b) * 2 + (h)) * HTB)
#define PG8_STAGE(bufoff, gbase, voff) do { _Pragma("unroll") for (int _i = 0; _i < 2; ++_i) \
        __builtin_amdgcn_global_load_lds((const unsigned*)((const char*)(gbase) + (voff)[_i]), (PG8_LAS unsigned*)(lds + (bufoff) + ldsw + _i * 8192), 16, 0, 0); } while (0)
#define PG8_LDA(dst, b, h) do { _Pragma("unroll") for (int m = 0; m < 4; ++m) _Pragma("unroll") for (int k = 0; k < 2; ++k) dst[m][k] = *(const PG8_LAS bf16x8*)(lds + PG8_SA(b, h) + aoff + m * 2048 + k * 1024); } while (0)
#define PG8_LDB(dst, b, h) do { _Pragma("unroll") for (int n = 0; n < 2; ++n) _Pragma("unroll") for (int k = 0; k < 2; ++k) dst[n][k] = *(const PG8_LAS bf16x8*)(lds + PG8_SB(b, h) + boff + n * 2048 + k * 1024); } while (0)
#define PG8_MMA(ai, bj, At, Bt) do { __builtin_amdgcn_s_setprio(1); _Pragma("unroll") for (int m = 0; m < 4; ++m) _Pragma("unroll") for (int n = 0; n < 2; ++n) _Pragma("unroll") for (int k = 0; k < 2; ++k) \
        acc[ai][bj][m][n] = __builtin_amdgcn_mfma_f32_16x16x32_bf16(Bt[n][k], At[m][k], acc[ai][bj][m][n], 0, 0, 0); __builtin_amdgcn_s_setprio(0); } while (0)
#define PG8_WAIT_V(n) asm volatile("s_waitcnt vmcnt(" #n ")" ::: "memory")
#define PG8_WAIT_L(n) asm volatile("s_waitcnt lgkmcnt(" #n ")" ::: "memory")
#define PG8_BAR __builtin_amdgcn_s_barrier()
#define PG8_SCHED __builtin_amdgcn_sched_barrier(0)
    Unit cur, nxt; int ui = 0;
    if (!S.next(0, cur)) return;
    f32x4 acc[2][2][4][2];
#pragma unroll
    for (int a = 0; a < 2; ++a)
#pragma unroll
        for (int b = 0; b < 2; ++b)
#pragma unroll
            for (int m = 0; m < 4; ++m)
#pragma unroll
                for (int n = 0; n < 2; ++n) acc[a][b][m][n] = (f32x4){0.f, 0.f, 0.f, 0.f};
    bf16x8 At[4][2], B0[2][2], B1[2][2];
    const char* cA = (const char*)g.A + (size_t)cur.pm * tstep; const char* cB = (const char*)g.Bt + (size_t)cur.pn * tstep;
    S.a_ready(cur);
    if constexpr (SP2) {
        PG8_STAGE(PG8_SB(0, 0), cB, voffB); PG8_STAGE(PG8_SB(0, 1), cB + hstep, voffB); PG8_STAGE(PG8_SA(0, 0), cA, voffA); PG8_STAGE(PG8_SA(0, 1), cA + hstep, voffA);
        if (wr == 1) PG8_BAR;
        PG8_WAIT_V(2); PG8_BAR;
        PG8_STAGE(PG8_SB(1, 0), cB + kstep, voffB); PG8_STAGE(PG8_SA(1, 0), cA + kstep, voffA); PG8_STAGE(PG8_SB(1, 1), cB + hstep + kstep, voffB);
        PG8_WAIT_V(6); PG8_BAR;
    } else {
        PG8_STAGE(PG8_SB(0, 0), cB, voffB); PG8_STAGE(PG8_SA(0, 0), cA, voffA); PG8_STAGE(PG8_SB(0, 1), cB + hstep, voffB); PG8_STAGE(PG8_SA(0, 1), cA + hstep, voffA);
        if (wr == 1) PG8_BAR;
        PG8_WAIT_V(4); PG8_BAR;
        PG8_STAGE(PG8_SB(1, 0), cB + kstep, voffB); PG8_STAGE(PG8_SA(1, 0), cA + kstep, voffA); PG8_STAGE(PG8_SB(1, 1), cB + hstep + kstep, voffB);
        PG8_WAIT_V(6); PG8_BAR;
    }
    for (;;) {
        const bool has_next = S.next(ui + 1, nxt);
        const char* nA = has_next ? (const char*)g.A + (size_t)nxt.pm * tstep : cA; const char* nB = has_next ? (const char*)g.Bt + (size_t)nxt.pn * tstep : cB;
        for (int t = 0; t < nt; t += 2) {
            const bool last = (t == nt - 2);
            const char* a1 = cA + (size_t)(t + 1) * kstep;
            const char* a2 = last ? nA : cA + (size_t)(t + 2) * kstep; const char* b2 = last ? nB : cB + (size_t)(t + 2) * kstep;
            const char* a3 = a2 + kstep; const char* b3 = b2 + kstep;
            if (last && has_next) S.a_ready(nxt);
            if constexpr (SP2) {
            PG8_LDB(B0, 0, 0); PG8_LDB(B1, 0, 1); PG8_SCHED; PG8_LDA(At, 0, 0); PG8_STAGE(PG8_SA(1, 1), a1 + hstep, voffA);
            PG8_WAIT_V(8); PG8_WAIT_L(0); PG8_BAR; PG8_MMA(0, 0, At, B0); PG8_MMA(0, 1, At, B1); PG8_BAR; PG8_SCHED;
            PG8_LDA(At, 0, 1); PG8_STAGE(PG8_SB(0, 0), b2, voffB); PG8_STAGE(PG8_SB(0, 1), b2 + hstep, voffB); PG8_STAGE(PG8_SA(0, 0), a2, voffA);
            PG8_WAIT_V(8); PG8_WAIT_L(0); PG8_BAR; PG8_MMA(1, 0, At, B0); PG8_MMA(1, 1, At, B1); PG8_BAR; PG8_SCHED;
            PG8_LDB(B0, 1, 0); PG8_LDB(B1, 1, 1); PG8_SCHED; PG8_LDA(At, 1, 0); PG8_STAGE(PG8_SA(0, 1), a2 + hstep, voffA);
            PG8_WAIT_V(8); PG8_WAIT_L(0); PG8_BAR; PG8_MMA(0, 0, At, B0); PG8_MMA(0, 1, At, B1); PG8_BAR; PG8_SCHED;
            PG8_LDA(At, 1, 1); PG8_STAGE(PG8_SB(1, 0), b3, voffB); PG8_STAGE(PG8_SB(1, 1), b3 + hstep, voffB); PG8_STAGE(PG8_SA(1, 0), a3, voffA);
            PG8_WAIT_V(8); PG8_WAIT_L(0); PG8_BAR; PG8_MMA(1, 0, At, B0); PG8_MMA(1, 1, At, B1); PG8_BAR; PG8_SCHED;
            } else {
            PG8_LDB(B0, 0, 0); PG8_SCHED; PG8_LDA(At, 0, 0); PG8_STAGE(PG8_SA(1, 1), a1 + hstep, voffA);
            PG8_WAIT_L(8); PG8_BAR; PG8_WAIT_L(0); PG8_MMA(0, 0, At, B0); PG8_BAR; PG8_SCHED;
            PG8_LDB(B1, 0, 1); PG8_STAGE(PG8_SB(0, 0), b2, voffB);
            PG8_BAR; PG8_WAIT_L(0); PG8_MMA(0, 1, At, B1); PG8_BAR;
            PG8_LDA(At, 0, 1); PG8_STAGE(PG8_SA(0, 0), a2, voffA);
            PG8_BAR; PG8_WAIT_L(0); PG8_MMA(1, 0, At, B0); PG8_BAR; PG8_SCHED;
            PG8_STAGE(PG8_SB(0, 1), b2 + hstep, voffB);
            PG8_WAIT_V(6); PG8_BAR; PG8_MMA(1, 1, At, B1); PG8_BAR;
            PG8_LDB(B0, 1, 0); PG8_SCHED; PG8_LDA(At, 1, 0); PG8_STAGE(PG8_SA(0, 1), a2 + hstep, voffA);
            PG8_WAIT_L(8); PG8_BAR; PG8_WAIT_L(0); PG8_MMA(0, 0, At, B0); PG8_BAR; PG8_SCHED;
            PG8_LDB(B1, 1, 1); PG8_STAGE(PG8_SB(1, 0), b3, voffB);
            PG8_BAR; PG8_WAIT_L(0); PG8_MMA(0, 1, At, B1); PG8_BAR;
            PG8_LDA(At, 1, 1); PG8_STAGE(PG8_SA(1, 0), a3, voffA);
            PG8_BAR; PG8_WAIT_L(0); PG8_MMA(1, 0, At, B0); PG8_BAR; PG8_SCHED;
            PG8_STAGE(PG8_SB(1, 1), b3 + hstep, voffB);
            PG8_WAIT_V(6); PG8_BAR; PG8_MMA(1, 1, At, B1); PG8_BAR;
            }
        }
        if constexpr (ALIGN_EPI) { if (wr == 0) PG8_BAR; }
        if constexpr (!Epi::AFTER_DRAIN) { E(acc, cur, wr, wc, fr, fq); S.done(cur); }
        if (!has_next) break;
#pragma unroll
        for (int a = 0; a < 2; ++a)
#pragma unroll
            for (int b = 0; b < 2; ++b)
#pragma unroll
                for (int m = 0; m < 4; ++m)
#pragma unroll
                    for (int n = 0; n < 2; ++n) acc[a][b][m][n] = (f32x4){0.f, 0.f, 0.f, 0.f};
        cur = nxt; cA = nA; cB = nB; ++ui;
        if constexpr (ALIGN_EPI) { if (wr == 1) PG8_BAR; }
    }
    PG8_WAIT_V(0);
    if constexpr (!ALIGN_EPI) { if (wr == 0) PG8_BAR; }
    PG8_BAR;
    if constexpr (Epi::AFTER_DRAIN) { E.fused(acc, cur, wr, wc, fr, fq, lds, wid, lane); S.done(cur); }
#undef PG8_SA
#undef PG8_SB
#undef PG8_STAGE
#undef PG8_LDA
#undef PG8_LDB
#undef PG8_MMA
#undef PG8_WAIT_V
#undef PG8_WAIT_L
#undef PG8_BAR
#undef PG8_SCHED
}
}
constexpr int BATCH = 2, SEQ = 8192, DM = 4096, M = BATCH * SEQ, DEPTH = 4, N_A = 2;
constexpr int MAINW = 3072, MEMW = 1024, INC = 8192, MIXW = 4096, KVW = 6144;
constexpr int LRU_NB = 12, SB_H = 24, MEM_T = 256, MEM_H = 4;
constexpr float EPS = 1e-6f;
constexpr int NWAVES = 8;
constexpr int LRU_T = 128, LRU_NC = SEQ / LRU_T;

constexpr size_t MiB = 1u << 20;
constexpr size_t WS_CTL = 0, CTL_ZERO_BYTES = 8 * MiB;
constexpr size_t WS_GRAN = 1 * MiB;
constexpr int CW_TMO = 16;
constexpr size_t WS_WIN0 = 16 * MiB, WS_WKV = 272 * MiB;
constexpr size_t WS_WOUT = 320 * MiB;
constexpr size_t WS_WMK = 448 * MiB, WS_WMV = 480 * MiB;
constexpr size_t WS_WG = 512 * MiB;
constexpr size_t WS_HB = 520 * MiB;
constexpr size_t WS_MEMB = 648 * MiB;
constexpr size_t WS_MEMK = 652 * MiB;
constexpr size_t WS_MEMVT = 656 * MiB;
constexpr size_t WS_PROJ = 660 * MiB;
constexpr size_t WS_KB = 1400 * MiB;
constexpr size_t WS_VT = 1500 * MiB;
constexpr size_t WS_MIX = 1108 * MiB;
constexpr size_t WS_OB = 1236 * MiB;
constexpr size_t WS_PART = 1364 * MiB;
constexpr size_t WS_AGG = 1368 * MiB;
constexpr size_t WS_RSTD = 1372 * MiB + 512 * 1024;
constexpr size_t WS_CARRY = 1371 * MiB;
constexpr size_t WS_END = 1600 * MiB;
constexpr int KPITCH = MAINW + 64, VTPITCH = M + 64;
constexpr int CW_BAR = 4096;

constexpr int RING_OFF = 0, RING_BYTES = 131072;
constexpr int LDSCTL_OFF = RING_BYTES, MISC_OFF = LDSCTL_OFF + 320;
constexpr int LDS_BYTES = 147456;
constexpr int UT_PITCH = 264;

#define GAS __attribute__((address_space(1)))
#define LAS __attribute__((address_space(3)))
typedef unsigned short bf16;
typedef unsigned v4u __attribute__((ext_vector_type(4)));
typedef unsigned v2u __attribute__((ext_vector_type(2)));
typedef float f32x4 __attribute__((ext_vector_type(4)));
typedef short bf16x8 __attribute__((ext_vector_type(8)));
typedef short bf16x4 __attribute__((ext_vector_type(4)));
typedef float f32x2 __attribute__((ext_vector_type(2)));
typedef GAS unsigned gu32;
#define LDS_WAIT() asm volatile("s_waitcnt lgkmcnt(0)" ::: "memory")
#define VM_WAIT() asm volatile("s_waitcnt vmcnt(0)" ::: "memory")
#define MFMA16(a, b, c) __builtin_amdgcn_mfma_f32_16x16x32_bf16((a), (b), (c), 0, 0, 0)
typedef __bf16 bf16x2v __attribute__((ext_vector_type(2)));
__device__ __forceinline__ unsigned pk2(float lo, float hi) { f32x2 v; v.x = lo; v.y = hi; return __builtin_bit_cast(unsigned, __builtin_convertvector(v, bf16x2v)); }
__device__ __forceinline__ unsigned f2bf(float f) { return pk2(f, 0.f) & 0xffffu; }
__device__ __forceinline__ float bf2f(unsigned short h) { return __builtin_bit_cast(float, (unsigned)h << 16); }
__device__ __forceinline__ float bflo(unsigned w) { return __builtin_bit_cast(float, w << 16); }
__device__ __forceinline__ float bfhi(unsigned w) { return __builtin_bit_cast(float, w & 0xffff0000u); }
__device__ __forceinline__ float wave_sum(float v) {
#pragma unroll
    for (int o = 1; o < 64; o <<= 1) v += __shfl_xor(v, o);
    return v;
}
#ifndef PL_SB
#define PL_SB 0
#endif
#ifndef PL_LRU
#define PL_LRU 1
#endif
__device__ __forceinline__ float xor16s(float v, int) { return __shfl_xor(v, 16); }
__device__ __forceinline__ float xor32s(float v, int) { return __shfl_xor(v, 32); }
__device__ __forceinline__ float xor16(float v, int g) { unsigned a = __builtin_bit_cast(unsigned, v), b = a;
    asm volatile("s_nop 1\n\tv_permlane16_swap_b32 %0, %1\n\ts_nop 1" : "+v"(a), "+v"(b)); return __builtin_bit_cast(float, (g & 1) ? a : b); }
__device__ __forceinline__ float xor32(float v, int g) { unsigned a = __builtin_bit_cast(unsigned, v), b = a;
    asm volatile("s_nop 1\n\tv_permlane32_swap_b32 %0, %1\n\ts_nop 1" : "+v"(a), "+v"(b)); return __builtin_bit_cast(float, (g & 2) ? a : b); }
__device__ __forceinline__ float fast_exp(float x) { return __builtin_amdgcn_exp2f(x * 1.44269504089f); }
__device__ __forceinline__ float fast_sigmoid(float x) { return __builtin_amdgcn_rcpf(1.0f + fast_exp(-x)); }
__device__ __forceinline__ float silu_f(float x) { return x * fast_sigmoid(x); }
__device__ __forceinline__ float softplus_f(float z) { return fmaxf(z, 0.f) + __builtin_amdgcn_logf(1.0f + fast_exp(-fabsf(z))) * 0.69314718056f; }

#define XB_TMO      128
#define XB_XCNT(j)  (256  + 64 * (j))
#define XB_XSUB(j)  (1280 + 64 * (j))
#define XB_XGEN(j)  (2304 + 64 * (j))
#define XB_TOP      3328
#define XB_TOPGEN   3392
#define XCD_BAR_WORDS 3456
#define XB_SPIN_CAP (1u << 18)
__device__ __forceinline__ unsigned xb_ld(unsigned* p)              { return __hip_atomic_load(p, __ATOMIC_RELAXED, __HIP_MEMORY_SCOPE_AGENT); }
__device__ __forceinline__ unsigned xb_add(unsigned* p, unsigned v) { return __hip_atomic_fetch_add(p, v, __ATOMIC_RELAXED, __HIP_MEMORY_SCOPE_AGENT); }
__device__ __forceinline__ unsigned xb_xcc_id() { return (unsigned)__builtin_amdgcn_s_getreg((3 << 11) | 20) & 0xFu; }
#define XB_SPIN(cond, bar) do { unsigned _sp = 0; while (cond) { __builtin_amdgcn_s_sleep(1); \
    if ((++_sp & 255u) == 0u) { if (xb_ld(&(bar)[XB_TMO])) break; if (_sp > XB_SPIN_CAP) { atomicAdd(&(bar)[XB_TMO], 1u); break; } } } } while (0)
struct XcdBarrier { unsigned* bar; unsigned x; volatile LAS unsigned* st; };
__device__ __forceinline__ XcdBarrier xcd_barrier_post(unsigned* bar, volatile LAS unsigned* st) {
    XcdBarrier b; b.bar = bar; b.x = xb_xcc_id(); b.st = st;
    if (threadIdx.x == 0) (void)xb_add(&bar[XB_XCNT(b.x)], 1u);
    return b;
}
__device__ __forceinline__ void xcd_barrier_complete(unsigned* bar, unsigned x, unsigned& nloc, unsigned& nx) {
    const unsigned G = gridDim.x * gridDim.y * gridDim.z;
    unsigned sum, cnt, mine, sp = 0u;
    for (;;) {
        sum = 0u; cnt = 0u; mine = 0u;
#pragma unroll
        for (unsigned j = 0; j < 16; ++j) { const unsigned c = xb_ld(&bar[XB_XCNT(j)]); sum += c; cnt += (c > 0u) ? 1u : 0u; mine = (j == x) ? c : mine; }
        if (sum == G) break;
        __builtin_amdgcn_s_sleep(1);
        if ((++sp & 255u) == 0u) { if (xb_ld(&bar[XB_TMO])) break; if (sp > XB_SPIN_CAP) { atomicAdd(&bar[XB_TMO], 1u); break; } }
    }
    nloc = mine > 0u ? mine : 1u; nx = cnt > 0u ? cnt : 1u;
}
__device__ __forceinline__ void xcd_barrier(const XcdBarrier& b) {
    asm volatile("s_waitcnt vmcnt(0)" ::: "memory");
    __syncthreads();
    if (threadIdx.x == 0) {
        unsigned* bar = b.bar;
        __builtin_amdgcn_s_waitcnt(0);
        unsigned nloc = b.st[0], nx = b.st[1];
        if (nloc == 0u) { xcd_barrier_complete(bar, b.x, nloc, nx); b.st[0] = nloc; b.st[1] = nx; }
        const unsigned old = xb_add(&bar[XB_XSUB(b.x)], 1u);
        const unsigned gen = old / nloc;
        if (old + 1u == (gen + 1u) * nloc) {
            __builtin_amdgcn_fence(__ATOMIC_RELEASE, "agent");
            asm volatile("s_waitcnt vmcnt(0)" ::: "memory");
            const unsigned og = xb_add(&bar[XB_TOP], 1u);
            const unsigned tg = og / nx;
            if (og + 1u == (tg + 1u) * nx) xb_add(&bar[XB_TOPGEN], 1u);
            else XB_SPIN(xb_ld(&bar[XB_TOPGEN]) == tg, bar);
            __builtin_amdgcn_fence(__ATOMIC_ACQUIRE, "agent");
            xb_add(&bar[XB_XGEN(b.x)], 1u);
            asm volatile("s_waitcnt vmcnt(0)" ::: "memory");
        } else {
            XB_SPIN(xb_ld(&bar[XB_XGEN(b.x)]) == gen, bar);
            __builtin_amdgcn_fence(__ATOMIC_ACQUIRE, "agent");
            asm volatile("s_waitcnt vmcnt(0)" ::: "memory");
        }
    }
    __syncthreads();
}

struct Frame {
    LAS unsigned char* lds;
    int tid, lane, wave, vcu, G;
    float* out;
    unsigned char* ws;
};
#define LAUNDER_S(p) asm volatile("" : "+s"(p))
enum { I_X = 0, I_MEM, I_PRE_GAIN, I_POST_GAIN, I_W_IN, I_W_OUT, I_W_MEM_KV, I_MEM_GAIN, I_CONV_W, I_CONV_B, I_GATE_A_W, I_GATE_A_B, I_GATE_X_W, I_GATE_X_B, I_LAM, I_KV_GAIN, I_W_KV, I_NIN };
constexpr int PTR_OFF = LDSCTL_OFF + 512;
__device__ __forceinline__ const float* inp(const Frame& F, int i) {
    const unsigned long long v = ((const LAS unsigned long long*)(F.lds + PTR_OFF))[i];
    const unsigned lo = __builtin_amdgcn_readfirstlane((unsigned)v), hi = __builtin_amdgcn_readfirstlane((unsigned)(v >> 32));
    return (const float*)(((unsigned long long)hi << 32) | lo);
}
__device__ __forceinline__ bf16* win_ptr(unsigned char* ws, int l) { return (bf16*)(ws + WS_WIN0) + (size_t)l * INC * DM; }

__device__ __forceinline__ void p0_transpose_item(const float* W, int K, int N, bf16* WT, const float* gain, LAS bf16* scr, int kb, int nb, int dst_row0, int lane) {
    const int k0 = 64 * kb, n0 = 64 * nb;
    const int lr = lane >> 4, lc = lane & 15;
    f32x4 v[16];
#pragma unroll
    for (int i = 0; i < 16; ++i) v[i] = __builtin_nontemporal_load((const GAS f32x4*)(W + (size_t)(k0 + 4 * i + lr) * N + n0 + 4 * lc));
    if (gain) {
#pragma unroll
        for (int i = 0; i < 16; ++i) v[i] = v[i] * gain[k0 + 4 * i + lr];
    }
#pragma unroll
    for (int i = 0; i < 16; ++i) { LAS bf16* d = scr + (4 * i + lr) * 66 + 4 * lc;
        *(LAS unsigned*)(d) = pk2(v[i].x, v[i].y); *(LAS unsigned*)(d + 2) = pk2(v[i].z, v[i].w); }
    LDS_WAIT(); asm volatile("" ::: "memory");
    const int kc = lane & 7, nr = lane >> 3;
#pragma unroll
    for (int j = 0; j < 8; ++j) { const LAS bf16* sp = scr + (8 * kc) * 66 + 8 * j + nr;
        v4u o; o.x = (unsigned)sp[0] | ((unsigned)sp[66] << 16); o.y = (unsigned)sp[2 * 66] | ((unsigned)sp[3 * 66] << 16);
        o.z = (unsigned)sp[4 * 66] | ((unsigned)sp[5 * 66] << 16); o.w = (unsigned)sp[6 * 66] | ((unsigned)sp[7 * 66] << 16);
        *(GAS v4u*)(WT + (size_t)(dst_row0 + 8 * j + nr) * K + k0 + 8 * kc) = o; }
    LDS_WAIT(); asm volatile("" ::: "memory");
}
template <bool NORMALISE>
__device__ __forceinline__ void rms_row_to_bf16(const float* xrow, bf16* orow, float* rstd_out, int lane) {
    const GAS f32x4* xr = (const GAS f32x4*)xrow + lane;
    f32x4 v[16]; float s = 0.f;
#pragma unroll
    for (int j = 0; j < 16; ++j) { v[j] = xr[64 * j]; s += (v[j].x * v[j].x + v[j].y * v[j].y) + (v[j].z * v[j].z + v[j].w * v[j].w); }
    const float nrm = sqrtf(wave_sum(s) * (1.0f / DM) + EPS), rstd = 1.0f / nrm;
    const float sc = rstd;
    if (!NORMALISE && lane == 0) *rstd_out = nrm;
    GAS unsigned long long* o8 = (GAS unsigned long long*)orow + lane;
#pragma unroll
    for (int j = 0; j < 16; ++j) o8[64 * j] = (unsigned long long)pk2(v[j].x * sc, v[j].y * sc) | ((unsigned long long)pk2(v[j].z * sc, v[j].w * sc) << 32);
}
constexpr int PI_MKV = 4 * 64 * 32, PI_IN = 4 * 64 * 128, PI_KV = 64 * 96, PI_OUT = 4 * 64 * 64, PI_G = 48 * 16;
constexpr int PW_MEM = PI_MKV + BATCH * MEM_T, PW_END = PW_MEM + PI_IN + PI_KV + PI_OUT + PI_G + M;
constexpr int PW_SPLIT = PW_MEM + 14336;
__device__ __forceinline__ void p0_do(Frame& F, int idx) {
    LAS bf16* scr = (LAS bf16*)(F.lds + RING_OFF + F.wave * 16384);
    int r = idx;
    if (r < PI_MKV) { const float* const w_mem_kv = inp(F, I_W_MEM_KV); const float* const mem_gain = inp(F, I_MEM_GAIN);
        const int l = r / 2048, rr = r % 2048, kb = rr / 32, nb = rr % 32; const int n0 = 64 * nb;
        bf16* dst = (bf16*)(F.ws + (n0 < MEMW ? WS_WMK : WS_WMV)); const int row0 = l * MEMW + (n0 < MEMW ? n0 : n0 - MEMW);
        p0_transpose_item(w_mem_kv + (size_t)l * DM * 2 * MEMW, DM, 2 * MEMW, dst, mem_gain, scr, kb, nb, row0, F.lane); return; } r -= PI_MKV;
    if (r < BATCH * MEM_T) { rms_row_to_bf16<true>(inp(F, I_MEM) + (size_t)r * DM, (bf16*)(F.ws + WS_MEMB) + (size_t)r * DM, nullptr, F.lane); return; } r -= BATCH * MEM_T;
    if (r < PI_IN) { const float* const w_in = inp(F, I_W_IN); const float* const pre_gain = inp(F, I_PRE_GAIN);
        const int l = r / 8192, rr = r % 8192, kb = rr / 128, nb = rr % 128;
        p0_transpose_item(w_in + (size_t)l * DM * INC, DM, INC, win_ptr(F.ws, l), pre_gain + l * DM, scr, kb, nb, 64 * nb, F.lane); return; } r -= PI_IN;
    if (r < PI_KV) { const int kb = r / 96, nb = r % 96;
        p0_transpose_item(inp(F, I_W_KV), DM, KVW, (bf16*)(F.ws + WS_WKV), inp(F, I_KV_GAIN), scr, kb, nb, 64 * nb, F.lane); return; } r -= PI_KV;
    if (r < PI_OUT) { const int l = r / 4096, rr = r % 4096, kb = rr / 64, nb = rr % 64;
        p0_transpose_item(inp(F, I_W_OUT) + (size_t)l * MIXW * DM, MIXW, DM, (bf16*)(F.ws + WS_WOUT) + (size_t)l * DM * MIXW, nullptr, scr, kb, nb, 64 * nb, F.lane); return; } r -= PI_OUT;
    if (r < PI_G) { const int mat = r / 16, rr = r % 16, kb = rr / 4, nb = rr % 4; const int ln = mat / 2, ga = mat % 2;
        p0_transpose_item(inp(F, ga ? I_GATE_X_W : I_GATE_A_W) + (size_t)ln * 65536, 256, 256, (bf16*)(F.ws + WS_WG) + (size_t)ln * 512 * 256, nullptr, scr, kb, nb, ga * 256 + 64 * nb, F.lane); return; } r -= PI_G;
    rms_row_to_bf16<false>(inp(F, I_X) + (size_t)r * DM, (bf16*)(F.ws + WS_HB) + (size_t)r * DM, (float*)(F.ws + WS_RSTD) + r, F.lane);
}

template <int LAYER>
__device__ __forceinline__ void nr_phase(Frame& F) {
    const int gw = F.vcu * NWAVES + F.wave, NGW = F.G * NWAVES, lane = F.lane;
    const bf16* ob = (const bf16*)(F.ws + WS_OB); const float* part = (const float*)(F.ws + WS_PART); bf16* hb = (bf16*)(F.ws + WS_HB); float* rstd_arr = (float*)(F.ws + WS_RSTD);
    const GAS f32x4* pg = (const GAS f32x4*)(inp(F, I_POST_GAIN) + LAYER * DM) + lane;
    for (int m0 = gw; m0 < M; m0 += 2 * NGW) {
        const int mA = m0, mB = (m0 + NGW < M) ? m0 + NGW : m0;
        const float ssA = part[(size_t)mA * 64 + lane], ssB = part[(size_t)mB * 64 + lane];
        const GAS v2u* oA = (const GAS v2u*)(ob + (size_t)mA * DM) + lane; const GAS v2u* oB = (const GAS v2u*)(ob + (size_t)mB * DM) + lane;
        GAS v2u* hA = (GAS v2u*)(hb + (size_t)mA * DM) + lane; GAS v2u* hB = (GAS v2u*)(hb + (size_t)mB * DM) + lane;
        v2u oa[16], ha[16], obv[16], hbv[16];
#pragma unroll
        for (int j = 0; j < 16; ++j) { oa[j] = __builtin_nontemporal_load(oA + 64 * j); ha[j] = hA[64 * j]; obv[j] = __builtin_nontemporal_load(oB + 64 * j); hbv[j] = hB[64 * j]; }
        const float rsA = 1.0f / sqrtf(wave_sum(ssA) * (1.0f / DM) + EPS), rsB = 1.0f / sqrtf(wave_sum(ssB) * (1.0f / DM) + EPS);
        const float nA = rstd_arr[mA], nB = rstd_arr[mB];
#pragma unroll
        for (int rI = 0; rI < 2; ++rI) {
            const float rs = rI ? rsB : rsA; const float hn = rI ? nB : nA; const int m = rI ? mB : mA; GAS v2u* hrow = rI ? hB : hA;
            if (rI == 1 && mB == mA) break;
            f32x4 v[16]; float s = 0.f;
#pragma unroll
            for (int j = 0; j < 16; ++j) { const v2u o = rI ? obv[j] : oa[j]; const v2u hh = rI ? hbv[j] : ha[j]; const f32x4 g = pg[64 * j];
                f32x4 r; r.x = bflo(hh.x) * hn + bflo(o.x) * rs * g.x; r.y = bfhi(hh.x) * hn + bfhi(o.x) * rs * g.y; r.z = bflo(hh.y) * hn + bflo(o.y) * rs * g.z; r.w = bfhi(hh.y) * hn + bfhi(o.y) * rs * g.w;
                v[j] = r; s += (r.x * r.x + r.y * r.y) + (r.z * r.z + r.w * r.w); }
            if (LAYER < DEPTH - 1) {
                const float nrm = sqrtf(wave_sum(s) * (1.0f / DM) + EPS), rstd = 1.0f / nrm;
                if (lane == 0) rstd_arr[m] = nrm;
#pragma unroll
                for (int j = 0; j < 16; ++j) { v2u w; w.x = pk2(v[j].x * rstd, v[j].y * rstd); w.y = pk2(v[j].z * rstd, v[j].w * rstd); hrow[64 * j] = w; }
            } else {
                GAS f32x4* outr = (GAS f32x4*)(F.out + (size_t)m * DM) + lane;
#pragma unroll
                for (int j = 0; j < 16; ++j) __builtin_nontemporal_store(v[j], outr + 64 * j);
            }
        }
    }
}

__device__ __forceinline__ bf16x8 pack8(float a0, float a1, float a2, float a3, float a4, float a5, float a6, float a7) {
    v4u p; p.x = pk2(a0, a1); p.y = pk2(a2, a3); p.z = pk2(a4, a5); p.w = pk2(a6, a7); return __builtin_bit_cast(bf16x8, p);
}
__host__ __device__ __forceinline__ int kperm(int rho) { return (rho & ~31) + 8 * ((rho & 15) >> 2) + 4 * ((rho >> 4) & 1) + (rho & 3); }
__device__ __forceinline__ void glds16(const bf16* g, LAS unsigned char* l) { __builtin_amdgcn_global_load_lds((const unsigned*)g, (LAS unsigned*)l, 16, 0, 0); }
#define WG_BAR() do { asm volatile("s_waitcnt vmcnt(0) lgkmcnt(0)" ::: "memory"); __builtin_amdgcn_s_barrier(); asm volatile("" ::: "memory"); } while (0)

#if PL_SB
#define SBX16 xor16
#define SBX32 xor32
#else
#define SBX16 xor16s
#define SBX32 xor32s
#endif
template <int NP, bool MASK>
__device__ __forceinline__ void sb_tile_weights(const f32x4 (&zt)[2 * NP], float (&w)[NP][8], float& R, int kb, int tq, int g) {
    float bt[NP][8], sp[NP][8], Sp[NP];
#pragma unroll
    for (int p = 0; p < NP; ++p) {
        float om[8];
#pragma unroll
        for (int jj = 0; jj < 8; ++jj) {
            const float t = fmaxf(zt[2 * p + (jj >> 2)][jj & 3], -126.0f);
            const float e = __builtin_amdgcn_exp2f(-t);
            float b = __builtin_amdgcn_rcpf(1.0f + e), o = e * b;
            if (MASK) { const bool valid = (kb + 32 * p + 8 * g + jj) < tq; b = valid ? b : 0.f; o = valid ? o : 1.f; }
            bt[p][jj] = b; om[jj] = o; }
        sp[p][7] = 1.f;
#pragma unroll
        for (int jj = 6; jj >= 0; --jj) sp[p][jj] = sp[p][jj + 1] * om[jj + 1];
        Sp[p] = sp[p][0] * om[0];
    }
    float Gp[NP], Tp[NP];
#pragma unroll
    for (int p = 0; p < NP; ++p) {
        const float p16 = SBX16(Sp[p], g);
        const float Ppair = Sp[p] * p16;
        const float p32 = SBX32(Ppair, g);
        Gp[p] = ((g & 1) ? 1.f : p16) * ((g & 2) ? 1.f : p32);
        Tp[p] = Ppair * p32;
    }
    float Facc = R;
#pragma unroll
    for (int p = NP - 1; p >= 0; --p) {
        const float base = Facc * Gp[p];
#pragma unroll
        for (int jj = 0; jj < 8; ++jj) w[p][jj] = bt[p][jj] * (base * sp[p][jj]);
        Facc *= Tp[p];
    }
    R = Facc;
}
template <bool MASK>
__device__ __forceinline__ void sb_tile_weights2(const f32x4 (&zt)[4], float (&w)[2][8], float& R, int kb, int tq, int g) {
    f32x2 bt[8], sp[8], om[8];
    const int lim = tq - kb - 8 * g;
#pragma unroll
    for (int jj = 0; jj < 8; ++jj) {
        f32x2 e;
        e.x = __builtin_fminf(__builtin_amdgcn_exp2f(-zt[jj >> 2][jj & 3]), 0x1p126f); e.y = __builtin_fminf(__builtin_amdgcn_exp2f(-zt[2 + (jj >> 2)][jj & 3]), 0x1p126f);
        const f32x2 d = e + (f32x2){1.0f, 1.0f};
        f32x2 b; b.x = __builtin_amdgcn_rcpf(d.x); b.y = __builtin_amdgcn_rcpf(d.y);
        f32x2 o = e * b;
        if (MASK) { const bool v0 = jj < lim, v1 = (32 + jj) < lim; b.x = v0 ? b.x : 0.f; o.x = v0 ? o.x : 1.f; b.y = v1 ? b.y : 0.f; o.y = v1 ? o.y : 1.f; }
        bt[jj] = b; om[jj] = o; }
    sp[7] = (f32x2){1.f, 1.f};
#pragma unroll
    for (int jj = 6; jj >= 0; --jj) sp[jj] = sp[jj + 1] * om[jj + 1];
    const f32x2 Sp = sp[0] * om[0];
    f32x2 p16; p16.x = SBX16(Sp.x, g); p16.y = SBX16(Sp.y, g);
    const f32x2 Ppair = Sp * p16;
    f32x2 p32; p32.x = SBX32(Ppair.x, g); p32.y = SBX32(Ppair.y, g);
    f32x2 Gp; Gp.x = ((g & 1) ? 1.f : p16.x) * ((g & 2) ? 1.f : p32.x); Gp.y = ((g & 1) ? 1.f : p16.y) * ((g & 2) ? 1.f : p32.y);
    const f32x2 Tp = Ppair * p32;
    f32x2 base; base.y = R * Gp.y; const float F1 = R * Tp.y; base.x = F1 * Gp.x; R = F1 * Tp.x;
#pragma unroll
    for (int jj = 0; jj < 8; ++jj) { const f32x2 ww = bt[jj] * (base * sp[jj]); w[0][jj] = ww.x; w[1][jj] = ww.y; }
}
template <int NP, int ROW0>
__device__ __forceinline__ void sb_compute(LAS unsigned char* stg, const bf16x8 (&qf)[4], f32x4 (&ot)[8], float& R, int kt, int tq, int tw, int c, int g) {
    f32x4 zt[2 * NP];
#pragma unroll
    for (int f = 0; f < 2 * NP; ++f) zt[f] = (f32x4){0.f, 0.f, 0.f, 0.f};
#pragma unroll
    for (int kk = 0; kk < 4; ++kk)
#pragma unroll
        for (int f = 0; f < 2 * NP; ++f) { const bf16x8 kf = *(const LAS bf16x8*)(stg + (kk >> 1) * 16384 + pg8::lds_byte(ROW0 + 16 * f + c, 32 * (kk & 1) + 8 * g));
            zt[f] = MFMA16(kf, qf[kk], zt[f]); }
    float w[NP][8];
    if constexpr (NP == 2) { if (kt + ROW0 + 63 >= tw) sb_tile_weights2<true>(zt, w, R, kt + ROW0, tq, g); else sb_tile_weights2<false>(zt, w, R, kt + ROW0, tq, g); }
    else { if (kt + ROW0 + 32 * NP - 1 >= tw) sb_tile_weights<NP, true>(zt, w, R, kt + ROW0, tq, g); else sb_tile_weights<NP, false>(zt, w, R, kt + ROW0, tq, g); }
#pragma unroll
    for (int p = 0; p < NP; ++p) {
        const bf16x8 wf = pack8(w[p][0], w[p][1], w[p][2], w[p][3], w[p][4], w[p][5], w[p][6], w[p][7]);
        constexpr int dummy = 0; (void)dummy;
        const int ko = ROW0 + 32 * p;
#pragma unroll
        for (int md = 0; md < 8; ++md) { const bf16x8 vf = *(const LAS bf16x8*)(stg + 32768 + (ko >> 6) * 16384 + pg8::lds_byte(16 * md + c, (ko & 63) + 8 * g)); ot[md] = MFMA16(vf, wf, ot[md]); }
    }
}

template <int ROW0>
__device__ __forceinline__ void sb_compute_joint(LAS unsigned char* stg, const bf16x8 (&qfA)[4], const bf16x8 (&qfB)[4], f32x4 (&otA)[8], f32x4 (&otB)[8], float& RA, float& RB,
                                                 int kt, int tqA, int twA, int tqB, int twB, int c, int g) {
    f32x4 ztA[4], ztB[4];
#pragma unroll
    for (int f = 0; f < 4; ++f) { ztA[f] = (f32x4){0.f, 0.f, 0.f, 0.f}; ztB[f] = (f32x4){0.f, 0.f, 0.f, 0.f}; }
#pragma unroll
    for (int kk = 0; kk < 4; ++kk)
#pragma unroll
        for (int f = 0; f < 4; ++f) { const bf16x8 kf = *(const LAS bf16x8*)(stg + (kk >> 1) * 16384 + pg8::lds_byte(ROW0 + 16 * f + c, 32 * (kk & 1) + 8 * g));
            ztA[f] = MFMA16(kf, qfA[kk], ztA[f]); ztB[f] = MFMA16(kf, qfB[kk], ztB[f]); }
    bf16x8 wfA[2], wfB[2];
    { float w[2][8];
      if (kt + ROW0 + 63 >= twA) sb_tile_weights2<true>(ztA, w, RA, kt + ROW0, tqA, g); else sb_tile_weights2<false>(ztA, w, RA, kt + ROW0, tqA, g);
#pragma unroll
      for (int p = 0; p < 2; ++p) wfA[p] = pack8(w[p][0], w[p][1], w[p][2], w[p][3], w[p][4], w[p][5], w[p][6], w[p][7]); }
    { float w[2][8];
      if (kt + ROW0 + 63 >= twB) sb_tile_weights2<true>(ztB, w, RB, kt + ROW0, tqB, g); else sb_tile_weights2<false>(ztB, w, RB, kt + ROW0, tqB, g);
#pragma unroll
      for (int p = 0; p < 2; ++p) wfB[p] = pack8(w[p][0], w[p][1], w[p][2], w[p][3], w[p][4], w[p][5], w[p][6], w[p][7]); }
#pragma unroll
    for (int p = 0; p < 2; ++p) {
        const int ko = ROW0 + 32 * p;
#pragma unroll
        for (int md = 0; md < 8; ++md) { const bf16x8 vf = *(const LAS bf16x8*)(stg + 32768 + (ko >> 6) * 16384 + pg8::lds_byte(16 * md + c, (ko & 63) + 8 * g));
            otA[md] = MFMA16(vf, wfA[p], otA[md]); otB[md] = MFMA16(vf, wfB[p], otB[md]); }
    }
}

template <bool DUMMY>
__device__ __forceinline__ void sb_attn_wg(Frame& F, int b, int hd, int qb2, int popt = 0) {
    const int tid = F.tid, lane = F.lane, wave = F.wave, c = lane & 15, g = lane >> 4;
    LAS unsigned char* const lds = F.lds + RING_OFF;
    const bf16* const proj = (const bf16*)(F.ws + WS_PROJ); const bf16* const KBp = (const bf16*)(F.ws + WS_KB); const bf16* const VTp = (const bf16*)(F.ws + WS_VT); bf16* const mix = (bf16*)(F.ws + WS_MIX);
    const int t0 = qb2 * 256;
    const int twA = t0 + 128 + 16 * wave, tqA = twA + c, twB = t0 + 16 * wave, tqB = twB + c;
    const size_t mrow = (size_t)b * SEQ;
    int R0, C0, R1, C1; pg8::stage_rc(tid * 16, R0, C0); pg8::stage_rc(tid * 16 + 8192, R1, C1);
    const bf16* const ksrc0 = KBp + ((size_t)hd * M + mrow + kperm(R0)) * 128 + C0;
    const bf16* const ksrc1 = KBp + ((size_t)hd * M + mrow + kperm(R1)) * 128 + C1;
    const bf16* const vsrc0 = VTp + (((size_t)hd * (M / 64) + mrow / 64) * 128 + R0) * 64 + C0;
    const bf16* const vsrc1 = VTp + (((size_t)hd * (M / 64) + mrow / 64) * 128 + R1) * 64 + C1;
    const unsigned ldsw = (unsigned)wave * 1024u;
#define SB_STAGE(s, kt) do { LAS unsigned char* d_ = lds + (s) * 65536 + ldsw; \
        glds16(ksrc0 + (size_t)(kt) * 128, d_); glds16(ksrc1 + (size_t)(kt) * 128, d_ + 8192); glds16(ksrc0 + (size_t)(kt) * 128 + 64, d_ + 16384); glds16(ksrc1 + (size_t)(kt) * 128 + 64, d_ + 24576); \
        glds16(vsrc0 + (size_t)(kt) * 128, d_ + 32768); glds16(vsrc1 + (size_t)(kt) * 128, d_ + 40960); glds16(vsrc0 + (size_t)(kt) * 128 + 8192, d_ + 49152); glds16(vsrc1 + (size_t)(kt) * 128 + 8192, d_ + 57344); } while (0)
    volatile LAS unsigned* const flg = (volatile LAS unsigned*)(F.lds + LDSCTL_OFF + 1024);
    bf16x8 qfA[4], qfB[4];
    { const bf16* qp = proj + (mrow + tqA) * INC + hd * 128 + 8 * g;
#pragma unroll
      for (int kk = 0; kk < 4; ++kk) qfA[kk] = *(const GAS bf16x8*)(qp + 32 * kk); }
    { const bf16* qp = proj + (mrow + tqB) * INC + hd * 128 + 8 * g;
#pragma unroll
      for (int kk = 0; kk < 4; ++kk) qfB[kk] = *(const GAS bf16x8*)(qp + 32 * kk); }
    f32x4 otA[8], otB[8];
#pragma unroll
    for (int md = 0; md < 8; ++md) { otA[md] = (f32x4){0.f, 0.f, 0.f, 0.f}; otB[md] = (f32x4){0.f, 0.f, 0.f, 0.f}; }
    float RA = 1.f, RB = 1.f;
    bool doneA = false, doneB = false;
    int kt = t0 + 128, j = 0;
    SB_STAGE(0, kt);
#define SB_TILE_STEP(S) { \
        WG_BAR();                                    \
        if (j > 0) { unsigned nd = 0; \
            _Pragma("unroll") for (int w = 0; w < 8; ++w) nd += flg[(j & 1) * 8 + w]; \
            if (nd == 8u) break; } \
        if (kt < 0) break; \
        const int ktn = kt - 128; \
        if (ktn >= 0 && popt != 5) SB_STAGE((S) ^ 1, ktn); \
        if (popt >= 4) { if (j >= 3) { doneA = true; doneB = true; } } \
        if (popt != 4) { \
        { const bool bIn = !doneB && kt < twB + 15;                       \
          const bool a64 = !doneA && (kt + 64 < twA + 15), b64 = bIn && (kt + 64 < twB + 15); \
          if (a64 && b64) sb_compute_joint<64>(lds + (S) * 65536, qfA, qfB, otA, otB, RA, RB, kt, tqA, twA, tqB, twB, c, g); \
          else if (a64) sb_compute<2, 64>(lds + (S) * 65536, qfA, otA, RA, kt, tqA, twA, c, g); \
          else if (b64) sb_compute<2, 64>(lds + (S) * 65536, qfB, otB, RB, kt, tqB, twB, c, g); \
          if (a64 && __all(RA == 0.0f)) doneA = true; \
          if (b64 && __all(RB == 0.0f)) doneB = true; \
          const bool a0 = !doneA, b0 = bIn && !doneB; \
          if (a0 && b0) sb_compute_joint<0>(lds + (S) * 65536, qfA, qfB, otA, otB, RA, RB, kt, tqA, twA, tqB, twB, c, g); \
          else if (a0) sb_compute<2, 0>(lds + (S) * 65536, qfA, otA, RA, kt, tqA, twA, c, g); \
          else if (b0) sb_compute<2, 0>(lds + (S) * 65536, qfB, otB, RB, kt, tqB, twB, c, g); \
          if (a0 && __all(RA == 0.0f)) doneA = true; \
          if (b0 && __all(RB == 0.0f)) doneB = true; } \
        } \
        if (popt >= 4 && j < 3) { doneA = false; doneB = false; } \
        if (lane == 0) flg[((j + 1) & 1) * 8 + wave] = (doneA && doneB) ? 1u : 0u; \
        kt = ktn; ++j; }
    if (DUMMY) { WG_BAR(); } else
    for (;;) { SB_TILE_STEP(0) SB_TILE_STEP(1) }
#undef SB_TILE_STEP
#undef SB_STAGE
    if (popt < 4)
#pragma unroll
    for (int q = 0; q < 2; ++q) { const size_t row = mrow + (q == 0 ? tqA : tqB);
#pragma unroll
        for (int md = 0; md < 8; ++md) { const int d0 = hd * 128 + 16 * md + 4 * g;
            const v2u gt = *(const GAS v2u*)(proj + row * INC + MAINW + d0);
            const f32x4 o4 = q == 0 ? otA[md] : otB[md];
            v2u o; o.x = pk2(o4[0] * silu_f(bflo(gt.x)), o4[1] * silu_f(bfhi(gt.x))); o.y = pk2(o4[2] * silu_f(bflo(gt.y)), o4[3] * silu_f(bfhi(gt.y)));
            *(GAS v2u*)(mix + row * MIXW + d0) = o; } }
    asm volatile("s_waitcnt lgkmcnt(0)" ::: "memory"); __builtin_amdgcn_s_barrier(); asm volatile("" ::: "memory");
}

__device__ __forceinline__ void mem_attn_wg(Frame& F, int layer, int b, int mh, int qb) {
    const int tid = F.tid, lane = F.lane, wave = F.wave, c = lane & 15, g = lane >> 4;
    LAS unsigned char* const lds = F.lds + RING_OFF;
    const bf16* const proj = (const bf16*)(F.ws + WS_PROJ); const bf16* const memk = (const bf16*)(F.ws + WS_MEMK); const bf16* const memvt = (const bf16*)(F.ws + WS_MEMVT); bf16* const mix = (bf16*)(F.ws + WS_MIX);
    const size_t row0 = (size_t)b * SEQ + qb * 256 + 32 * wave + c;
    const int fbase = layer * MEMW + mh * 256;
    const unsigned ldsw = (unsigned)wave * 1024u;
    int Rr[2], Cc[2]; pg8::stage_rc(tid * 16, Rr[0], Cc[0]); pg8::stage_rc(tid * 16 + 8192, Rr[1], Cc[1]);
#pragma unroll
    for (int kh = 0; kh < 2; ++kh)
#pragma unroll
        for (int dq = 0; dq < 4; ++dq)
#pragma unroll
            for (int i = 0; i < 2; ++i) glds16(memk + (size_t)(b * MEM_T + 128 * kh + kperm(Rr[i])) * (DEPTH * MEMW) + fbase + 64 * dq + Cc[i], lds + kh * 65536 + dq * 16384 + i * 8192 + ldsw);
    bf16x8 qf[2][8];
#pragma unroll
    for (int q = 0; q < 2; ++q) { const bf16* qp = proj + (row0 + 16 * q) * INC + 2 * MAINW + mh * 256 + 8 * g;
#pragma unroll
      for (int kk = 0; kk < 8; ++kk) qf[q][kk] = *(const GAS bf16x8*)(qp + 32 * kk); }
    WG_BAR();
    f32x4 st[2][16];
#pragma unroll
    for (int fg = 0; fg < 16; ++fg) { st[0][fg] = (f32x4){0.f, 0.f, 0.f, 0.f}; st[1][fg] = (f32x4){0.f, 0.f, 0.f, 0.f}; }
#pragma unroll
    for (int kh = 0; kh < 2; ++kh)
#pragma unroll
        for (int kk = 0; kk < 8; ++kk)
#pragma unroll
            for (int f = 0; f < 8; ++f) { const bf16x8 kf = *(const LAS bf16x8*)(lds + kh * 65536 + (kk >> 1) * 16384 + pg8::lds_byte(16 * f + c, 32 * (kk & 1) + 8 * g));
                st[0][8 * kh + f] = MFMA16(kf, qf[0][kk], st[0][8 * kh + f]); st[1][8 * kh + f] = MFMA16(kf, qf[1][kk], st[1][8 * kh + f]); }
    float inv[2];
    bf16x8 pf[2][8];
#pragma unroll
    for (int q = 0; q < 2; ++q) {
        float mx = -3.0e38f;
#pragma unroll
        for (int f = 0; f < 16; ++f)
#pragma unroll
            for (int r = 0; r < 4; ++r) mx = fmaxf(mx, st[q][f][r]);
        mx = fmaxf(mx, __shfl_xor(mx, 16)); mx = fmaxf(mx, __shfl_xor(mx, 32));
        float den = 0.f;
#pragma unroll
        for (int f = 0; f < 16; ++f)
#pragma unroll
            for (int r = 0; r < 4; ++r) { const float p = __builtin_amdgcn_exp2f(st[q][f][r] - mx); st[q][f][r] = p; den += p; }
        den += __shfl_xor(den, 16); den += __shfl_xor(den, 32);
        inv[q] = 1.0f / den;
#pragma unroll
        for (int pg = 0; pg < 8; ++pg) { const int fa = 8 * (pg >> 2) + 2 * (pg & 3); pf[q][pg] = pack8(st[q][fa][0], st[q][fa][1], st[q][fa][2], st[q][fa][3], st[q][fa + 1][0], st[q][fa + 1][1], st[q][fa + 1][2], st[q][fa + 1][3]); }
    }
    WG_BAR();
#pragma unroll
    for (int kh = 0; kh < 2; ++kh)
#pragma unroll
        for (int dh = 0; dh < 2; ++dh)
#pragma unroll
            for (int kq = 0; kq < 2; ++kq)
#pragma unroll
                for (int i = 0; i < 2; ++i) glds16(memvt + (size_t)(fbase + 128 * dh + Rr[i]) * (BATCH * MEM_T) + b * MEM_T + 128 * kh + 64 * kq + Cc[i], lds + kh * 65536 + (dh * 2 + kq) * 16384 + i * 8192 + ldsw);
    v2u gtm[2][2][8];
#pragma unroll
    for (int half = 0; half < 2; ++half)
#pragma unroll
        for (int q = 0; q < 2; ++q)
#pragma unroll
            for (int md = 0; md < 8; ++md) gtm[half][q][md] = *(const GAS v2u*)(proj + (row0 + 16 * q) * INC + 2 * MAINW + MEMW + mh * 256 + 128 * half + 16 * md + 4 * g);
    WG_BAR();
#pragma unroll
    for (int half = 0; half < 2; ++half) {
        f32x4 ot[2][8];
#pragma unroll
        for (int md = 0; md < 8; ++md) { ot[0][md] = (f32x4){0.f, 0.f, 0.f, 0.f}; ot[1][md] = (f32x4){0.f, 0.f, 0.f, 0.f}; }
#pragma unroll
        for (int pg = 0; pg < 8; ++pg) { const int kh = pg >> 2, p = pg & 3;
#pragma unroll
            for (int md = 0; md < 8; ++md) { const bf16x8 vf = *(const LAS bf16x8*)(lds + kh * 65536 + (half * 2 + (p >> 1)) * 16384 + pg8::lds_byte(16 * md + c, 32 * (p & 1) + 8 * g));
                ot[0][md] = MFMA16(vf, pf[0][pg], ot[0][md]); ot[1][md] = MFMA16(vf, pf[1][pg], ot[1][md]); } }
#pragma unroll
        for (int q = 0; q < 2; ++q)
#pragma unroll
            for (int md = 0; md < 8; ++md) { const int d0 = mh * 256 + 128 * half + 16 * md + 4 * g; const size_t row = row0 + 16 * q;
                const v2u gt = gtm[half][q][md];
                v2u o; o.x = pk2(ot[q][md][0] * inv[q] * silu_f(bflo(gt.x)), ot[q][md][1] * inv[q] * silu_f(bfhi(gt.x))); o.y = pk2(ot[q][md][2] * inv[q] * silu_f(bflo(gt.y)), ot[q][md][3] * inv[q] * silu_f(bfhi(gt.y)));
                *(GAS v2u*)(mix + row * MIXW + MAINW + d0) = o; }
    }
    WG_BAR();
}

__device__ __forceinline__ void lru_carry_phase(Frame& F) {
    const int gw = F.vcu * NWAVES + F.wave, NGW = F.G * NWAVES;
    const float* agg = (const float*)(F.ws + WS_AGG); float* carry = (float*)(F.ws + WS_CARRY);
    for (int u = gw; u < BATCH * (MAINW / 64); u += NGW) {
        const int b = u / (MAINW / 64), chn = (u % (MAINW / 64)) * 64 + F.lane;
        float hc = 0.f;
#pragma unroll 1
        for (int c0 = 0; c0 < LRU_NC; c0 += 16) {
            f32x2 ag[16];
#pragma unroll
            for (int i = 0; i < 16; ++i) ag[i] = *(const GAS f32x2*)(agg + ((size_t)(b * LRU_NC + c0 + i) * MAINW + chn) * 2);
#pragma unroll
            for (int i = 0; i < 16; ++i) { *(GAS float*)(carry + (size_t)(b * LRU_NC + c0 + i) * MAINW + chn) = hc; hc = ag[i].x * hc + ag[i].y; }
        }
    }
}

template <bool FINAL>
__device__ __forceinline__ void lru_unit(Frame& F, int layer, int b, int n, int ch) {
    const int tid = F.tid, lane = F.lane, wave = F.wave, c = lane & 15, g = lane >> 4;
    const bf16* proj = (const bf16*)(F.ws + WS_PROJ);
    const float* const conv_w = inp(F, I_CONV_W); const float* const conv_b = inp(F, I_CONV_B);
    LAS bf16* ut = (LAS bf16*)(F.lds + RING_OFF);
    const int t0 = ch * LRU_T; const size_t mrow = (size_t)b * SEQ;
    {
        const int cg = tid & 31, rg = tid >> 5;
        const int col = 256 * n + 8 * cg;
        float cw[4][8], cb[8];
#pragma unroll
        for (int k = 0; k < 4; ++k) { const f32x4 a = *(const GAS f32x4*)(conv_w + ((size_t)layer * 4 + k) * MAINW + col), bb = *(const GAS f32x4*)(conv_w + ((size_t)layer * 4 + k) * MAINW + col + 4);
            cw[k][0] = a.x; cw[k][1] = a.y; cw[k][2] = a.z; cw[k][3] = a.w; cw[k][4] = bb.x; cw[k][5] = bb.y; cw[k][6] = bb.z; cw[k][7] = bb.w; }
        { const f32x4 a = *(const GAS f32x4*)(conv_b + (size_t)layer * MAINW + col), bb = *(const GAS f32x4*)(conv_b + (size_t)layer * MAINW + col + 4);
            cb[0] = a.x; cb[1] = a.y; cb[2] = a.z; cb[3] = a.w; cb[4] = bb.x; cb[5] = bb.y; cb[6] = bb.z; cb[7] = bb.w; }
        float xr[11][8];
#pragma unroll
        for (int i = 0; i < 11; ++i) { const int t = t0 + rg * 8 - 3 + i;
            v4u raw = (v4u){0u, 0u, 0u, 0u};
            if (t >= 0) raw = *(const GAS v4u*)(proj + (mrow + t) * INC + col);
            xr[i][0] = bflo(raw.x); xr[i][1] = bfhi(raw.x); xr[i][2] = bflo(raw.y); xr[i][3] = bfhi(raw.y); xr[i][4] = bflo(raw.z); xr[i][5] = bfhi(raw.z); xr[i][6] = bflo(raw.w); xr[i][7] = bfhi(raw.w); }
#pragma unroll
        for (int tt = 0; tt < 8; ++tt) { float u[8];
#pragma unroll
            for (int e = 0; e < 8; ++e) u[e] = cb[e] + cw[0][e] * xr[tt][e] + cw[1][e] * xr[tt + 1][e] + cw[2][e] * xr[tt + 2][e] + cw[3][e] * xr[tt + 3][e];
            v4u o; o.x = pk2(u[0], u[1]); o.y = pk2(u[2], u[3]); o.z = pk2(u[4], u[5]); o.w = pk2(u[6], u[7]);
            *(LAS v4u*)(ut + (rg * 8 + tt) * UT_PITCH + 8 * cg) = o; }
    }
    __syncthreads();
    float* agg = (float*)(F.ws + WS_AGG);
    const bf16* wg = (const bf16*)(F.ws + WS_WG) + (size_t)(layer * LRU_NB + n) * 512 * 256;
#pragma unroll 1
    for (int nf = 0; nf < 2; ++nf) {
        const int chl = 32 * wave + 16 * nf + c;
        const int chn = 256 * n + chl;
        const bf16* const gbase = proj + (mrow + t0) * INC + MAINW + 256 * n;
        bf16* const obase = (bf16*)(F.ws + WS_MIX) + (mrow + t0) * MIXW + 256 * n;
        const int goff = (4 * g) * INC + chl, ooff = (4 * g) * MIXW + chl;
        unsigned short gtv[8][4];
        if (FINAL) {
#pragma unroll
            for (int mf = 0; mf < 8; ++mf)
#pragma unroll
                for (int r = 0; r < 4; ++r) gtv[mf][r] = *(const GAS bf16*)(gbase + (16 * mf + r) * INC + goff);
        }
        f32x4 acc[8][2];
#pragma unroll
        for (int mf = 0; mf < 8; ++mf) { acc[mf][0] = (f32x4){0.f, 0.f, 0.f, 0.f}; acc[mf][1] = (f32x4){0.f, 0.f, 0.f, 0.f}; }
        bf16x8 bfr[8][2];
#pragma unroll
        for (int kk = 0; kk < 8; ++kk)
#pragma unroll
            for (int ga = 0; ga < 2; ++ga) bfr[kk][ga] = *(const GAS bf16x8*)(wg + (size_t)(ga * 256 + chl) * 256 + 32 * kk + 8 * g);
#pragma unroll
        for (int kk = 0; kk < 8; ++kk) {
            bf16x8 afr[8];
#pragma unroll
            for (int mf = 0; mf < 8; ++mf) afr[mf] = *(const LAS bf16x8*)(ut + (16 * mf + c) * UT_PITCH + 32 * kk + 8 * g);
#pragma unroll
            for (int mf = 0; mf < 8; ++mf) { acc[mf][0] = MFMA16(afr[mf], bfr[kk][0], acc[mf][0]); acc[mf][1] = MFMA16(afr[mf], bfr[kk][1], acc[mf][1]); }
            asm volatile("" ::: "memory");
        }
        {
            const float ba = inp(F, I_GATE_A_B)[(size_t)layer * MAINW + chn], bx = inp(F, I_GATE_X_B)[(size_t)layer * MAINW + chn];
            const float c8 = -8.0f * softplus_f(-inp(F, I_LAM)[(size_t)layer * MAINW + chn]);
#pragma unroll
            for (int mf = 0; mf < 8; ++mf)
#pragma unroll
                for (int r = 0; r < 4; ++r) {
                    const float rr = fast_sigmoid(acc[mf][0][r] + ba), ii = fast_sigmoid(acc[mf][1][r] + bx);
                    const float a = fast_exp(c8 * rr);
                    const float uval = bf2f(ut[(16 * mf + 4 * g + r) * UT_PITCH + chl]);
                    const float om = fmaxf(1.0f - a * a, 0.f);
                    acc[mf][0][r] = a; acc[mf][1][r] = __builtin_amdgcn_sqrtf(om) * (ii * uval);
                }
        }
        float hc = 0.f;
        float PT = 1.f;
        if (FINAL) {
            hc = *(const GAS float*)((const float*)(F.ws + WS_CARRY) + (size_t)(b * LRU_NC + ch) * MAINW + chn);
        }
#pragma unroll
        for (int mf = 0; mf < 8; ++mf) {
            float A = 1.f, B = 0.f;
#pragma unroll
            for (int r = 0; r < 4; ++r) { const float a = acc[mf][0][r]; A *= a; B = a * B + acc[mf][1][r]; }
            float Ai = A, Bi = B;
            { const float Ap = __shfl_up(Ai, 16), Bp = __shfl_up(Bi, 16); if (g >= 1) { Bi = Ai * Bp + Bi; Ai = Ap * Ai; } }
            { const float Ap = __shfl_up(Ai, 32), Bp = __shfl_up(Bi, 32); if (g >= 2) { Bi = Ai * Bp + Bi; Ai = Ap * Ai; } }
            const float Af = __shfl(Ai, 48 + c), Bf = __shfl(Bi, 48 + c);
            if (FINAL) {
                float Ae = __shfl_up(Ai, 16), Be = __shfl_up(Bi, 16); if (g == 0) { Ae = 1.f; Be = 0.f; }
                float h = Ae * hc + Be;
#pragma unroll
                for (int r = 0; r < 4; ++r) { h = acc[mf][0][r] * h + acc[mf][1][r];
                    const float gt = bf2f(gtv[mf][r]);
                    *(GAS bf16*)(obase + (16 * mf + r) * MIXW + ooff) = (bf16)f2bf(h * silu_f(gt)); }
                hc = Af * hc + Bf;
            } else { hc = Af * hc + Bf; PT *= Af; }
        }
        if (!FINAL && g == 0) { f32x2 o; o.x = PT; o.y = hc; *(GAS f32x2*)(agg + ((size_t)(b * LRU_NC + ch) * MAINW + chn) * 2) = o; }
    }
    __syncthreads();
}

#if PL_LRU
#define LRX16 xor16
#define LRX32 xor32
#else
#define LRX16 xor16s
#define LRX32 xor32s
#endif
__device__ __forceinline__ void lru_unit_chain(Frame& F, int layer, int b, int n, int ch, int popt = 0) {
    constexpr bool FINAL = true;
    const int tid = F.tid, lane = F.lane, wave = F.wave, c = lane & 15, g = lane >> 4;
    const bf16* proj = (const bf16*)(F.ws + WS_PROJ);
    const float* const conv_w = inp(F, I_CONV_W); const float* const conv_b = inp(F, I_CONV_B);
    LAS bf16* ut = (LAS bf16*)(F.lds + RING_OFF);
    const int t0 = ch * LRU_T; const size_t mrow = (size_t)b * SEQ;
    {
        const int cg = tid & 31, rg = tid >> 5;
        const int col = 256 * n + 8 * cg;
        float cw[4][8], cb[8];
#pragma unroll
        for (int k = 0; k < 4; ++k) { const f32x4 a = *(const GAS f32x4*)(conv_w + ((size_t)layer * 4 + k) * MAINW + col), bb = *(const GAS f32x4*)(conv_w + ((size_t)layer * 4 + k) * MAINW + col + 4);
            cw[k][0] = a.x; cw[k][1] = a.y; cw[k][2] = a.z; cw[k][3] = a.w; cw[k][4] = bb.x; cw[k][5] = bb.y; cw[k][6] = bb.z; cw[k][7] = bb.w; }
        { const f32x4 a = *(const GAS f32x4*)(conv_b + (size_t)layer * MAINW + col), bb = *(const GAS f32x4*)(conv_b + (size_t)layer * MAINW + col + 4);
            cb[0] = a.x; cb[1] = a.y; cb[2] = a.z; cb[3] = a.w; cb[4] = bb.x; cb[5] = bb.y; cb[6] = bb.z; cb[7] = bb.w; }
        float xr[11][8];
#pragma unroll
        for (int i = 0; i < 11; ++i) { const int t = t0 + rg * 8 - 3 + i;
            v4u raw = (v4u){0u, 0u, 0u, 0u};
            if (t >= 0) raw = *(const GAS v4u*)(proj + (mrow + t) * INC + col);
            xr[i][0] = bflo(raw.x); xr[i][1] = bfhi(raw.x); xr[i][2] = bflo(raw.y); xr[i][3] = bfhi(raw.y); xr[i][4] = bflo(raw.z); xr[i][5] = bfhi(raw.z); xr[i][6] = bflo(raw.w); xr[i][7] = bfhi(raw.w); }
#pragma unroll
        for (int tt = 0; tt < 8; ++tt) { float u[8];
#pragma unroll
            for (int e = 0; e < 8; ++e) u[e] = cb[e] + cw[0][e] * xr[tt][e] + cw[1][e] * xr[tt + 1][e] + cw[2][e] * xr[tt + 2][e] + cw[3][e] * xr[tt + 3][e];
            v4u o; o.x = pk2(u[0], u[1]); o.y = pk2(u[2], u[3]); o.z = pk2(u[4], u[5]); o.w = pk2(u[6], u[7]);
            const int tl = rg * 8 + tt;
            *(LAS v4u*)(ut + (16 * ((tl >> 2) & 7) + 4 * (tl >> 5) + (tl & 3)) * UT_PITCH + 8 * cg) = o; }
    }
    __syncthreads();
    const bf16* wg = (const bf16*)(F.ws + WS_WG) + (size_t)(layer * LRU_NB + n) * 512 * 256;
#pragma unroll 1
    for (int nf = 0; nf < 2; ++nf) {
        const int chl = 32 * wave + 16 * nf + c;
        const int chn = 256 * n + chl;
        const bf16* const gbase = proj + (mrow + t0) * INC + MAINW + 256 * n;
        bf16* const obase = (bf16*)(F.ws + WS_MIX) + (mrow + t0) * MIXW + 256 * n;
        const unsigned goff = (unsigned)((32 * g) * INC + chl), ooff = (unsigned)((32 * g) * MIXW + chl);
        unsigned short gtv[8][4];
        if (FINAL) {
#pragma unroll
            for (int mf = 0; mf < 8; ++mf)
#pragma unroll
                for (int r = 0; r < 4; ++r) gtv[mf][r] = ((const GAS bf16*)gbase)[(unsigned)((4 * mf + r) * INC) + goff];
        }
        f32x4 acc[8][2];
#pragma unroll
        for (int mf = 0; mf < 8; ++mf) { acc[mf][0] = (f32x4){0.f, 0.f, 0.f, 0.f}; acc[mf][1] = (f32x4){0.f, 0.f, 0.f, 0.f}; }
        bf16x8 bfr[8][2];
#pragma unroll
        for (int kk = 0; kk < 8; ++kk)
#pragma unroll
            for (int ga = 0; ga < 2; ++ga) bfr[kk][ga] = *(const GAS bf16x8*)(wg + (size_t)(ga * 256 + chl) * 256 + 32 * kk + 8 * g);
        bf16x8 afA[4], afB[4];
#pragma unroll
        for (int i = 0; i < 4; ++i) afA[i] = *(const LAS bf16x8*)(ut + (16 * i + c) * UT_PITCH + 8 * g);
#pragma unroll
        for (int kk = 0; kk < 8; ++kk) {
#pragma unroll
            for (int i = 0; i < 4; ++i) afB[i] = *(const LAS bf16x8*)(ut + (16 * (4 + i) + c) * UT_PITCH + 32 * kk + 8 * g);
#pragma unroll
            for (int i = 0; i < 4; ++i) { acc[i][0] = MFMA16(afA[i], bfr[kk][0], acc[i][0]); acc[i][1] = MFMA16(afA[i], bfr[kk][1], acc[i][1]); }
            asm volatile("" ::: "memory");
            if (kk < 7) {
#pragma unroll
                for (int i = 0; i < 4; ++i) afA[i] = *(const LAS bf16x8*)(ut + (16 * i + c) * UT_PITCH + 32 * (kk + 1) + 8 * g); }
#pragma unroll
            for (int i = 0; i < 4; ++i) { acc[4 + i][0] = MFMA16(afB[i], bfr[kk][0], acc[4 + i][0]); acc[4 + i][1] = MFMA16(afB[i], bfr[kk][1], acc[4 + i][1]); }
            asm volatile("" ::: "memory");
        }
        {
            const float L2E = 1.44269504089f;
            const float ban = -L2E * inp(F, I_GATE_A_B)[(size_t)layer * MAINW + chn], bxn = -L2E * inp(F, I_GATE_X_B)[(size_t)layer * MAINW + chn];
            const float c8 = -8.0f * L2E * softplus_f(-inp(F, I_LAM)[(size_t)layer * MAINW + chn]);
#pragma unroll
            for (int mf = 0; mf < 8; ++mf)
#pragma unroll
                for (int r = 0; r < 4; r += 2) {
                    f32x2 xa, xi; xa.x = acc[mf][0][r]; xa.y = acc[mf][0][r + 1]; xi.x = acc[mf][1][r]; xi.y = acc[mf][1][r + 1];
                    const f32x2 ta = __builtin_elementwise_fma(xa, (f32x2){-L2E, -L2E}, (f32x2){ban, ban}), ti = __builtin_elementwise_fma(xi, (f32x2){-L2E, -L2E}, (f32x2){bxn, bxn});
                    f32x2 da, di; da.x = __builtin_amdgcn_exp2f(ta.x); da.y = __builtin_amdgcn_exp2f(ta.y); di.x = __builtin_amdgcn_exp2f(ti.x); di.y = __builtin_amdgcn_exp2f(ti.y);
                    da = da + (f32x2){1.0f, 1.0f}; di = di + (f32x2){1.0f, 1.0f};
                    f32x2 rr, ii; rr.x = __builtin_amdgcn_rcpf(da.x); rr.y = __builtin_amdgcn_rcpf(da.y); ii.x = __builtin_amdgcn_rcpf(di.x); ii.y = __builtin_amdgcn_rcpf(di.y);
                    const f32x2 ca = rr * (f32x2){c8, c8};
                    f32x2 a; a.x = __builtin_amdgcn_exp2f(ca.x); a.y = __builtin_amdgcn_exp2f(ca.y);
                    f32x2 uv; uv.x = bf2f(ut[(16 * mf + 4 * g + r) * UT_PITCH + chl]); uv.y = bf2f(ut[(16 * mf + 4 * g + r + 1) * UT_PITCH + chl]);
                    const f32x2 om = __builtin_elementwise_fma(-a, a, (f32x2){1.0f, 1.0f});
                    f32x2 sq; sq.x = __builtin_amdgcn_sqrtf(fmaxf(om.x, 0.f)); sq.y = __builtin_amdgcn_sqrtf(fmaxf(om.y, 0.f));
                    const f32x2 bb = sq * (ii * uv);
                    acc[mf][0][r] = a.x; acc[mf][0][r + 1] = a.y; acc[mf][1][r] = bb.x; acc[mf][1][r + 1] = bb.y;
                }
        }
        float A = 1.f, B = 0.f;
#pragma unroll
        for (int mf = 0; mf < 8; ++mf)
#pragma unroll
            for (int r = 0; r < 4; ++r) { const float a = acc[mf][0][r]; A *= a; B = a * B + acc[mf][1][r]; }
        float Ae, Be, PT, HT;
        { const float A16 = LRX16(A, g), B16 = LRX16(B, g);
          const bool odd = (g & 1) != 0, hi2 = (g & 2) != 0;
          const float PA = A * A16, PB = odd ? (A * B16 + B) : (A16 * B + B16);
          const float Aw = odd ? A16 : 1.f, Bw = odd ? B16 : 0.f;
          const float PA32 = LRX32(PA, g), PB32 = LRX32(PB, g);
          Ae = hi2 ? PA32 * Aw : Aw; Be = hi2 ? (Aw * PB32 + Bw) : Bw;
          PT = PA * PA32; HT = hi2 ? (PA * PB32 + PB) : (PA32 * PB + PB32); }
        typedef GAS unsigned long long gu64;
        gu64* const gr = (gu64*)(F.ws + WS_GRAN) + (size_t)((b * LRU_NB + n) * LRU_NC) * 512;
        const unsigned long long tagw = (unsigned long long)(layer + 1) << 32;
        if (g == 0 && popt == 0) { __hip_atomic_store(gr + (size_t)ch * 512 + chl * 2, tagw | __builtin_bit_cast(unsigned, PT), __ATOMIC_RELAXED, __HIP_MEMORY_SCOPE_AGENT);
                      __hip_atomic_store(gr + (size_t)ch * 512 + chl * 2 + 1, tagw | __builtin_bit_cast(unsigned, HT), __ATOMIC_RELAXED, __HIP_MEMORY_SCOPE_AGENT); }
        float hc = 0.f;
        if (ch > 0 && popt != 6) {
            const int q = (ch + 3) >> 2, lo = g * q, hi = (lo + q) < ch ? (lo + q) : ch;
            float Pg = 1.f, Hg = 0.f;
#pragma unroll 1
            for (int bs = 0; bs < q; bs += 8) {
                unsigned long long gp[8], gh[8]; unsigned spins = 0;
                for (;;) { bool ok = true;
#pragma unroll
                    for (int i = 0; i < 8; ++i) { const int cc = lo + bs + i; if (cc < hi) {
                        gp[i] = __hip_atomic_load(gr + (size_t)cc * 512 + chl * 2, __ATOMIC_RELAXED, __HIP_MEMORY_SCOPE_AGENT);
                        gh[i] = __hip_atomic_load(gr + (size_t)cc * 512 + chl * 2 + 1, __ATOMIC_RELAXED, __HIP_MEMORY_SCOPE_AGENT);
                        ok = ok && ((gp[i] >> 32) == (unsigned long long)(layer + 1)) && ((gh[i] >> 32) == (unsigned long long)(layer + 1)); } }
                    if (__all(ok)) break;
                    __builtin_amdgcn_s_sleep(2);
                    if (++spins > (1u << 17)) { if (lane == 0) __hip_atomic_store((GAS unsigned*)(F.ws + WS_CTL) + CW_TMO, 1u, __ATOMIC_RELAXED, __HIP_MEMORY_SCOPE_AGENT); break; }
                }
#pragma unroll
                for (int i = 0; i < 8; ++i) { const int cc = lo + bs + i; if (cc < hi) { const float P = __builtin_bit_cast(float, (unsigned)gp[i]), H = __builtin_bit_cast(float, (unsigned)gh[i]); Hg = P * Hg + H; Pg = P * Pg; } }
            }
            const float A16 = LRX16(Pg, g), B16 = LRX16(Hg, g);
            const bool odd = (g & 1) != 0;
            const float PA = Pg * A16, PB = odd ? (Pg * B16 + Hg) : (A16 * Hg + B16);
            const float PA32 = LRX32(PA, g), PB32 = LRX32(PB, g);
            hc = (g & 2) ? (PA * PB32 + PB) : (PA32 * PB + PB32);
        }
        float h = Ae * hc + Be;
#pragma unroll
        for (int mf = 0; mf < 8; ++mf)
#pragma unroll
            for (int r = 0; r < 4; r += 2) {
                f32x2 gt; gt.x = bf2f(gtv[mf][r]); gt.y = bf2f(gtv[mf][r + 1]);
                const f32x2 tg = gt * (f32x2){-1.44269504089f, -1.44269504089f};
                f32x2 dg; dg.x = __builtin_amdgcn_exp2f(tg.x); dg.y = __builtin_amdgcn_exp2f(tg.y); dg = dg + (f32x2){1.0f, 1.0f};
                f32x2 rg; rg.x = __builtin_amdgcn_rcpf(dg.x); rg.y = __builtin_amdgcn_rcpf(dg.y);
                f32x2 hv; h = acc[mf][0][r] * h + acc[mf][1][r]; hv.x = h; h = acc[mf][0][r + 1] * h + acc[mf][1][r + 1]; hv.y = h;
                const f32x2 ov = hv * (gt * rg);
                if (popt == 0) { ((GAS bf16*)obase)[(unsigned)((4 * mf + r) * MIXW) + ooff] = (bf16)f2bf(ov.x); ((GAS bf16*)obase)[(unsigned)((4 * mf + r + 1) * MIXW) + ooff] = (bf16)f2bf(ov.y); }
                else asm volatile("" :: "v"(ov.x), "v"(ov.y)); }
    }
    __syncthreads();
}

#ifndef PROBE_MEMREP
#define PROBE_MEMREP 1
#endif
#ifndef PROBE_SBDUMMY
#define PROBE_SBDUMMY 0
#endif
#ifndef PROBE_OPT
#define PROBE_OPT 0
#endif
#ifndef PROBE_MASK
#define PROBE_MASK 0
#endif
#ifndef PROBE_TAIL
#define PROBE_TAIL 0
#define PROBE_TAIL_T 50.0f
#endif
#ifndef PROBE_CLK
#define PROBE_CLK 0
#define PROBE_LAYER 3
#endif
#ifndef MK_ONE_LAUNCH
#define MK_ONE_LAUNCH 1
#endif
constexpr int NPHASES = 2 + 6 * DEPTH;
struct Args { const float* in[17]; float* out; unsigned char* ws; int ph_lo, ph_hi, opt, pad; };
__global__ void __launch_bounds__(NWAVES * 64, 2) yoco_fwd(Args args) {
    extern __shared__ __attribute__((aligned(16))) unsigned char lds[];
    Frame F;
    F.lds = (LAS unsigned char*)lds;
    volatile LAS unsigned* MISC = (volatile LAS unsigned*)(F.lds + MISC_OFF);
    F.tid = threadIdx.x; F.lane = F.tid & 63; F.wave = __builtin_amdgcn_readfirstlane(F.tid >> 6);
    F.G = gridDim.x; { const int bx = blockIdx.x; F.vcu = (F.G % 8 == 0) ? (bx % 8) * (F.G / 8) + bx / 8 : bx; }
    F.out = args.out; F.ws = args.ws;
    unsigned* ctl = (unsigned*)(F.ws + WS_CTL);
    for (int u = F.tid; u < (LDS_BYTES - LDSCTL_OFF) / 4; u += NWAVES * 64) ((LAS unsigned*)(F.lds + LDSCTL_OFF))[u] = 0u;
    __syncthreads();
    if (F.tid < I_NIN) ((LAS unsigned long long*)(F.lds + PTR_OFF))[F.tid] = (unsigned long long)args.in[F.tid];
    __syncthreads();
    const int lo = args.ph_lo, hi = args.ph_hi;
    XcdBarrier bar; bar.bar = ctl + CW_BAR; bar.x = 0; bar.st = nullptr;
    if (hi - lo > 1) bar = xcd_barrier_post(ctl + CW_BAR, MISC + 8);
    long long pc0 = 0, pc1 = 0, pw0 = 0, pw1 = 0; (void)pc0; (void)pc1; (void)pw0; (void)pw1;
#define IN(k) (lo <= (k) && (k) < hi)
#define SEAM(k) do { if (IN(k) && IN((k) + 1)) xcd_barrier(bar); } while (0)

#define PHASE_PTRS() Frame P = F; P.ws = args.ws; LAUNDER_S(P.ws); P.out = args.out; LAUNDER_S(P.out); \
    { int t_ = threadIdx.x; asm volatile("" : "+v"(t_)); P.tid = t_; P.lane = t_ & 63; P.wave = __builtin_amdgcn_readfirstlane(t_ >> 6); } \
    const int gw = P.vcu * NWAVES + P.wave, NGW = P.G * NWAVES; (void)gw; (void)NGW; \
    bf16* const HB = (bf16*)(P.ws + WS_HB); bf16* const PROJ = (bf16*)(P.ws + WS_PROJ); bf16* const KB = (bf16*)(P.ws + WS_KB); bf16* const VT = (bf16*)(P.ws + WS_VT); \
    bf16* const MIX = (bf16*)(P.ws + WS_MIX); bf16* const OB = (bf16*)(P.ws + WS_OB); bf16* const MEMB = (bf16*)(P.ws + WS_MEMB); bf16* const MEMK = (bf16*)(P.ws + WS_MEMK); bf16* const MEMVT = (bf16*)(P.ws + WS_MEMVT); \
    (void)HB; (void)PROJ; (void)KB; (void)VT; (void)MIX; (void)OB; (void)MEMB; (void)MEMK; (void)MEMVT;

    if (IN(0)) { PHASE_PTRS();
#ifndef DIS_P0
        for (int it = gw; it < PW_MEM; it += NGW) p0_do(P, it);
#endif
 }
    SEAM(0);
    if (IN(1)) { PHASE_PTRS();
#ifndef DIS_GMEM
        { pg8::Gemm g{MEMB, (const bf16*)(P.ws + WS_WMK), BATCH * MEM_T, DEPTH * MEMW, DM}; pg8::StaticOrder S; S.init(BATCH * MEM_T, DEPTH * MEMW, F.G, (int)blockIdx.x);
          pg8::EpiBf16 E{MEMK, DEPTH * MEMW, nullptr, nullptr, 0.0625f * 1.44269504089f};
          pg8::gemm_phase<pg8::EpiBf16, pg8::StaticOrder, true, true>(F.lds + RING_OFF, g, S, E); }
        { pg8::Gemm g{(const bf16*)(P.ws + WS_WMV), MEMB, DEPTH * MEMW, BATCH * MEM_T, DM}; pg8::StaticOrder S; S.init(DEPTH * MEMW, BATCH * MEM_T, F.G, (int)((blockIdx.x + F.G / 2) % F.G));
          pg8::EpiBf16 E{MEMVT, BATCH * MEM_T, nullptr, nullptr, 1.0f};
          pg8::gemm_phase<pg8::EpiBf16, pg8::StaticOrder, true, true>(F.lds + RING_OFF, g, S, E); }
#endif
        {
            const int bx = (int)blockIdx.x; const bool isg = bx < 32 || (bx >= P.G / 2 && bx < P.G / 2 + 32);
            if (!isg && P.G == 256) { const int rank = (bx < 128 ? bx - 32 : bx - 64) * NWAVES + P.wave;
                for (int it = PW_MEM + rank; it < PW_SPLIT; it += 192 * NWAVES) p0_do(P, it); }
            for (int it = (P.G == 256 ? PW_SPLIT : PW_MEM) + gw; it < PW_END; it += NGW) p0_do(P, it);
        }
    }
    SEAM(1);
    { constexpr int l = 0;
        const int pb = 2 + 6 * l;
        if (IN(pb)) { PHASE_PTRS();
#if PROBE_CLK
            if (l == PROBE_LAYER) { pc0 = clock64(); pw0 = wall_clock64(); }
#endif
            { pg8::Gemm g{HB, win_ptr(P.ws, l), M, INC, DM}; pg8::StaticOrder S; S.init(M, INC, F.G, (int)blockIdx.x);
              pg8::EpiBf16 E{PROJ, INC, nullptr, nullptr, 1.0f};
              pg8::gemm_phase<pg8::EpiBf16, pg8::StaticOrder, true, true>(F.lds + RING_OFF, g, S, E); }
#ifndef DIS_GVT
            if (l == N_A) {
              { pg8::Gemm g{HB, (const bf16*)(P.ws + WS_WKV), M, MAINW, DM}; pg8::StaticOrder S; S.init(M, MAINW, F.G, (int)blockIdx.x);
                pg8::EpiKVTile<0, M> E{KB, nullptr, 0.08838834764831845f * 1.44269504089f};
                pg8::gemm_phase<pg8::EpiKVTile<0, M>, pg8::StaticOrder, true, true>(F.lds + RING_OFF, g, S, E); }
              { pg8::Gemm g{(const bf16*)(P.ws + WS_WKV) + (size_t)MAINW * DM, HB, MAINW, M, DM}; pg8::StaticOrder S; S.init(MAINW, M, F.G, (int)blockIdx.x);
                pg8::EpiKVTile<1, M> E{VT, nullptr, 1.0f};
                pg8::gemm_phase<pg8::EpiKVTile<1, M>, pg8::StaticOrder, true, true>(F.lds + RING_OFF, g, S, E); }
            }
#endif
#if PROBE_CLK
            if (l == PROBE_LAYER) { pc1 = clock64(); pw1 = wall_clock64(); }
#endif
#if PROBE_TAIL
            if (l == PROBE_LAYER && threadIdx.x == 0) { const unsigned long long t_ = wall_clock64(); atomicMax((unsigned long long*)(P.ws + WS_CTL) + 20, t_); atomicAdd((unsigned long long*)(P.ws + WS_CTL) + 21, t_); }
#endif
        }
        SEAM(pb);
        if (IN(pb + 1)) { PHASE_PTRS();
#ifndef DIS_LRU
            if (l < N_A) {
                const int xg = (int)blockIdx.x & 7, jg = (int)blockIdx.x >> 3;
                for (int k = jg; k < 3 * LRU_NC; k += (P.G >> 3)) { const int chain = 3 * xg + k % 3; lru_unit_chain(P, l, chain / LRU_NB, chain % LRU_NB, k / 3, args.opt); }
            }
#endif
#ifndef DIS_SB
            if (l >= N_A) { for (int u = P.vcu; u < (args.opt == 1 ? BATCH * SB_H * (SEQ / 256) / 2 : args.opt == 3 ? 0 : BATCH * SB_H * (SEQ / 256)); u += P.G) {
#if PROBE_SBDUMMY
                sb_attn_wg<true>(P, u / (SB_H * (SEQ / 256)), (u / (SEQ / 256)) % SB_H, u % (SEQ / 256));
#endif
                sb_attn_wg<false>(P, u / (SB_H * (SEQ / 256)), (u / (SEQ / 256)) % SB_H, u % (SEQ / 256), args.opt); } }
#endif
#ifndef DIS_MEM
            if (args.opt == 0 || args.opt == 3) for (int rep_ = 0; rep_ < PROBE_MEMREP; ++rep_)
            for (int u = P.vcu; u < BATCH * MEM_H * (SEQ / 256); u += P.G) mem_attn_wg(P, l, u / (MEM_H * (SEQ / 256)), (u / (SEQ / 256)) % MEM_H, u % (SEQ / 256));
#endif
        }
        SEAM(pb + 1);
        if (IN(pb + 4)) { PHASE_PTRS();
#ifndef DIS_G2
            pg8::Gemm g{MIX, (const bf16*)(P.ws + WS_WOUT) + (size_t)l * DM * MIXW, M, DM, MIXW}; pg8::StaticOrder S; S.init(M, DM, F.G, (int)blockIdx.x);
            pg8::EpiBf16SS E{OB, DM, (float*)(P.ws + WS_PART)};
            pg8::gemm_phase<pg8::EpiBf16SS, pg8::StaticOrder, true, true>(F.lds + RING_OFF, g, S, E);
#endif
        }
        SEAM(pb + 4);
#ifndef DIS_NR
        if (IN(pb + 5)) { PHASE_PTRS(); nr_phase<l>(P); }
#endif
        SEAM(pb + 5);
    }
    { constexpr int l = 1;
        const int pb = 2 + 6 * l;
        if (IN(pb)) { PHASE_PTRS();
#if PROBE_CLK
            if (l == PROBE_LAYER) { pc0 = clock64(); pw0 = wall_clock64(); }
#endif
            { pg8::Gemm g{HB, win_ptr(P.ws, l), M, INC, DM}; pg8::StaticOrder S; S.init(M, INC, F.G, (int)blockIdx.x);
              pg8::EpiBf16 E{PROJ, INC, nullptr, nullptr, 1.0f};
              pg8::gemm_phase<pg8::EpiBf16, pg8::StaticOrder, true, true>(F.lds + RING_OFF, g, S, E); }
#ifndef DIS_GVT
            if (l == N_A) {
              { pg8::Gemm g{HB, (const bf16*)(P.ws + WS_WKV), M, MAINW, DM}; pg8::StaticOrder S; S.init(M, MAINW, F.G, (int)blockIdx.x);
                pg8::EpiKVTile<0, M> E{KB, nullptr, 0.08838834764831845f * 1.44269504089f};
                pg8::gemm_phase<pg8::EpiKVTile<0, M>, pg8::StaticOrder, true, true>(F.lds + RING_OFF, g, S, E); }
              { pg8::Gemm g{(const bf16*)(P.ws + WS_WKV) + (size_t)MAINW * DM, HB, MAINW, M, DM}; pg8::StaticOrder S; S.init(MAINW, M, F.G, (int)blockIdx.x);
                pg8::EpiKVTile<1, M> E{VT, nullptr, 1.0f};
                pg8::gemm_phase<pg8::EpiKVTile<1, M>, pg8::StaticOrder, true, true>(F.lds + RING_OFF, g, S, E); }
            }
#endif
#if PROBE_CLK
            if (l == PROBE_LAYER) { pc1 = clock64(); pw1 = wall_clock64(); }
#endif
#if PROBE_TAIL
            if (l == PROBE_LAYER && threadIdx.x == 0) { const unsigned long long t_ = wall_clock64(); atomicMax((unsigned long long*)(P.ws + WS_CTL) + 20, t_); atomicAdd((unsigned long long*)(P.ws + WS_CTL) + 21, t_); }
#endif
        }
        SEAM(pb);
        if (IN(pb + 1)) { PHASE_PTRS();
#ifndef DIS_LRU
            if (l < N_A) {
                const int xg = (int)blockIdx.x & 7, jg = (int)blockIdx.x >> 3;
                for (int k = jg; k < 3 * LRU_NC; k += (P.G >> 3)) { const int chain = 3 * xg + k % 3; lru_unit_chain(P, l, chain / LRU_NB, chain % LRU_NB, k / 3, args.opt); }
            }
#endif
#ifndef DIS_SB
            if (l >= N_A) { for (int u = P.vcu; u < (args.opt == 1 ? BATCH * SB_H * (SEQ / 256) / 2 : args.opt == 3 ? 0 : BATCH * SB_H * (SEQ / 256)); u += P.G) {
#if PROBE_SBDUMMY
                sb_attn_wg<true>(P, u / (SB_H * (SEQ / 256)), (u / (SEQ / 256)) % SB_H, u % (SEQ / 256));
#endif
                sb_attn_wg<false>(P, u / (SB_H * (SEQ / 256)), (u / (SEQ / 256)) % SB_H, u % (SEQ / 256), args.opt); } }
#endif
#ifndef DIS_MEM
            if (args.opt == 0 || args.opt == 3) for (int rep_ = 0; rep_ < PROBE_MEMREP; ++rep_)
            for (int u = P.vcu; u < BATCH * MEM_H * (SEQ / 256); u += P.G) mem_attn_wg(P, l, u / (MEM_H * (SEQ / 256)), (u / (SEQ / 256)) % MEM_H, u % (SEQ / 256));
#endif
        }
        SEAM(pb + 1);
        if (IN(pb + 4)) { PHASE_PTRS();
#ifndef DIS_G2
            pg8::Gemm g{MIX, (const bf16*)(P.ws + WS_WOUT) + (size_t)l * DM * MIXW, M, DM, MIXW}; pg8::StaticOrder S; S.init(M, DM, F.G, (int)blockIdx.x);
            pg8::EpiBf16SS E{OB, DM, (float*)(P.ws + WS_PART)};
            pg8::gemm_phase<pg8::EpiBf16SS, pg8::StaticOrder, true, true>(F.lds + RING_OFF, g, S, E);
#endif
        }
        SEAM(pb + 4);
#ifndef DIS_NR
        if (IN(pb + 5)) { PHASE_PTRS(); nr_phase<l>(P); }
#endif
        SEAM(pb + 5);
    }
    { constexpr int l = 2;
        const int pb = 2 + 6 * l;
        if (IN(pb)) { PHASE_PTRS();
#if PROBE_CLK
            if (l == PROBE_LAYER) { pc0 = clock64(); pw0 = wall_clock64(); }
#endif
            { pg8::Gemm g{HB, win_ptr(P.ws, l), M, INC, DM}; pg8::StaticOrder S; S.init(M, INC, F.G, (int)blockIdx.x);
              pg8::EpiBf16 E{PROJ, INC, nullptr, nullptr, 1.0f};
              pg8::gemm_phase<pg8::EpiBf16, pg8::StaticOrder, true, true>(F.lds + RING_OFF, g, S, E); }
#ifndef DIS_GVT
            if (l == N_A) {
              { pg8::Gemm g{HB, (const bf16*)(P.ws + WS_WKV), M, MAINW, DM}; pg8::StaticOrder S; S.init(M, MAINW, F.G, (int)blockIdx.x);
                pg8::EpiKVTile<0, M> E{KB, nullptr, 0.08838834764831845f * 1.44269504089f};
                pg8::gemm_phase<pg8::EpiKVTile<0, M>, pg8::StaticOrder, true, true>(F.lds + RING_OFF, g, S, E); }
              { pg8::Gemm g{(const bf16*)(P.ws + WS_WKV) + (size_t)MAINW * DM, HB, MAINW, M, DM}; pg8::StaticOrder S; S.init(MAINW, M, F.G, (int)blockIdx.x);
                pg8::EpiKVTile<1, M> E{VT, nullptr, 1.0f};
                pg8::gemm_phase<pg8::EpiKVTile<1, M>, pg8::StaticOrder, true, true>(F.lds + RING_OFF, g, S, E); }
            }
#endif
#if PROBE_CLK
            if (l == PROBE_LAYER) { pc1 = clock64(); pw1 = wall_clock64(); }
#endif
#if PROBE_TAIL
            if (l == PROBE_LAYER && threadIdx.x == 0) { const unsigned long long t_ = wall_clock64(); atomicMax((unsigned long long*)(P.ws + WS_CTL) + 20, t_); atomicAdd((unsigned long long*)(P.ws + WS_CTL) + 21, t_); }
#endif
        }
        SEAM(pb);
        if (IN(pb + 1)) { PHASE_PTRS();
#ifndef DIS_LRU
            if (l < N_A) {
                const int xg = (int)blockIdx.x & 7, jg = (int)blockIdx.x >> 3;
                for (int k = jg; k < 3 * LRU_NC; k += (P.G >> 3)) { const int chain = 3 * xg + k % 3; lru_unit_chain(P, l, chain / LRU_NB, chain % LRU_NB, k / 3, args.opt); }
            }
#endif
#ifndef DIS_SB
            if (l >= N_A) { for (int u = P.vcu; u < (args.opt == 1 ? BATCH * SB_H * (SEQ / 256) / 2 : args.opt == 3 ? 0 : BATCH * SB_H * (SEQ / 256)); u += P.G) {
#if PROBE_SBDUMMY
                sb_attn_wg<true>(P, u / (SB_H * (SEQ / 256)), (u / (SEQ / 256)) % SB_H, u % (SEQ / 256));
#endif
                sb_attn_wg<false>(P, u / (SB_H * (SEQ / 256)), (u / (SEQ / 256)) % SB_H, u % (SEQ / 256), args.opt); } }
#endif
#ifndef DIS_MEM
            if (args.opt == 0 || args.opt == 3) for (int rep_ = 0; rep_ < PROBE_MEMREP; ++rep_)
            for (int u = P.vcu; u < BATCH * MEM_H * (SEQ / 256); u += P.G) mem_attn_wg(P, l, u / (MEM_H * (SEQ / 256)), (u / (SEQ / 256)) % MEM_H, u % (SEQ / 256));
#endif
        }
        SEAM(pb + 1);
        if (IN(pb + 4)) { PHASE_PTRS();
#ifndef DIS_G2
            pg8::Gemm g{MIX, (const bf16*)(P.ws + WS_WOUT) + (size_t)l * DM * MIXW, M, DM, MIXW}; pg8::StaticOrder S; S.init(M, DM, F.G, (int)blockIdx.x);
            pg8::EpiBf16SS E{OB, DM, (float*)(P.ws + WS_PART)};
            pg8::gemm_phase<pg8::EpiBf16SS, pg8::StaticOrder, true, true>(F.lds + RING_OFF, g, S, E);
#endif
        }
        SEAM(pb + 4);
#ifndef DIS_NR
        if (IN(pb + 5)) { PHASE_PTRS(); nr_phase<l>(P); }
#endif
        SEAM(pb + 5);
    }
    { constexpr int l = 3;
        const int pb = 2 + 6 * l;
        if (IN(pb)) { PHASE_PTRS();
#if PROBE_CLK
            if (l == PROBE_LAYER) { pc0 = clock64(); pw0 = wall_clock64(); }
#endif
            { pg8::Gemm g{HB, win_ptr(P.ws, l), M, INC, DM}; pg8::StaticOrder S; S.init(M, INC, F.G, (int)blockIdx.x);
              pg8::EpiBf16 E{PROJ, INC, nullptr, nullptr, 1.0f};
              pg8::gemm_phase<pg8::EpiBf16, pg8::StaticOrder, true, true>(F.lds + RING_OFF, g, S, E); }
#ifndef DIS_GVT
            if (l == N_A) {
              { pg8::Gemm g{HB, (const bf16*)(P.ws + WS_WKV), M, MAINW, DM}; pg8::StaticOrder S; S.init(M, MAINW, F.G, (int)blockIdx.x);
                pg8::EpiKVTile<0, M> E{KB, nullptr, 0.08838834764831845f * 1.44269504089f};
                pg8::gemm_phase<pg8::EpiKVTile<0, M>, pg8::StaticOrder, true, true>(F.lds + RING_OFF, g, S, E); }
              { pg8::Gemm g{(const bf16*)(P.ws + WS_WKV) + (size_t)MAINW * DM, HB, MAINW, M, DM}; pg8::StaticOrder S; S.init(MAINW, M, F.G, (int)blockIdx.x);
                pg8::EpiKVTile<1, M> E{VT, nullptr, 1.0f};
                pg8::gemm_phase<pg8::EpiKVTile<1, M>, pg8::StaticOrder, true, true>(F.lds + RING_OFF, g, S, E); }
            }
#endif
#if PROBE_CLK
            if (l == PROBE_LAYER) { pc1 = clock64(); pw1 = wall_clock64(); }
#endif
#if PROBE_TAIL
            if (l == PROBE_LAYER && threadIdx.x == 0) { const unsigned long long t_ = wall_clock64(); atomicMax((unsigned long long*)(P.ws + WS_CTL) + 20, t_); atomicAdd((unsigned long long*)(P.ws + WS_CTL) + 21, t_); }
#endif
        }
        SEAM(pb);
        if (IN(pb + 1)) { PHASE_PTRS();
#ifndef DIS_LRU
            if (l < N_A) {
                const int xg = (int)blockIdx.x & 7, jg = (int)blockIdx.x >> 3;
                for (int k = jg; k < 3 * LRU_NC; k += (P.G >> 3)) { const int chain = 3 * xg + k % 3; lru_unit_chain(P, l, chain / LRU_NB, chain % LRU_NB, k / 3, args.opt); }
            }
#endif
#ifndef DIS_SB
            if (l >= N_A) { for (int u = P.vcu; u < (args.opt == 1 ? BATCH * SB_H * (SEQ / 256) / 2 : args.opt == 3 ? 0 : BATCH * SB_H * (SEQ / 256)); u += P.G) {
#if PROBE_SBDUMMY
                sb_attn_wg<true>(P, u / (SB_H * (SEQ / 256)), (u / (SEQ / 256)) % SB_H, u % (SEQ / 256));
#endif
                sb_attn_wg<false>(P, u / (SB_H * (SEQ / 256)), (u / (SEQ / 256)) % SB_H, u % (SEQ / 256), args.opt); } }
#endif
#ifndef DIS_MEM
            if (args.opt == 0 || args.opt == 3) for (int rep_ = 0; rep_ < PROBE_MEMREP; ++rep_)
            for (int u = P.vcu; u < BATCH * MEM_H * (SEQ / 256); u += P.G) mem_attn_wg(P, l, u / (MEM_H * (SEQ / 256)), (u / (SEQ / 256)) % MEM_H, u % (SEQ / 256));
#endif
        }
        SEAM(pb + 1);
        if (IN(pb + 4)) { PHASE_PTRS();
#ifndef DIS_G2
            pg8::Gemm g{MIX, (const bf16*)(P.ws + WS_WOUT) + (size_t)l * DM * MIXW, M, DM, MIXW}; pg8::StaticOrder S; S.init(M, DM, F.G, (int)blockIdx.x);
            pg8::EpiBf16SS E{OB, DM, (float*)(P.ws + WS_PART)};
            pg8::gemm_phase<pg8::EpiBf16SS, pg8::StaticOrder, true, true>(F.lds + RING_OFF, g, S, E);
#endif
        }
        SEAM(pb + 4);
#ifndef DIS_NR
        if (IN(pb + 5)) { PHASE_PTRS(); nr_phase<l>(P); }
#endif
        SEAM(pb + 5);
    }
#if PROBE_TAIL
    xcd_barrier(bar);
    if (blockIdx.x == 0 && threadIdx.x == 0) { const unsigned long long mx = ((unsigned long long*)(args.ws + WS_CTL))[20], sm = ((unsigned long long*)(args.ws + WS_CTL))[21]; const float tail_us = ((float)(long long)(mx - sm / 256ull)) * 0.01f; if (tail_us > PROBE_TAIL_T) args.out[0] += 1000.0f; }
#endif
#if PROBE_CLK
    xcd_barrier(bar);
    if (blockIdx.x == 0 && threadIdx.x == 0) { const float ghz = (float)(pc1 - pc0) / ((float)(pw1 - pw0) * 10.0f); args.out[0] += (PROBE_CLK == 1 ? (ghz > PROBE_T ? 1000.0f : 0.0f) : (float)(pw1 - pw0) * 0.01f); }
#endif
#undef IN
#undef SEAM
}

extern "C" void kernel_launch(void* const* d_in, const int* in_sizes, int n_in, void* d_out, int out_size, void* d_ws, size_t ws_size, hipStream_t stream) {
    static int grid = 0;
    if (grid == 0) {
        if (n_in != 17 || in_sizes[0] != M * DM || out_size != M * DM || ws_size < WS_END) { fprintf(stderr, "kernel_launch: unexpected shapes (n_in %d, in0 %d, out %d, ws %zu); nothing launched\n", n_in, n_in > 0 ? in_sizes[0] : -1, out_size, ws_size); grid = -1; return; }
        int dev = 0, cus = 0, per_cu = 0;
        if (hipGetDevice(&dev) != hipSuccess || hipDeviceGetAttribute(&cus, hipDeviceAttributeMultiprocessorCount, dev) != hipSuccess) { grid = -1; return; }
        if (hipFuncSetAttribute((const void*)yoco_fwd, hipFuncAttributeMaxDynamicSharedMemorySize, LDS_BYTES) != hipSuccess) { fprintf(stderr, "kernel_launch: hipFuncSetAttribute failed\n"); grid = -1; return; }
        if (hipOccupancyMaxActiveBlocksPerMultiprocessor(&per_cu, (const void*)yoco_fwd, NWAVES * 64, LDS_BYTES) != hipSuccess || per_cu < 1)
            fprintf(stderr, "kernel_launch: note: occupancy query reports %d workgroups per CU\n", per_cu);
        (void)hipGetLastError();
        grid = cus;
    }
    if (grid < 0) return;
    if (hipMemsetAsync((char*)d_ws + WS_CTL, 0, CTL_ZERO_BYTES, stream) != hipSuccess) return;
    Args a{};
    for (int i = 0; i < 17; ++i) a.in[i] = (const float*)d_in[i];
    a.out = (float*)d_out; a.ws = (unsigned char*)d_ws;
#if MK_ONE_LAUNCH
    a.ph_lo = 0; a.ph_hi = NPHASES;
    hipLaunchKernelGGL(yoco_fwd, dim3(grid), dim3(NWAVES * 64), LDS_BYTES, stream, a);
#else
    for (int ph = 0; ph < NPHASES; ++ph) {
        if (ph >= 2 && ((ph - 2) % 6 == 2 || (ph - 2) % 6 == 3)) continue;
        a.ph_lo = ph; a.ph_hi = ph + 1;
        for (int rep = 0; rep < (((PROBE_MASK >> ph) & 1) ? 2 : 1); ++rep) {
            a.opt = rep ? PROBE_OPT : 0;
            hipLaunchKernelGGL(yoco_fwd, dim3(grid), dim3(NWAVES * 64), LDS_BYTES, stream, a); }
        a.opt = 0;
    }
#endif
}
```

```cpp
#include <hip/hip_runtime.h>
#include <cstdio>
#include <cstdint>
namespace pg8 {
#define PG8_LAS __attribute__((address_space(3)))
typedef unsigned short bf16_t;
typedef short bf16x8 __attribute__((ext_vector_type(8)));
typedef float f32x4 __attribute__((ext_vector_type(4)));
typedef unsigned u32x4 __attribute__((ext_vector_type(4)));
constexpr int BM = 256, BK = 64, HALF = 128, HTB = HALF * BK * 2  , STAGE_BYTES = 8 * HTB, NXCD = 8, WGM = 8;

__host__ __device__ __forceinline__ int lds_byte(int r, int c) { const int st = (r >> 4) * 2 + (c >> 5), rr = r & 15, cc = c & 31, ob = rr * 64 + cc * 2; return st * 1024 + (ob ^ (((ob >> 9) & 1) << 5)); }
__host__ __device__ __forceinline__ void stage_rc(int b, int& R, int& C) { const int st = b / 1024, sb = b % 1024, swz = sb ^ (((sb >> 9) & 1) << 5); R = (st >> 1) * 16 + swz / 64; C = (st & 1) * 32 + (swz % 64) / 2; }
__host__ __device__ __forceinline__ int perm32(int rho) { const int n = rho >> 4, i = rho & 15; return 8 * (i >> 2) + 4 * n + (i & 3); }

struct Unit { int pm, pn; };
struct Gemm { const bf16_t* A; const bf16_t* Bt; int M, N, K; };

struct StaticOrder {
    int nM, nN, nwg, G, c;
    __host__ __device__ void init(int M, int N, int G_, int c_) { nM = M / BM; nN = N / BM; nwg = nM * nN; G = G_; c = c_; }
    __host__ __device__ bool next(int i, Unit& u) const {
        const long L = (long)i * G + c; if (L >= nwg) return false;
        int wgid = (int)L; { const int q = nwg / NXCD, r = nwg % NXCD, xcd = wgid % NXCD, off = wgid / NXCD; wgid = (xcd < r ? xcd * (q + 1) : r * (q + 1) + (xcd - r) * q) + off; }
        const int nig = WGM * nN, gid = wgid / nig, fm = gid * WGM, gsz = (nM - fm) < WGM ? (nM - fm) : WGM;
        u.pm = fm + ((wgid % nig) % gsz); u.pn = (wgid % nig) / gsz; return true;
    }
    __device__ __forceinline__ void a_ready(const Unit&) const {}
    __device__ __forceinline__ void done(const Unit&) const {}
};

__device__ __forceinline__ unsigned cvt_pk_bf16(float lo, float hi) { unsigned r; asm volatile("v_cvt_pk_bf16_f32 %0, %1, %2" : "=v"(r) : "v"(lo), "v"(hi)); return r; }

struct EpiBf16 {
    static constexpr bool PERM = true, AFTER_DRAIN = false;
    bf16_t* O; int ldc; const float* rscale; const float* cscale; float ks;
    __device__ __forceinline__ void operator()(const f32x4 (&acc)[2][2][4][2], const Unit& u, int wr, int wc, int fr, int fq) const {
        const int row0 = u.pm * BM + wr * 64 + fr; const int col0 = u.pn * BM + wc * 32 + 8 * fq;
        f32x4 cs[2][2];
#pragma unroll
        for (int bj = 0; bj < 2; ++bj)
#pragma unroll
            for (int n = 0; n < 2; ++n) cs[bj][n] = cscale ? *(const f32x4*)(cscale + col0 + bj * HALF + 4 * n) : (f32x4){1.f, 1.f, 1.f, 1.f};
#pragma unroll
        for (int ai = 0; ai < 2; ++ai)
#pragma unroll
            for (int m = 0; m < 4; ++m) { const int row = row0 + ai * HALF + m * 16; bf16_t* rowp = O + (size_t)row * ldc + col0; const float rs = (rscale ? rscale[row] : 1.f) * ks;
#pragma unroll
                for (int bj = 0; bj < 2; ++bj) { const f32x4 v0 = acc[ai][bj][m][0] * rs * cs[bj][0], v1 = acc[ai][bj][m][1] * rs * cs[bj][1];
                    u32x4 w; w.x = cvt_pk_bf16(v0[0], v0[1]); w.y = cvt_pk_bf16(v0[2], v0[3]); w.z = cvt_pk_bf16(v1[0], v1[1]); w.w = cvt_pk_bf16(v1[2], v1[3]);
                    *(u32x4*)(rowp + bj * HALF) = w; } }
    }
};
template <int MODE, int M_> struct EpiKVTile {
    static constexpr bool PERM = true, AFTER_DRAIN = false;
    bf16_t* O; const float* scale; float ks;
    __device__ __forceinline__ void operator()(const f32x4 (&acc)[2][2][4][2], const Unit& u, int wr, int wc, int fr, int fq) const {
        const int row0 = u.pm * BM + wr * 64 + fr; const int col0 = u.pn * BM + wc * 32 + 8 * fq;
        f32x4 cs[2][2];
#pragma unroll
        for (int bj = 0; bj < 2; ++bj)
#pragma unroll
            for (int n = 0; n < 2; ++n) cs[bj][n] = (MODE == 1 && scale) ? *(const f32x4*)(scale + col0 + bj * HALF + 4 * n) : (f32x4){1.f, 1.f, 1.f, 1.f};
#pragma unroll
        for (int ai = 0; ai < 2; ++ai)
#pragma unroll
            for (int m = 0; m < 4; ++m) { const int row = row0 + ai * HALF + m * 16; const float rs = ((MODE == 0 && scale) ? scale[row] : 1.f) * ks;
#pragma unroll
                for (int bj = 0; bj < 2; ++bj) { const f32x4 v0 = acc[ai][bj][m][0] * rs * cs[bj][0], v1 = acc[ai][bj][m][1] * rs * cs[bj][1];
                    u32x4 w; w.x = cvt_pk_bf16(v0[0], v0[1]); w.y = cvt_pk_bf16(v0[2], v0[3]); w.z = cvt_pk_bf16(v1[0], v1[1]); w.w = cvt_pk_bf16(v1[2], v1[3]);
                    const int col = col0 + bj * HALF;
                    size_t off;
                    if (MODE == 0) off = ((size_t)(col >> 7) * M_ + row) * 128 + (col & 127);
                    else off = (((size_t)(row >> 7) * (M_ / 64) + (col >> 6)) * 128 + (row & 127)) * 64 + (col & 63);
                    *(u32x4*)(O + off) = w; } }
    }
};
struct EpiBf16SS {
    static constexpr bool PERM = true, AFTER_DRAIN = false;
    bf16_t* O; int ldc; float* part;
    __device__ __forceinline__ void operator()(const f32x4 (&acc)[2][2][4][2], const Unit& u, int wr, int wc, int fr, int fq) const {
        const int row0 = u.pm * BM + wr * 64 + fr; const int col0 = u.pn * BM + wc * 32 + 8 * fq;
#pragma unroll
        for (int ai = 0; ai < 2; ++ai)
#pragma unroll
            for (int m = 0; m < 4; ++m) { const int row = row0 + ai * HALF + m * 16; bf16_t* rowp = O + (size_t)row * ldc + col0; float ss = 0.f;
#pragma unroll
                for (int bj = 0; bj < 2; ++bj) { const f32x4 v0 = acc[ai][bj][m][0], v1 = acc[ai][bj][m][1];
                    ss += (v0[0] * v0[0] + v0[1] * v0[1]) + (v0[2] * v0[2] + v0[3] * v0[3]) + (v1[0] * v1[0] + v1[1] * v1[1]) + (v1[2] * v1[2] + v1[3] * v1[3]);
                    u32x4 w; w.x = cvt_pk_bf16(v0[0], v0[1]); w.y = cvt_pk_bf16(v0[2], v0[3]); w.z = cvt_pk_bf16(v1[0], v1[1]); w.w = cvt_pk_bf16(v1[2], v1[3]);
                    *(u32x4*)(rowp + bj * HALF) = w; }
                ss += __shfl_xor(ss, 16); ss += __shfl_xor(ss, 32);
                if (fq == 0) part[(size_t)row * 64 + u.pn * 4 + wc] = ss; }
    }
};

template <class Epi, class Sched, bool ALIGN_EPI = false, bool SP2 = false>
__device__ __forceinline__ void gemm_phase(PG8_LAS unsigned char* lds, const Gemm g, const Sched& S, const Epi& E) {
    int tid_l = threadIdx.x; asm volatile("" : "+v"(tid_l));
    const int tid = tid_l, wid = __builtin_amdgcn_readfirstlane(tid >> 6), lane = tid & 63, wr = wid >> 2, wc = wid & 3, fr = lane & 15, fq = lane >> 4;
    const int K = g.K, nt = K / BK;
    unsigned voffA[2], voffB[2];
#pragma unroll
    for (int i = 0; i < 2; ++i) { int R, C; stage_rc(tid * 16 + i * 8192, R, C); const int Rb = Epi::PERM ? ((R & ~31) + perm32(R & 31)) : R;
        voffA[i] = (unsigned)(R * K + C) * 2u; voffB[i] = (unsigned)(Rb * K + C) * 2u; }
    const size_t kstep = (size_t)(BK * 2);
    const size_t hstep = (size_t)HALF * K * 2;
    const size_t tstep = 2 * hstep;
    const unsigned ldsw = (unsigned)wid * 1024u;
    const int aoff = lds_byte(wr * 64 + fr, fq * 8), boff = lds_byte(wc * 32 + fr, fq * 8);
#define PG8_SA(b, h) (((b) * 2 + (h)) * HTB)
#define PG8_SB(b, h) ((4 + (b) * 2 + (h)) * HTB)
#define PG8_STAGE(bufoff, gbase, voff) do { _Pragma("unroll") for (int _i = 0; _i < 2; ++_i) \
        __builtin_amdgcn_global_load_lds((const unsigned*)((const char*)(gbase) + (voff)[_i]), (PG8_LAS unsigned*)(lds + (bufoff) + ldsw + _i * 8192), 16, 0, 0); } while (0)
#define PG8_LDA(dst, b, h) do { _Pragma("unroll") for (int m = 0; m < 4; ++m) _Pragma("unroll") for (int k = 0; k < 2; ++k) dst[m][k] = *(const PG8_LAS bf16x8*)(lds + PG8_SA(b, h) + aoff + m * 2048 + k * 1024); } while (0)
#define PG8_LDB(dst, b, h) do { _Pragma("unroll") for (int n = 0; n < 2; ++n) _Pragma("unroll") for (int k = 0; k < 2; ++k) dst[n][k] = *(const PG8_LAS bf16x8*)(lds + PG8_SB(b, h) + boff + n * 2048 + k * 1024); } while (0)
#define PG8_MMA(ai, bj, At, Bt) do { __builtin_amdgcn_s_setprio(1); _Pragma("unroll") for (int m = 0; m < 4; ++m) _Pragma("unroll") for (int n = 0; n < 2; ++n) _Pragma("unroll") for (int k = 0; k < 2; ++k) \
        acc[ai][bj][m][n] = __builtin_amdgcn_mfma_f32_16x16x32_bf16(Bt[n][k], At[m][k], acc[ai][bj][m][n], 0, 0, 0); __builtin_amdgcn_s_setprio(0); } while (0)
#define PG8_WAIT_V(n) asm volatile("s_waitcnt vmcnt(" #n ")" ::: "memory")
#define PG8_WAIT_L(n) asm volatile("s_waitcnt lgkmcnt(" #n ")" ::: "memory")
#define PG8_BAR __builtin_amdgcn_s_barrier()
#define PG8_SCHED __builtin_amdgcn_sched_barrier(0)
    Unit cur, nxt; int ui = 0;
    if (!S.next(0, cur)) return;
    f32x4 acc[2][2][4][2];
#pragma unroll
    for (int a = 0; a < 2; ++a)
#pragma unroll
        for (int b = 0; b < 2; ++b)
#pragma unroll
            for (int m = 0; m < 4; ++m)
#pragma unroll
                for (int n = 0; n < 2; ++n) acc[a][b][m][n] = (f32x4){0.f, 0.f, 0.f, 0.f};
    bf16x8 At[4][2], B0[2][2], B1[2][2];
    const char* cA = (const char*)g.A + (size_t)cur.pm * tstep; const char* cB = (const char*)g.Bt + (size_t)cur.pn * tstep;
    S.a_ready(cur);
    if constexpr (SP2) {
        PG8_STAGE(PG8_SB(0, 0), cB, voffB); PG8_STAGE(PG8_SB(0, 1), cB + hstep, voffB); PG8_STAGE(PG8_SA(0, 0), cA, voffA); PG8_STAGE(PG8_SA(0, 1), cA + hstep, voffA);
        if (wr == 1) PG8_BAR;
        PG8_WAIT_V(2); PG8_BAR;
        PG8_STAGE(PG8_SB(1, 0), cB + kstep, voffB); PG8_STAGE(PG8_SA(1, 0), cA + kstep, voffA); PG8_STAGE(PG8_SB(1, 1), cB + hstep + kstep, voffB);
        PG8_WAIT_V(6); PG8_BAR;
    } else {
        PG8_STAGE(PG8_SB(0, 0), cB, voffB); PG8_STAGE(PG8_SA(0, 0), cA, voffA); PG8_STAGE(PG8_SB(0, 1), cB + hstep, voffB); PG8_STAGE(PG8_SA(0, 1), cA + hstep, voffA);
        if (wr == 1) PG8_BAR;
        PG8_WAIT_V(4); PG8_BAR;
        PG8_STAGE(PG8_SB(1, 0), cB + kstep, voffB); PG8_STAGE(PG8_SA(1, 0), cA + kstep, voffA); PG8_STAGE(PG8_SB(1, 1), cB + hstep + kstep, voffB);
        PG8_WAIT_V(6); PG8_BAR;
    }
    for (;;) {
        const bool has_next = S.next(ui + 1, nxt);
        const char* nA = has_next ? (const char*)g.A + (size_t)nxt.pm * tstep : cA; const char* nB = has_next ? (const char*)g.Bt + (size_t)nxt.pn * tstep : cB;
        for (int t = 0; t < nt; t += 2) {
            const bool last = (t == nt - 2);
            const char* a1 = cA + (size_t)(t + 1) * kstep;
            const char* a2 = last ? nA : cA + (size_t)(t + 2) * kstep; const char* b2 = last ? nB : cB + (size_t)(t + 2) * kstep;
            const char* a3 = a2 + kstep; const char* b3 = b2 + kstep;
            if (last && has_next) S.a_ready(nxt);
            if constexpr (SP2) {
            PG8_LDB(B0, 0, 0); PG8_LDB(B1, 0, 1); PG8_SCHED; PG8_LDA(At, 0, 0); PG8_STAGE(PG8_SA(1, 1), a1 + hstep, voffA);
            PG8_WAIT_V(8); PG8_WAIT_L(0); PG8_BAR; PG8_MMA(0, 0, At, B0); PG8_MMA(0, 1, At, B1); PG8_BAR; PG8_SCHED;
            PG8_LDA(At, 0, 1); PG8_STAGE(PG8_SB(0, 0), b2, voffB); PG8_STAGE(PG8_SB(0, 1), b2 + hstep, voffB); PG8_STAGE(PG8_SA(0, 0), a2, voffA);
            PG8_WAIT_V(8); PG8_WAIT_L(0); PG8_BAR; PG8_MMA(1, 0, At, B0); PG8_MMA(1, 1, At, B1); PG8_BAR; PG8_SCHED;
            PG8_LDB(B0, 1, 0); PG8_LDB(B1, 1, 1); PG8_SCHED; PG8_LDA(At, 1, 0); PG8_STAGE(PG8_SA(0, 1), a2 + hstep, voffA);
            PG8_WAIT_V(8); PG8_WAIT_L(0); PG8_BAR; PG8_MMA(0, 0, At, B0); PG8_MMA(0, 1, At, B1); PG8_BAR; PG8_SCHED;
            PG8_LDA(At, 1, 1); PG8_STAGE(PG8_SB(1, 0), b3, voffB); PG8_STAGE(PG8_SB(1, 1), b3 + hstep, voffB); PG8_STAGE(PG8_SA(1, 0), a3, voffA);
            PG8_WAIT_V(8); PG8_WAIT_L(0); PG8_BAR; PG8_MMA(1, 0, At, B0); PG8_MMA(1, 1, At, B1); PG8_BAR; PG8_SCHED;
            } else {
            PG8_LDB(B0, 0, 0); PG8_SCHED; PG8_LDA(At, 0, 0); PG8_STAGE(PG8_SA(1, 1), a1 + hstep, voffA);
            PG8_WAIT_L(8); PG8_BAR; PG8_WAIT_L(0); PG8_MMA(0, 0, At, B0); PG8_BAR; PG8_SCHED;
            PG8_LDB(B1, 0, 1); PG8_STAGE(PG8_SB(0, 0), b2, voffB);
            PG8_BAR; PG8_WAIT_L(0); PG8_MMA(0, 1, At, B1); PG8_BAR;
            PG8_LDA(At, 0, 1); PG8_STAGE(PG8_SA(0, 0), a2, voffA);
            PG8_BAR; PG8_WAIT_L(0); PG8_MMA(1, 0, At, B0); PG8_BAR; PG8_SCHED;
            PG8_STAGE(PG8_SB(0, 1), b2 + hstep, voffB);
            PG8_WAIT_V(6); PG8_BAR; PG8_MMA(1, 1, At, B1); PG8_BAR;
            PG8_LDB(B0, 1, 0); PG8_SCHED; PG8_LDA(At, 1, 0); PG8_STAGE(PG8_SA(0, 1), a2 + hstep, voffA);
            PG8_WAIT_L(8); PG8_BAR; PG8_WAIT_L(0); PG8_MMA(0, 0, At, B0); PG8_BAR; PG8_SCHED;
            PG8_LDB(B1, 1, 1); PG8_STAGE(PG8_SB(1, 0), b3, voffB);
            PG8_BAR; PG8_WAIT_L(0); PG8_MMA(0, 1, At, B1); PG8_BAR;
            PG8_LDA(At, 1, 1); PG8_STAGE(PG8_SA(1, 0), a3, voffA);
            PG8_BAR; PG8_WAIT_L(0); PG8_MMA(1, 0, At, B0); PG8_BAR; PG8_SCHED;
            PG8_STAGE(PG8_SB(1, 1), b3 + hstep, voffB);
            PG8_WAIT_V(6); PG8_BAR; PG8_MMA(1, 1, At, B1); PG8_BAR;
            }
        }
        if constexpr (ALIGN_EPI) { if (wr == 0) PG8_BAR; }
        if constexpr (!Epi::AFTER_DRAIN) { E(acc, cur, wr, wc, fr, fq); S.done(cur); }
        if (!has_next) break;
#pragma unroll
        for (int a = 0; a < 2; ++a)
#pragma unroll
            for (int b = 0; b < 2; ++b)
#pragma unroll
                for (int m = 0; m < 4; ++m)
#pragma unroll
                    for (int n = 0; n < 2; ++n) acc[a][b][m][n] = (f32x4){0.f, 0.f, 0.f, 0.f};
        cur = nxt; cA = nA; cB = nB; ++ui;
        if constexpr (ALIGN_EPI) { if (wr == 1) PG8_BAR; }
    }
    PG8_WAIT_V(0);
    if constexpr (!ALIGN_EPI) { if (wr == 0) PG8_BAR; }
    PG8_BAR;
    if constexpr (Epi::AFTER_DRAIN) { E.fused(acc, cur, wr, wc, fr, fq, lds, wid, lane); S.done(cur); }
#undef PG8_SA
#undef PG8_SB
#undef PG8_STAGE
#undef PG8_LDA
#undef PG8_LDB
#undef PG8_MMA
#undef PG8_WAIT_V
#undef PG8_WAIT_L
#undef PG8_BAR
#undef PG8_SCHED
}
}
constexpr int BATCH = 2, SEQ = 8192, DM = 4096, M = BATCH * SEQ, DEPTH = 4, N_A = 2;
constexpr int MAINW = 3072, MEMW = 1024, INC = 8192, MIXW = 4096, KVW = 6144;
constexpr int LRU_NB = 12, SB_H = 24, MEM_T = 256, MEM_H = 4;
constexpr float EPS = 1e-6f;
constexpr int NWAVES = 8;
constexpr int LRU_T = 128, LRU_NC = SEQ / LRU_T;

constexpr size_t MiB = 1u << 20;
constexpr size_t WS_CTL = 0, CTL_ZERO_BYTES = 8 * MiB;
constexpr size_t WS_GRAN = 1 * MiB;
constexpr int CW_TMO = 16;
constexpr size_t WS_WIN0 = 16 * MiB, WS_WKV = 272 * MiB;
constexpr size_t WS_WOUT = 320 * MiB;
constexpr size_t WS_WMK = 448 * MiB, WS_WMV = 480 * MiB;
constexpr size_t WS_WG = 512 * MiB;
constexpr size_t WS_HB = 520 * MiB;
constexpr size_t WS_MEMB = 648 * MiB;
constexpr size_t WS_MEMK = 652 * MiB;
constexpr size_t WS_MEMVT = 656 * MiB;
constexpr size_t WS_PROJ = 660 * MiB;
constexpr size_t WS_KB = 1400 * MiB;
constexpr size_t WS_VT = 1500 * MiB;
constexpr size_t WS_MIX = 1108 * MiB;
constexpr size_t WS_OB = 1236 * MiB;
constexpr size_t WS_PART = 1364 * MiB;
constexpr size_t WS_AGG = 1368 * MiB;
constexpr size_t WS_RSTD = 1372 * MiB + 512 * 1024;
constexpr size_t WS_CARRY = 1371 * MiB;
constexpr size_t WS_END = 1600 * MiB;
constexpr int KPITCH = MAINW + 64, VTPITCH = M + 64;
constexpr int CW_BAR = 4096;

constexpr int RING_OFF = 0, RING_BYTES = 131072;
constexpr int LDSCTL_OFF = RING_BYTES, MISC_OFF = LDSCTL_OFF + 320;
constexpr int LDS_BYTES = 147456;
constexpr int UT_PITCH = 264;

#define GAS __attribute__((address_space(1)))
#define LAS __attribute__((address_space(3)))
typedef unsigned short bf16;
typedef unsigned v4u __attribute__((ext_vector_type(4)));
typedef unsigned v2u __attribute__((ext_vector_type(2)));
typedef float f32x4 __attribute__((ext_vector_type(4)));
typedef short bf16x8 __attribute__((ext_vector_type(8)));
typedef short bf16x4 __attribute__((ext_vector_type(4)));
typedef float f32x2 __attribute__((ext_vector_type(2)));
typedef GAS unsigned gu32;
#define LDS_WAIT() asm volatile("s_waitcnt lgkmcnt(0)" ::: "memory")
#define VM_WAIT() asm volatile("s_waitcnt vmcnt(0)" ::: "memory")
#define MFMA16(a, b, c) __builtin_amdgcn_mfma_f32_16x16x32_bf16((a), (b), (c), 0, 0, 0)
typedef __bf16 bf16x2v __attribute__((ext_vector_type(2)));
__device__ __forceinline__ unsigned pk2(float lo, float hi) { f32x2 v; v.x = lo; v.y = hi; return __builtin_bit_cast(unsigned, __builtin_convertvector(v, bf16x2v)); }
__device__ __forceinline__ unsigned f2bf(float f) { return pk2(f, 0.f) & 0xffffu; }
__device__ __forceinline__ float bf2f(unsigned short h) { return __builtin_bit_cast(float, (unsigned)h << 16); }
__device__ __forceinline__ float bflo(unsigned w) { return __builtin_bit_cast(float, w << 16); }
__device__ __forceinline__ float bfhi(unsigned w) { return __builtin_bit_cast(float, w & 0xffff0000u); }
__device__ __forceinline__ float wave_sum(float v) {
#pragma unroll
    for (int o = 1; o < 64; o <<= 1) v += __shfl_xor(v, o);
    return v;
}
#ifndef PL_SB
#define PL_SB 0
#endif
#ifndef PL_LRU
#define PL_LRU 1
#endif
__device__ __forceinline__ float xor16s(float v, int) { return __shfl_xor(v, 16); }
__device__ __forceinline__ float xor32s(float v, int) { return __shfl_xor(v, 32); }
__device__ __forceinline__ float xor16(float v, int g) { unsigned a = __builtin_bit_cast(unsigned, v), b = a;
    asm volatile("s_nop 1\n\tv_permlane16_swap_b32 %0, %1\n\ts_nop 1" : "+v"(a), "+v"(b)); return __builtin_bit_cast(float, (g & 1) ? a : b); }
__device__ __forceinline__ float xor32(float v, int g) { unsigned a = __builtin_bit_cast(unsigned, v), b = a;
    asm volatile("s_nop 1\n\tv_permlane32_swap_b32 %0, %1\n\ts_nop 1" : "+v"(a), "+v"(b)); return __builtin_bit_cast(float, (g & 2) ? a : b); }
__device__ __forceinline__ float fast_exp(float x) { return __builtin_amdgcn_exp2f(x * 1.44269504089f); }
__device__ __forceinline__ float fast_sigmoid(float x) { return __builtin_amdgcn_rcpf(1.0f + fast_exp(-x)); }
__device__ __forceinline__ float silu_f(float x) { return x * fast_sigmoid(x); }
__device__ __forceinline__ float softplus_f(float z) { return fmaxf(z, 0.f) + __builtin_amdgcn_logf(1.0f + fast_exp(-fabsf(z))) * 0.69314718056f; }

#define XB_TMO      128
#define XB_XCNT(j)  (256  + 64 * (j))
#define XB_XSUB(j)  (1280 + 64 * (j))
#define XB_XGEN(j)  (2304 + 64 * (j))
#define XB_TOP      3328
#define XB_TOPGEN   3392
#define XCD_BAR_WORDS 3456
#define XB_SPIN_CAP (1u << 18)
__device__ __forceinline__ unsigned xb_ld(unsigned* p)              { return __hip_atomic_load(p, __ATOMIC_RELAXED, __HIP_MEMORY_SCOPE_AGENT); }
__device__ __forceinline__ unsigned xb_add(unsigned* p, unsigned v) { return __hip_atomic_fetch_add(p, v, __ATOMIC_RELAXED, __HIP_MEMORY_SCOPE_AGENT); }
__device__ __forceinline__ unsigned xb_xcc_id() { return (unsigned)__builtin_amdgcn_s_getreg((3 << 11) | 20) & 0xFu; }
#define XB_SPIN(cond, bar) do { unsigned _sp = 0; while (cond) { __builtin_amdgcn_s_sleep(1); \
    if ((++_sp & 255u) == 0u) { if (xb_ld(&(bar)[XB_TMO])) break; if (_sp > XB_SPIN_CAP) { atomicAdd(&(bar)[XB_TMO], 1u); break; } } } } while (0)
struct XcdBarrier { unsigned* bar; unsigned x; volatile LAS unsigned* st; };
__device__ __forceinline__ XcdBarrier xcd_barrier_post(unsigned* bar, volatile LAS unsigned* st) {
    XcdBarrier b; b.bar = bar; b.x = xb_xcc_id(); b.st = st;
    if (threadIdx.x == 0) (void)xb_add(&bar[XB_XCNT(b.x)], 1u);
    return b;
}
__device__ __forceinline__ void xcd_barrier_complete(unsigned* bar, unsigned x, unsigned& nloc, unsigned& nx) {
    const unsigned G = gridDim.x * gridDim.y * gridDim.z;
    unsigned sum, cnt, mine, sp = 0u;
    for (;;) {
        sum = 0u; cnt = 0u; mine = 0u;
#pragma unroll
        for (unsigned j = 0; j < 16; ++j) { const unsigned c = xb_ld(&bar[XB_XCNT(j)]); sum += c; cnt += (c > 0u) ? 1u : 0u; mine = (j == x) ? c : mine; }
        if (sum == G) break;
        __builtin_amdgcn_s_sleep(1);
        if ((++sp & 255u) == 0u) { if (xb_ld(&bar[XB_TMO])) break; if (sp > XB_SPIN_CAP) { atomicAdd(&bar[XB_TMO], 1u); break; } }
    }
    nloc = mine > 0u ? mine : 1u; nx = cnt > 0u ? cnt : 1u;
}
__device__ __forceinline__ void xcd_barrier(const XcdBarrier& b) {
    asm volatile("s_waitcnt vmcnt(0)" ::: "memory");
    __syncthreads();
    if (threadIdx.x == 0) {
        unsigned* bar = b.bar;
        __builtin_amdgcn_s_waitcnt(0);
        unsigned nloc = b.st[0], nx = b.st[1];
        if (nloc == 0u) { xcd_barrier_complete(bar, b.x, nloc, nx); b.st[0] = nloc; b.st[1] = nx; }
        const unsigned old = xb_add(&bar[XB_XSUB(b.x)], 1u);
        const unsigned gen = old / nloc;
        if (old + 1u == (gen + 1u) * nloc) {
            __builtin_amdgcn_fence(__ATOMIC_RELEASE, "agent");
            asm volatile("s_waitcnt vmcnt(0)" ::: "memory");
            const unsigned og = xb_add(&bar[XB_TOP], 1u);
            const unsigned tg = og / nx;
            if (og + 1u == (tg + 1u) * nx) xb_add(&bar[XB_TOPGEN], 1u);
            else XB_SPIN(xb_ld(&bar[XB_TOPGEN]) == tg, bar);
            __builtin_amdgcn_fence(__ATOMIC_ACQUIRE, "agent");
            xb_add(&bar[XB_XGEN(b.x)], 1u);
            asm volatile("s_waitcnt vmcnt(0)" ::: "memory");
        } else {
            XB_SPIN(xb_ld(&bar[XB_XGEN(b.x)]) == gen, bar);
            __builtin_amdgcn_fence(__ATOMIC_ACQUIRE, "agent");
            asm volatile("s_waitcnt vmcnt(0)" ::: "memory");
        }
    }
    __syncthreads();
}

struct Frame {
    LAS unsigned char* lds;
    int tid, lane, wave, vcu, G;
    float* out;
    unsigned char* ws;
};
#define LAUNDER_S(p) asm volatile("" : "+s"(p))
enum { I_X = 0, I_MEM, I_PRE_GAIN, I_POST_GAIN, I_W_IN, I_W_OUT, I_W_MEM_KV, I_MEM_GAIN, I_CONV_W, I_CONV_B, I_GATE_A_W, I_GATE_A_B, I_GATE_X_W, I_GATE_X_B, I_LAM, I_KV_GAIN, I_W_KV, I_NIN };
constexpr int PTR_OFF = LDSCTL_OFF + 512;
__device__ __forceinline__ const float* inp(const Frame& F, int i) {
    const unsigned long long v = ((const LAS unsigned long long*)(F.lds + PTR_OFF))[i];
    const unsigned lo = __builtin_amdgcn_readfirstlane((unsigned)v), hi = __builtin_amdgcn_readfirstlane((unsigned)(v >> 32));
    return (const float*)(((unsigned long long)hi << 32) | lo);
}
__device__ __forceinline__ bf16* win_ptr(unsigned char* ws, int l) { return (bf16*)(ws + WS_WIN0) + (size_t)l * INC * DM; }

__device__ __forceinline__ void p0_transpose_item(const float* W, int K, int N, bf16* WT, const float* gain, LAS bf16* scr, int kb, int nb, int dst_row0, int lane) {
    const int k0 = 64 * kb, n0 = 64 * nb;
    const int lr = lane >> 4, lc = lane & 15;
    f32x4 v[16];
#pragma unroll
    for (int i = 0; i < 16; ++i) v[i] = __builtin_nontemporal_load((const GAS f32x4*)(W + (size_t)(k0 + 4 * i + lr) * N + n0 + 4 * lc));
    if (gain) {
#pragma unroll
        for (int i = 0; i < 16; ++i) v[i] = v[i] * gain[k0 + 4 * i + lr];
    }
#pragma unroll
    for (int i = 0; i < 16; ++i) { LAS bf16* d = scr + (4 * i + lr) * 66 + 4 * lc;
        *(LAS unsigned*)(d) = pk2(v[i].x, v[i].y); *(LAS unsigned*)(d + 2) = pk2(v[i].z, v[i].w); }
    LDS_WAIT(); asm volatile("" ::: "memory");
    const int kc = lane & 7, nr = lane >> 3;
#pragma unroll
    for (int j = 0; j < 8; ++j) { const LAS bf16* sp = scr + (8 * kc) * 66 + 8 * j + nr;
        v4u o; o.x = (unsigned)sp[0] | ((unsigned)sp[66] << 16); o.y = (unsigned)sp[2 * 66] | ((unsigned)sp[3 * 66] << 16);
        o.z = (unsigned)sp[4 * 66] | ((unsigned)sp[5 * 66] << 16); o.w = (unsigned)sp[6 * 66] | ((unsigned)sp[7 * 66] << 16);
        *(GAS v4u*)(WT + (size_t)(dst_row0 + 8 * j + nr) * K + k0 + 8 * kc) = o; }
    LDS_WAIT(); asm volatile("" ::: "memory");
}
template <bool NORMALISE>
__device__ __forceinline__ void rms_row_to_bf16(const float* xrow, bf16* orow, float* rstd_out, int lane) {
    const GAS f32x4* xr = (const GAS f32x4*)xrow + lane;
    f32x4 v[16]; float s = 0.f;
#pragma unroll
    for (int j = 0; j < 16; ++j) { v[j] = xr[64 * j]; s += (v[j].x * v[j].x + v[j].y * v[j].y) + (v[j].z * v[j].z + v[j].w * v[j].w); }
    const float nrm = sqrtf(wave_sum(s) * (1.0f / DM) + EPS), rstd = 1.0f / nrm;
    const float sc = rstd;
    if (!NORMALISE && lane == 0) *rstd_out = nrm;
    GAS unsigned long long* o8 = (GAS unsigned long long*)orow + lane;
#pragma unroll
    for (int j = 0; j < 16; ++j) o8[64 * j] = (unsigned long long)pk2(v[j].x * sc, v[j].y * sc) | ((unsigned long long)pk2(v[j].z * sc, v[j].w * sc) << 32);
}
constexpr int PI_MKV = 4 * 64 * 32, PI_IN = 4 * 64 * 128, PI_KV = 64 * 96, PI_OUT = 4 * 64 * 64, PI_G = 48 * 16;
constexpr int PW_MEM = PI_MKV + BATCH * MEM_T, PW_END = PW_MEM + PI_IN + PI_KV + PI_OUT + PI_G + M;
constexpr int PW_SPLIT = PW_MEM + 14336;
__device__ __forceinline__ void p0_do(Frame& F, int idx) {
    LAS bf16* scr = (LAS bf16*)(F.lds + RING_OFF + F.wave * 16384);
    int r = idx;
    if (r < PI_MKV) { const float* const w_mem_kv = inp(F, I_W_MEM_KV); const float* const mem_gain = inp(F, I_MEM_GAIN);
        const int l = r / 2048, rr = r % 2048, kb = rr / 32, nb = rr % 32; const int n0 = 64 * nb;
        bf16* dst = (bf16*)(F.ws + (n0 < MEMW ? WS_WMK : WS_WMV)); const int row0 = l * MEMW + (n0 < MEMW ? n0 : n0 - MEMW);
        p0_transpose_item(w_mem_kv + (size_t)l * DM * 2 * MEMW, DM, 2 * MEMW, dst, mem_gain, scr, kb, nb, row0, F.lane); return; } r -= PI_MKV;
    if (r < BATCH * MEM_T) { rms_row_to_bf16<true>(inp(F, I_MEM) + (size_t)r * DM, (bf16*)(F.ws + WS_MEMB) + (size_t)r * DM, nullptr, F.lane); return; } r -= BATCH * MEM_T;
    if (r < PI_IN) { const float* const w_in = inp(F, I_W_IN); const float* const pre_gain = inp(F, I_PRE_GAIN);
        const int l = r / 8192, rr = r % 8192, kb = rr / 128, nb = rr % 128;
        p0_transpose_item(w_in + (size_t)l * DM * INC, DM, INC, win_ptr(F.ws, l), pre_gain + l * DM, scr, kb, nb, 64 * nb, F.lane); return; } r -= PI_IN;
    if (r < PI_KV) { const int kb = r / 96, nb = r % 96;
        p0_transpose_item(inp(F, I_W_KV), DM, KVW, (bf16*)(F.ws + WS_WKV), inp(F, I_KV_GAIN), scr, kb, nb, 64 * nb, F.lane); return; } r -= PI_KV;
    if (r < PI_OUT) { const int l = r / 4096, rr = r % 4096, kb = rr / 64, nb = rr % 64;
        p0_transpose_item(inp(F, I_W_OUT) + (size_t)l * MIXW * DM, MIXW, DM, (bf16*)(F.ws + WS_WOUT) + (size_t)l * DM * MIXW, nullptr, scr, kb, nb, 64 * nb, F.lane); return; } r -= PI_OUT;
    if (r < PI_G) { const int mat = r / 16, rr = r % 16, kb = rr / 4, nb = rr % 4; const int ln = mat / 2, ga = mat % 2;
        p0_transpose_item(inp(F, ga ? I_GATE_X_W : I_GATE_A_W) + (size_t)ln * 65536, 256, 256, (bf16*)(F.ws + WS_WG) + (size_t)ln * 512 * 256, nullptr, scr, kb, nb, ga * 256 + 64 * nb, F.lane); return; } r -= PI_G;
    rms_row_to_bf16<false>(inp(F, I_X) + (size_t)r * DM, (bf16*)(F.ws + WS_HB) + (size_t)r * DM, (float*)(F.ws + WS_RSTD) + r, F.lane);
}

template <int LAYER>
__device__ __forceinline__ void nr_phase(Frame& F) {
    const int gw = F.vcu * NWAVES + F.wave, NGW = F.G * NWAVES, lane = F.lane;
    const bf16* ob = (const bf16*)(F.ws + WS_OB); const float* part = (const float*)(F.ws + WS_PART); bf16* hb = (bf16*)(F.ws + WS_HB); float* rstd_arr = (float*)(F.ws + WS_RSTD);
    const GAS f32x4* pg = (const GAS f32x4*)(inp(F, I_POST_GAIN) + LAYER * DM) + lane;
    for (int m0 = gw; m0 < M; m0 += 2 * NGW) {
        const int mA = m0, mB = (m0 + NGW < M) ? m0 + NGW : m0;
        const float ssA = part[(size_t)mA * 64 + lane], ssB = part[(size_t)mB * 64 + lane];
        const GAS v2u* oA = (const GAS v2u*)(ob + (size_t)mA * DM) + lane; const GAS v2u* oB = (const GAS v2u*)(ob + (size_t)mB * DM) + lane;
        GAS v2u* hA = (GAS v2u*)(hb + (size_t)mA * DM) + lane; GAS v2u* hB = (GAS v2u*)(hb + (size_t)mB * DM) + lane;
        v2u oa[16], ha[16], obv[16], hbv[16];
#pragma unroll
        for (int j = 0; j < 16; ++j) { oa[j] = __builtin_nontemporal_load(oA + 64 * j); ha[j] = hA[64 * j]; obv[j] = __builtin_nontemporal_load(oB + 64 * j); hbv[j] = hB[64 * j]; }
        const float rsA = 1.0f / sqrtf(wave_sum(ssA) * (1.0f / DM) + EPS), rsB = 1.0f / sqrtf(wave_sum(ssB) * (1.0f / DM) + EPS);
        const float nA = rstd_arr[mA], nB = rstd_arr[mB];
#pragma unroll
        for (int rI = 0; rI < 2; ++rI) {
            const float rs = rI ? rsB : rsA; const float hn = rI ? nB : nA; const int m = rI ? mB : mA; GAS v2u* hrow = rI ? hB : hA;
            if (rI == 1 && mB == mA) break;
            f32x4 v[16]; float s = 0.f;
#pragma unroll
            for (int j = 0; j < 16; ++j) { const v2u o = rI ? obv[j] : oa[j]; const v2u hh = rI ? hbv[j] : ha[j]; const f32x4 g = pg[64 * j];
                f32x4 r; r.x = bflo(hh.x) * hn + bflo(o.x) * rs * g.x; r.y = bfhi(hh.x) * hn + bfhi(o.x) * rs * g.y; r.z = bflo(hh.y) * hn + bflo(o.y) * rs * g.z; r.w = bfhi(hh.y) * hn + bfhi(o.y) * rs * g.w;
                v[j] = r; s += (r.x * r.x + r.y * r.y) + (r.z * r.z + r.w * r.w); }
            if (LAYER < DEPTH - 1) {
                const float nrm = sqrtf(wave_sum(s) * (1.0f / DM) + EPS), rstd = 1.0f / nrm;
                if (lane == 0) rstd_arr[m] = nrm;
#pragma unroll
                for (int j = 0; j < 16; ++j) { v2u w; w.x = pk2(v[j].x * rstd, v[j].y * rstd); w.y = pk2(v[j].z * rstd, v[j].w * rstd); hrow[64 * j] = w; }
            } else {
                GAS f32x4* outr = (GAS f32x4*)(F.out + (size_t)m * DM) + lane;
#pragma unroll
                for (int j = 0; j < 16; ++j) outr[64 * j] = v[j];
            }
        }
    }
}

__device__ __forceinline__ bf16x8 pack8(float a0, float a1, float a2, float a3, float a4, float a5, float a6, float a7) {
    v4u p; p.x = pk2(a0, a1); p.y = pk2(a2, a3); p.z = pk2(a4, a5); p.w = pk2(a6, a7); return __builtin_bit_cast(bf16x8, p);
}
__host__ __device__ __forceinline__ int kperm(int rho) { return (rho & ~31) + 8 * ((rho & 15) >> 2) + 4 * ((rho >> 4) & 1) + (rho & 3); }
__device__ __forceinline__ void glds16(const bf16* g, LAS unsigned char* l) { __builtin_amdgcn_global_load_lds((const unsigned*)g, (LAS unsigned*)l, 16, 0, 0); }
#define WG_BAR() do { asm volatile("s_waitcnt vmcnt(0) lgkmcnt(0)" ::: "memory"); __builtin_amdgcn_s_barrier(); asm volatile("" ::: "memory"); } while (0)

#if PL_SB
#define SBX16 xor16
#define SBX32 xor32
#else
#define SBX16 xor16s
#define SBX32 xor32s
#endif
template <int NP, bool MASK>
__device__ __forceinline__ void sb_tile_weights(const f32x4 (&zt)[2 * NP], float (&w)[NP][8], float& R, int kb, int tq, int g) {
    float bt[NP][8], sp[NP][8], Sp[NP];
#pragma unroll
    for (int p = 0; p < NP; ++p) {
        float om[8];
#pragma unroll
        for (int jj = 0; jj < 8; ++jj) {
            const float t = fmaxf(zt[2 * p + (jj >> 2)][jj & 3], -126.0f);
            const float e = __builtin_amdgcn_exp2f(-t);
            float b = __builtin_amdgcn_rcpf(1.0f + e), o = e * b;
            if (MASK) { const bool valid = (kb + 32 * p + 8 * g + jj) < tq; b = valid ? b : 0.f; o = valid ? o : 1.f; }
            bt[p][jj] = b; om[jj] = o; }
        sp[p][7] = 1.f;
#pragma unroll
        for (int jj = 6; jj >= 0; --jj) sp[p][jj] = sp[p][jj + 1] * om[jj + 1];
        Sp[p] = sp[p][0] * om[0];
    }
    float Gp[NP], Tp[NP];
#pragma unroll
    for (int p = 0; p < NP; ++p) {
        const float p16 = SBX16(Sp[p], g);
        const float Ppair = Sp[p] * p16;
        const float p32 = SBX32(Ppair, g);
        Gp[p] = ((g & 1) ? 1.f : p16) * ((g & 2) ? 1.f : p32);
        Tp[p] = Ppair * p32;
    }
    float Facc = R;
#pragma unroll
    for (int p = NP - 1; p >= 0; --p) {
        const float base = Facc * Gp[p];
#pragma unroll
        for (int jj = 0; jj < 8; ++jj) w[p][jj] = bt[p][jj] * (base * sp[p][jj]);
        Facc *= Tp[p];
    }
    R = Facc;
}
template <bool MASK>
__device__ __forceinline__ void sb_tile_weights2(const f32x4 (&zt)[4], float (&w)[2][8], float& R, int kb, int tq, int g) {
    f32x2 bt[8], sp[8], om[8];
    const int lim = tq - kb - 8 * g;
#pragma unroll
    for (int jj = 0; jj < 8; ++jj) {
        f32x2 e;
        e.x = __builtin_fminf(__builtin_amdgcn_exp2f(-zt[jj >> 2][jj & 3]), 0x1p126f); e.y = __builtin_fminf(__builtin_amdgcn_exp2f(-zt[2 + (jj >> 2)][jj & 3]), 0x1p126f);
        const f32x2 d = e + (f32x2){1.0f, 1.0f};
        f32x2 b; b.x = __builtin_amdgcn_rcpf(d.x); b.y = __builtin_amdgcn_rcpf(d.y);
        f32x2 o = e * b;
        if (MASK) { const bool v0 = jj < lim, v1 = (32 + jj) < lim; b.x = v0 ? b.x : 0.f; o.x = v0 ? o.x : 1.f; b.y = v1 ? b.y : 0.f; o.y = v1 ? o.y : 1.f; }
        bt[jj] = b; om[jj] = o; }
    sp[7] = (f32x2){1.f, 1.f};
#pragma unroll
    for (int jj = 6; jj >= 0; --jj) sp[jj] = sp[jj + 1] * om[jj + 1];
    const f32x2 Sp = sp[0] * om[0];
    f32x2 p16; p16.x = SBX16(Sp.x, g); p16.y = SBX16(Sp.y, g);
    const f32x2 Ppair = Sp * p16;
    f32x2 p32; p32.x = SBX32(Ppair.x, g); p32.y = SBX32(Ppair.y, g);
    f32x2 Gp; Gp.x = ((g & 1) ? 1.f : p16.x) * ((g & 2) ? 1.f : p32.x); Gp.y = ((g & 1) ? 1.f : p16.y) * ((g & 2) ? 1.f : p32.y);
    const f32x2 Tp = Ppair * p32;
    f32x2 base; base.y = R * Gp.y; const float F1 = R * Tp.y; base.x = F1 * Gp.x; R = F1 * Tp.x;
#pragma unroll
    for (int jj = 0; jj < 8; ++jj) { const f32x2 ww = bt[jj] * (base * sp[jj]); w[0][jj] = ww.x; w[1][jj] = ww.y; }
}
template <int NP, int ROW0>
__device__ __forceinline__ void sb_compute(LAS unsigned char* stg, const bf16x8 (&qf)[4], f32x4 (&ot)[8], float& R, int kt, int tq, int tw, int c, int g) {
    f32x4 zt[2 * NP];
#pragma unroll
    for (int f = 0; f < 2 * NP; ++f) zt[f] = (f32x4){0.f, 0.f, 0.f, 0.f};
#pragma unroll
    for (int kk = 0; kk < 4; ++kk)
#pragma unroll
        for (int f = 0; f < 2 * NP; ++f) { const bf16x8 kf = *(const LAS bf16x8*)(stg + (kk >> 1) * 16384 + pg8::lds_byte(ROW0 + 16 * f + c, 32 * (kk & 1) + 8 * g));
            zt[f] = MFMA16(kf, qf[kk], zt[f]); }
    float w[NP][8];
    if constexpr (NP == 2) { if (kt + ROW0 + 63 >= tw) sb_tile_weights2<true>(zt, w, R, kt + ROW0, tq, g); else sb_tile_weights2<false>(zt, w, R, kt + ROW0, tq, g); }
    else { if (kt + ROW0 + 32 * NP - 1 >= tw) sb_tile_weights<NP, true>(zt, w, R, kt + ROW0, tq, g); else sb_tile_weights<NP, false>(zt, w, R, kt + ROW0, tq, g); }
#pragma unroll
    for (int p = 0; p < NP; ++p) {
        const bf16x8 wf = pack8(w[p][0], w[p][1], w[p][2], w[p][3], w[p][4], w[p][5], w[p][6], w[p][7]);
        constexpr int dummy = 0; (void)dummy;
        const int ko = ROW0 + 32 * p;
#pragma unroll
        for (int md = 0; md < 8; ++md) { const bf16x8 vf = *(const LAS bf16x8*)(stg + 32768 + (ko >> 6) * 16384 + pg8::lds_byte(16 * md + c, (ko & 63) + 8 * g)); ot[md] = MFMA16(vf, wf, ot[md]); }
    }
}

template <int ROW0>
__device__ __forceinline__ void sb_compute_joint(LAS unsigned char* stg, const bf16x8 (&qfA)[4], const bf16x8 (&qfB)[4], f32x4 (&otA)[8], f32x4 (&otB)[8], float& RA, float& RB,
                                                 int kt, int tqA, int twA, int tqB, int twB, int c, int g) {
    f32x4 ztA[4], ztB[4];
#pragma unroll
    for (int f = 0; f < 4; ++f) { ztA[f] = (f32x4){0.f, 0.f, 0.f, 0.f}; ztB[f] = (f32x4){0.f, 0.f, 0.f, 0.f}; }
#pragma unroll
    for (int kk = 0; kk < 4; ++kk)
#pragma unroll
        for (int f = 0; f < 4; ++f) { const bf16x8 kf = *(const LAS bf16x8*)(stg + (kk >> 1) * 16384 + pg8::lds_byte(ROW0 + 16 * f + c, 32 * (kk & 1) + 8 * g));
            ztA[f] = MFMA16(kf, qfA[kk], ztA[f]); ztB[f] = MFMA16(kf, qfB[kk], ztB[f]); }
    bf16x8 wfA[2], wfB[2];
    { float w[2][8];
      if (kt + ROW0 + 63 >= twA) sb_tile_weights2<true>(ztA, w, RA, kt + ROW0, tqA, g); else sb_tile_weights2<false>(ztA, w, RA, kt + ROW0, tqA, g);
#pragma unroll
      for (int p = 0; p < 2; ++p) wfA[p] = pack8(w[p][0], w[p][1], w[p][2], w[p][3], w[p][4], w[p][5], w[p][6], w[p][7]); }
    { float w[2][8];
      if (kt + ROW0 + 63 >= twB) sb_tile_weights2<true>(ztB, w, RB, kt + ROW0, tqB, g); else sb_tile_weights2<false>(ztB, w, RB, kt + ROW0, tqB, g);
#pragma unroll
      for (int p = 0; p < 2; ++p) wfB[p] = pack8(w[p][0], w[p][1], w[p][2], w[p][3], w[p][4], w[p][5], w[p][6], w[p][7]); }
#pragma unroll
    for (int p = 0; p < 2; ++p) {
        const int ko = ROW0 + 32 * p;
#pragma unroll
        for (int md = 0; md < 8; ++md) { const bf16x8 vf = *(const LAS bf16x8*)(stg + 32768 + (ko >> 6) * 16384 + pg8::lds_byte(16 * md + c, (ko & 63) + 8 * g));
            otA[md] = MFMA16(vf, wfA[p], otA[md]); otB[md] = MFMA16(vf, wfB[p], otB[md]); }
    }
}

template <bool DUMMY>
__device__ __forceinline__ void sb_attn_wg(Frame& F, int b, int hd, int qb2, int popt = 0) {
    const int tid = F.tid, lane = F.lane, wave = F.wave, c = lane & 15, g = lane >> 4;
    LAS unsigned char* const lds = F.lds + RING_OFF;
    const bf16* const proj = (const bf16*)(F.ws + WS_PROJ); const bf16* const KBp = (const bf16*)(F.ws + WS_KB); const bf16* const VTp = (const bf16*)(F.ws + WS_VT); bf16* const mix = (bf16*)(F.ws + WS_MIX);
    const int t0 = qb2 * 256;
    const int twA = t0 + 128 + 16 * wave, tqA = twA + c, twB = t0 + 16 * wave, tqB = twB + c;
    const size_t mrow = (size_t)b * SEQ;
    int R0, C0, R1, C1; pg8::stage_rc(tid * 16, R0, C0); pg8::stage_rc(tid * 16 + 8192, R1, C1);
    const bf16* const ksrc0 = KBp + ((size_t)hd * M + mrow + kperm(R0)) * 128 + C0;
    const bf16* const ksrc1 = KBp + ((size_t)hd * M + mrow + kperm(R1)) * 128 + C1;
    const bf16* const vsrc0 = VTp + (((size_t)hd * (M / 64) + mrow / 64) * 128 + R0) * 64 + C0;
    const bf16* const vsrc1 = VTp + (((size_t)hd * (M / 64) + mrow / 64) * 128 + R1) * 64 + C1;
    const unsigned ldsw = (unsigned)wave * 1024u;
#define SB_STAGE(s, kt) do { LAS unsigned char* d_ = lds + (s) * 65536 + ldsw; \
        glds16(ksrc0 + (size_t)(kt) * 128, d_); glds16(ksrc1 + (size_t)(kt) * 128, d_ + 8192); glds16(ksrc0 + (size_t)(kt) * 128 + 64, d_ + 16384); glds16(ksrc1 + (size_t)(kt) * 128 + 64, d_ + 24576); \
        glds16(vsrc0 + (size_t)(kt) * 128, d_ + 32768); glds16(vsrc1 + (size_t)(kt) * 128, d_ + 40960); glds16(vsrc0 + (size_t)(kt) * 128 + 8192, d_ + 49152); glds16(vsrc1 + (size_t)(kt) * 128 + 8192, d_ + 57344); } while (0)
    volatile LAS unsigned* const flg = (volatile LAS unsigned*)(F.lds + LDSCTL_OFF + 1024);
    bf16x8 qfA[4], qfB[4];
    { const bf16* qp = proj + (mrow + tqA) * INC + hd * 128 + 8 * g;
#pragma unroll
      for (int kk = 0; kk < 4; ++kk) qfA[kk] = *(const GAS bf16x8*)(qp + 32 * kk); }
    { const bf16* qp = proj + (mrow + tqB) * INC + hd * 128 + 8 * g;
#pragma unroll
      for (int kk = 0; kk < 4; ++kk) qfB[kk] = *(const GAS bf16x8*)(qp + 32 * kk); }
    f32x4 otA[8], otB[8];
#pragma unroll
    for (int md = 0; md < 8; ++md) { otA[md] = (f32x4){0.f, 0.f, 0.f, 0.f}; otB[md] = (f32x4){0.f, 0.f, 0.f, 0.f}; }
    float RA = 1.f, RB = 1.f;
    bool doneA = false, doneB = false;
    int kt = t0 + 128, j = 0;
    SB_STAGE(0, kt);
#define SB_TILE_STEP(S) { \
        WG_BAR();                                    \
        if (j > 0) { unsigned nd = 0; \
            _Pragma("unroll") for (int w = 0; w < 8; ++w) nd += flg[(j & 1) * 8 + w]; \
            if (nd == 8u) break; } \
        if (kt < 0) break; \
        const int ktn = kt - 128; \
        if (ktn >= 0 && popt != 5) SB_STAGE((S) ^ 1, ktn); \
        if (popt >= 4) { if (j >= 3) { doneA = true; doneB = true; } } \
        if (popt != 4) { \
        { const bool bIn = !doneB && kt < twB + 15;                       \
          const bool a64 = !doneA && (kt + 64 < twA + 15), b64 = bIn && (kt + 64 < twB + 15); \
          if (a64 && b64) sb_compute_joint<64>(lds + (S) * 65536, qfA, qfB, otA, otB, RA, RB, kt, tqA, twA, tqB, twB, c, g); \
          else if (a64) sb_compute<2, 64>(lds + (S) * 65536, qfA, otA, RA, kt, tqA, twA, c, g); \
          else if (b64) sb_compute<2, 64>(lds + (S) * 65536, qfB, otB, RB, kt, tqB, twB, c, g); \
          if (a64 && __all(RA == 0.0f)) doneA = true; \
          if (b64 && __all(RB == 0.0f)) doneB = true; \
          const bool a0 = !doneA, b0 = bIn && !doneB; \
          if (a0 && b0) sb_compute_joint<0>(lds + (S) * 65536, qfA, qfB, otA, otB, RA, RB, kt, tqA, twA, tqB, twB, c, g); \
          else if (a0) sb_compute<2, 0>(lds + (S) * 65536, qfA, otA, RA, kt, tqA, twA, c, g); \
          else if (b0) sb_compute<2, 0>(lds + (S) * 65536, qfB, otB, RB, kt, tqB, twB, c, g); \
          if (a0 && __all(RA == 0.0f)) doneA = true; \
          if (b0 && __all(RB == 0.0f)) doneB = true; } \
        } \
        if (popt >= 4 && j < 3) { doneA = false; doneB = false; } \
        if (lane == 0) flg[((j + 1) & 1) * 8 + wave] = (doneA && doneB) ? 1u : 0u; \
        kt = ktn; ++j; }
    if (DUMMY) { WG_BAR(); } else
    for (;;) { SB_TILE_STEP(0) SB_TILE_STEP(1) }
#undef SB_TILE_STEP
#undef SB_STAGE
    if (popt < 4)
#pragma unroll
    for (int q = 0; q < 2; ++q) { const size_t row = mrow + (q == 0 ? tqA : tqB);
#pragma unroll
        for (int md = 0; md < 8; ++md) { const int d0 = hd * 128 + 16 * md + 4 * g;
            const v2u gt = *(const GAS v2u*)(proj + row * INC + MAINW + d0);
            const f32x4 o4 = q == 0 ? otA[md] : otB[md];
            v2u o; o.x = pk2(o4[0] * silu_f(bflo(gt.x)), o4[1] * silu_f(bfhi(gt.x))); o.y = pk2(o4[2] * silu_f(bflo(gt.y)), o4[3] * silu_f(bfhi(gt.y)));
            *(GAS v2u*)(mix + row * MIXW + d0) = o; } }
    asm volatile("s_waitcnt lgkmcnt(0)" ::: "memory"); __builtin_amdgcn_s_barrier(); asm volatile("" ::: "memory");
}

__device__ __forceinline__ void mem_attn_wg(Frame& F, int layer, int b, int mh, int qb) {
    const int tid = F.tid, lane = F.lane, wave = F.wave, c = lane & 15, g = lane >> 4;
    LAS unsigned char* const lds = F.lds + RING_OFF;
    const bf16* const proj = (const bf16*)(F.ws + WS_PROJ); const bf16* const memk = (const bf16*)(F.ws + WS_MEMK); const bf16* const memvt = (const bf16*)(F.ws + WS_MEMVT); bf16* const mix = (bf16*)(F.ws + WS_MIX);
    const size_t row0 = (size_t)b * SEQ + qb * 256 + 32 * wave + c;
    const int fbase = layer * MEMW + mh * 256;
    const unsigned ldsw = (unsigned)wave * 1024u;
    int Rr[2], Cc[2]; pg8::stage_rc(tid * 16, Rr[0], Cc[0]); pg8::stage_rc(tid * 16 + 8192, Rr[1], Cc[1]);
#pragma unroll
    for (int kh = 0; kh < 2; ++kh)
#pragma unroll
        for (int dq = 0; dq < 4; ++dq)
#pragma unroll
            for (int i = 0; i < 2; ++i) glds16(memk + (size_t)(b * MEM_T + 128 * kh + kperm(Rr[i])) * (DEPTH * MEMW) + fbase + 64 * dq + Cc[i], lds + kh * 65536 + dq * 16384 + i * 8192 + ldsw);
    bf16x8 qf[2][8];
#pragma unroll
    for (int q = 0; q < 2; ++q) { const bf16* qp = proj + (row0 + 16 * q) * INC + 2 * MAINW + mh * 256 + 8 * g;
#pragma unroll
      for (int kk = 0; kk < 8; ++kk) qf[q][kk] = *(const GAS bf16x8*)(qp + 32 * kk); }
    WG_BAR();
    f32x4 st[2][16];
#pragma unroll
    for (int fg = 0; fg < 16; ++fg) { st[0][fg] = (f32x4){0.f, 0.f, 0.f, 0.f}; st[1][fg] = (f32x4){0.f, 0.f, 0.f, 0.f}; }
#pragma unroll
    for (int kh = 0; kh < 2; ++kh)
#pragma unroll
        for (int kk = 0; kk < 8; ++kk)
#pragma unroll
            for (int f = 0; f < 8; ++f) { const bf16x8 kf = *(const LAS bf16x8*)(lds + kh * 65536 + (kk >> 1) * 16384 + pg8::lds_byte(16 * f + c, 32 * (kk & 1) + 8 * g));
                st[0][8 * kh + f] = MFMA16(kf, qf[0][kk], st[0][8 * kh + f]); st[1][8 * kh + f] = MFMA16(kf, qf[1][kk], st[1][8 * kh + f]); }
    float inv[2];
    bf16x8 pf[2][8];
#pragma unroll
    for (int q = 0; q < 2; ++q) {
        float mx = -3.0e38f;
#pragma unroll
        for (int f = 0; f < 16; ++f)
#pragma unroll
            for (int r = 0; r < 4; ++r) mx = fmaxf(mx, st[q][f][r]);
        mx = fmaxf(mx, __shfl_xor(mx, 16)); mx = fmaxf(mx, __shfl_xor(mx, 32));
        float den = 0.f;
#pragma unroll
        for (int f = 0; f < 16; ++f)
#pragma unroll
            for (int r = 0; r < 4; ++r) { const float p = __builtin_amdgcn_exp2f(st[q][f][r] - mx); st[q][f][r] = p; den += p; }
        den += __shfl_xor(den, 16); den += __shfl_xor(den, 32);
        inv[q] = 1.0f / den;
#pragma unroll
        for (int pg = 0; pg < 8; ++pg) { const int fa = 8 * (pg >> 2) + 2 * (pg & 3); pf[q][pg] = pack8(st[q][fa][0], st[q][fa][1], st[q][fa][2], st[q][fa][3], st[q][fa + 1][0], st[q][fa + 1][1], st[q][fa + 1][2], st[q][fa + 1][3]); }
    }
    WG_BAR();
#pragma unroll
    for (int kh = 0; kh < 2; ++kh)
#pragma unroll
        for (int dh = 0; dh < 2; ++dh)
#pragma unroll
            for (int kq = 0; kq < 2; ++kq)
#pragma unroll
                for (int i = 0; i < 2; ++i) glds16(memvt + (size_t)(fbase + 128 * dh + Rr[i]) * (BATCH * MEM_T) + b * MEM_T + 128 * kh + 64 * kq + Cc[i], lds + kh * 65536 + (dh * 2 + kq) * 16384 + i * 8192 + ldsw);
    v2u gtm[2][2][8];
#pragma unroll
    for (int half = 0; half < 2; ++half)
#pragma unroll
        for (int q = 0; q < 2; ++q)
#pragma unroll
            for (int md = 0; md < 8; ++md) gtm[half][q][md] = *(const GAS v2u*)(proj + (row0 + 16 * q) * INC + 2 * MAINW + MEMW + mh * 256 + 128 * half + 16 * md + 4 * g);
    WG_BAR();
#pragma unroll
    for (int half = 0; half < 2; ++half) {
        f32x4 ot[2][8];
#pragma unroll
        for (int md = 0; md < 8; ++md) { ot[0][md] = (f32x4){0.f, 0.f, 0.f, 0.f}; ot[1][md] = (f32x4){0.f, 0.f, 0.f, 0.f}; }
#pragma unroll
        for (int pg = 0; pg < 8; ++pg) { const int kh = pg >> 2, p = pg & 3;
#pragma unroll
            for (int md = 0; md < 8; ++md) { const bf16x8 vf = *(const LAS bf16x8*)(lds + kh * 65536 + (half * 2 + (p >> 1)) * 16384 + pg8::lds_byte(16 * md + c, 32 * (p & 1) + 8 * g));
                ot[0][md] = MFMA16(vf, pf[0][pg], ot[0][md]); ot[1][md] = MFMA16(vf, pf[1][pg], ot[1][md]); } }
#pragma unroll
        for (int q = 0; q < 2; ++q)
#pragma unroll
            for (int md = 0; md < 8; ++md) { const int d0 = mh * 256 + 128 * half + 16 * md + 4 * g; const size_t row = row0 + 16 * q;
                const v2u gt = gtm[half][q][md];
                v2u o; o.x = pk2(ot[q][md][0] * inv[q] * silu_f(bflo(gt.x)), ot[q][md][1] * inv[q] * silu_f(bfhi(gt.x))); o.y = pk2(ot[q][md][2] * inv[q] * silu_f(bflo(gt.y)), ot[q][md][3] * inv[q] * silu_f(bfhi(gt.y)));
                *(GAS v2u*)(mix + row * MIXW + MAINW + d0) = o; }
    }
    WG_BAR();
}

__device__ __forceinline__ void lru_carry_phase(Frame& F) {
    const int gw = F.vcu * NWAVES + F.wave, NGW = F.G * NWAVES;
    const float* agg = (const float*)(F.ws + WS_AGG); float* carry = (float*)(F.ws + WS_CARRY);
    for (int u = gw; u < BATCH * (MAINW / 64); u += NGW) {
        const int b = u / (MAINW / 64), chn = (u % (MAINW / 64)) * 64 + F.lane;
        float hc = 0.f;
#pragma unroll 1
        for (int c0 = 0; c0 < LRU_NC; c0 += 16) {
            f32x2 ag[16];
#pragma unroll
            for (int i = 0; i < 16; ++i) ag[i] = *(const GAS f32x2*)(agg + ((size_t)(b * LRU_NC + c0 + i) * MAINW + chn) * 2);
#pragma unroll
            for (int i = 0; i < 16; ++i) { *(GAS float*)(carry + (size_t)(b * LRU_NC + c0 + i) * MAINW + chn) = hc; hc = ag[i].x * hc + ag[i].y; }
        }
    }
}

template <bool FINAL>
__device__ __forceinline__ void lru_unit(Frame& F, int layer, int b, int n, int ch) {
    const int tid = F.tid, lane = F.lane, wave = F.wave, c = lane & 15, g = lane >> 4;
    const bf16* proj = (const bf16*)(F.ws + WS_PROJ);
    const float* const conv_w = inp(F, I_CONV_W); const float* const conv_b = inp(F, I_CONV_B);
    LAS bf16* ut = (LAS bf16*)(F.lds + RING_OFF);
    const int t0 = ch * LRU_T; const size_t mrow = (size_t)b * SEQ;
    {
        const int cg = tid & 31, rg = tid >> 5;
        const int col = 256 * n + 8 * cg;
        float cw[4][8], cb[8];
#pragma unroll
        for (int k = 0; k < 4; ++k) { const f32x4 a = *(const GAS f32x4*)(conv_w + ((size_t)layer * 4 + k) * MAINW + col), bb = *(const GAS f32x4*)(conv_w + ((size_t)layer * 4 + k) * MAINW + col + 4);
            cw[k][0] = a.x; cw[k][1] = a.y; cw[k][2] = a.z; cw[k][3] = a.w; cw[k][4] = bb.x; cw[k][5] = bb.y; cw[k][6] = bb.z; cw[k][7] = bb.w; }
        { const f32x4 a = *(const GAS f32x4*)(conv_b + (size_t)layer * MAINW + col), bb = *(const GAS f32x4*)(conv_b + (size_t)layer * MAINW + col + 4);
            cb[0] = a.x; cb[1] = a.y; cb[2] = a.z; cb[3] = a.w; cb[4] = bb.x; cb[5] = bb.y; cb[6] = bb.z; cb[7] = bb.w; }
        float xr[11][8];
#pragma unroll
        for (int i = 0; i < 11; ++i) { const int t = t0 + rg * 8 - 3 + i;
            v4u raw = (v4u){0u, 0u, 0u, 0u};
            if (t >= 0) raw = *(const GAS v4u*)(proj + (mrow + t) * INC + col);
            xr[i][0] = bflo(raw.x); xr[i][1] = bfhi(raw.x); xr[i][2] = bflo(raw.y); xr[i][3] = bfhi(raw.y); xr[i][4] = bflo(raw.z); xr[i][5] = bfhi(raw.z); xr[i][6] = bflo(raw.w); xr[i][7] = bfhi(raw.w); }
#pragma unroll
        for (int tt = 0; tt < 8; ++tt) { float u[8];
#pragma unroll
            for (int e = 0; e < 8; ++e) u[e] = cb[e] + cw[0][e] * xr[tt][e] + cw[1][e] * xr[tt + 1][e] + cw[2][e] * xr[tt + 2][e] + cw[3][e] * xr[tt + 3][e];
            v4u o; o.x = pk2(u[0], u[1]); o.y = pk2(u[2], u[3]); o.z = pk2(u[4], u[5]); o.w = pk2(u[6], u[7]);
            *(LAS v4u*)(ut + (rg * 8 + tt) * UT_PITCH + 8 * cg) = o; }
    }
    __syncthreads();
    float* agg = (float*)(F.ws + WS_AGG);
    const bf16* wg = (const bf16*)(F.ws + WS_WG) + (size_t)(layer * LRU_NB + n) * 512 * 256;
#pragma unroll 1
    for (int nf = 0; nf < 2; ++nf) {
        const int chl = 32 * wave + 16 * nf + c;
        const int chn = 256 * n + chl;
        const bf16* const gbase = proj + (mrow + t0) * INC + MAINW + 256 * n;
        bf16* const obase = (bf16*)(F.ws + WS_MIX) + (mrow + t0) * MIXW + 256 * n;
        const int goff = (4 * g) * INC + chl, ooff = (4 * g) * MIXW + chl;
        unsigned short gtv[8][4];
        if (FINAL) {
#pragma unroll
            for (int mf = 0; mf < 8; ++mf)
#pragma unroll
                for (int r = 0; r < 4; ++r) gtv[mf][r] = *(const GAS bf16*)(gbase + (16 * mf + r) * INC + goff);
        }
        f32x4 acc[8][2];
#pragma unroll
        for (int mf = 0; mf < 8; ++mf) { acc[mf][0] = (f32x4){0.f, 0.f, 0.f, 0.f}; acc[mf][1] = (f32x4){0.f, 0.f, 0.f, 0.f}; }
        bf16x8 bfr[8][2];
#pragma unroll
        for (int kk = 0; kk < 8; ++kk)
#pragma unroll
            for (int ga = 0; ga < 2; ++ga) bfr[kk][ga] = *(const GAS bf16x8*)(wg + (size_t)(ga * 256 + chl) * 256 + 32 * kk + 8 * g);
#pragma unroll
        for (int kk = 0; kk < 8; ++kk) {
            bf16x8 afr[8];
#pragma unroll
            for (int mf = 0; mf < 8; ++mf) afr[mf] = *(const LAS bf16x8*)(ut + (16 * mf + c) * UT_PITCH + 32 * kk + 8 * g);
#pragma unroll
            for (int mf = 0; mf < 8; ++mf) { acc[mf][0] = MFMA16(afr[mf], bfr[kk][0], acc[mf][0]); acc[mf][1] = MFMA16(afr[mf], bfr[kk][1], acc[mf][1]); }
            asm volatile("" ::: "memory");
        }
        {
            const float ba = inp(F, I_GATE_A_B)[(size_t)layer * MAINW + chn], bx = inp(F, I_GATE_X_B)[(size_t)layer * MAINW + chn];
            const float c8 = -8.0f * softplus_f(-inp(F, I_LAM)[(size_t)layer * MAINW + chn]);
#pragma unroll
            for (int mf = 0; mf < 8; ++mf)
#pragma unroll
                for (int r = 0; r < 4; ++r) {
                    const float rr = fast_sigmoid(acc[mf][0][r] + ba), ii = fast_sigmoid(acc[mf][1][r] + bx);
                    const float a = fast_exp(c8 * rr);
                    const float uval = bf2f(ut[(16 * mf + 4 * g + r) * UT_PITCH + chl]);
                    const float om = fmaxf(1.0f - a * a, 0.f);
                    acc[mf][0][r] = a; acc[mf][1][r] = __builtin_amdgcn_sqrtf(om) * (ii * uval);
                }
        }
        float hc = 0.f;
        float PT = 1.f;
        if (FINAL) {
            hc = *(const GAS float*)((const float*)(F.ws + WS_CARRY) + (size_t)(b * LRU_NC + ch) * MAINW + chn);
        }
#pragma unroll
        for (int mf = 0; mf < 8; ++mf) {
            float A = 1.f, B = 0.f;
#pragma unroll
            for (int r = 0; r < 4; ++r) { const float a = acc[mf][0][r]; A *= a; B = a * B + acc[mf][1][r]; }
            float Ai = A, Bi = B;
            { const float Ap = __shfl_up(Ai, 16), Bp = __shfl_up(Bi, 16); if (g >= 1) { Bi = Ai * Bp + Bi; Ai = Ap * Ai; } }
            { const float Ap = __shfl_up(Ai, 32), Bp = __shfl_up(Bi, 32); if (g >= 2) { Bi = Ai * Bp + Bi; Ai = Ap * Ai; } }
            const float Af = __shfl(Ai, 48 + c), Bf = __shfl(Bi, 48 + c);
            if (FINAL) {
                float Ae = __shfl_up(Ai, 16), Be = __shfl_up(Bi, 16); if (g == 0) { Ae = 1.f; Be = 0.f; }
                float h = Ae * hc + Be;
#pragma unroll
                for (int r = 0; r < 4; ++r) { h = acc[mf][0][r] * h + acc[mf][1][r];
                    const float gt = bf2f(gtv[mf][r]);
                    *(GAS bf16*)(obase + (16 * mf + r) * MIXW + ooff) = (bf16)f2bf(h * silu_f(gt)); }
                hc = Af * hc + Bf;
            } else { hc = Af * hc + Bf; PT *= Af; }
        }
        if (!FINAL && g == 0) { f32x2 o; o.x = PT; o.y = hc; *(GAS f32x2*)(agg + ((size_t)(b * LRU_NC + ch) * MAINW + chn) * 2) = o; }
    }
    __syncthreads();
}

#if PL_LRU
#define LRX16 xor16
#define LRX32 xor32
#else
#define LRX16 xor16s
#define LRX32 xor32s
#endif
__device__ __forceinline__ void lru_unit_chain(Frame& F, int layer, int b, int n, int ch, int popt = 0) {
    constexpr bool FINAL = true;
    const int tid = F.tid, lane = F.lane, wave = F.wave, c = lane & 15, g = lane >> 4;
    const bf16* proj = (const bf16*)(F.ws + WS_PROJ);
    const float* const conv_w = inp(F, I_CONV_W); const float* const conv_b = inp(F, I_CONV_B);
    LAS bf16* ut = (LAS bf16*)(F.lds + RING_OFF);
    const int t0 = ch * LRU_T; const size_t mrow = (size_t)b * SEQ;
    {
        const int cg = tid & 31, rg = tid >> 5;
        const int col = 256 * n + 8 * cg;
        float cw[4][8], cb[8];
#pragma unroll
        for (int k = 0; k < 4; ++k) { const f32x4 a = *(const GAS f32x4*)(conv_w + ((size_t)layer * 4 + k) * MAINW + col), bb = *(const GAS f32x4*)(conv_w + ((size_t)layer * 4 + k) * MAINW + col + 4);
            cw[k][0] = a.x; cw[k][1] = a.y; cw[k][2] = a.z; cw[k][3] = a.w; cw[k][4] = bb.x; cw[k][5] = bb.y; cw[k][6] = bb.z; cw[k][7] = bb.w; }
        { const f32x4 a = *(const GAS f32x4*)(conv_b + (size_t)layer * MAINW + col), bb = *(const GAS f32x4*)(conv_b + (size_t)layer * MAINW + col + 4);
            cb[0] = a.x; cb[1] = a.y; cb[2] = a.z; cb[3] = a.w; cb[4] = bb.x; cb[5] = bb.y; cb[6] = bb.z; cb[7] = bb.w; }
        float xr[11][8];
#pragma unroll
        for (int i = 0; i < 11; ++i) { const int t = t0 + rg * 8 - 3 + i;
            v4u raw = (v4u){0u, 0u, 0u, 0u};
            if (t >= 0) raw = *(const GAS v4u*)(proj + (mrow + t) * INC + col);
            xr[i][0] = bflo(raw.x); xr[i][1] = bfhi(raw.x); xr[i][2] = bflo(raw.y); xr[i][3] = bfhi(raw.y); xr[i][4] = bflo(raw.z); xr[i][5] = bfhi(raw.z); xr[i][6] = bflo(raw.w); xr[i][7] = bfhi(raw.w); }
#pragma unroll
        for (int tt = 0; tt < 8; ++tt) { float u[8];
#pragma unroll
            for (int e = 0; e < 8; ++e) u[e] = cb[e] + cw[0][e] * xr[tt][e] + cw[1][e] * xr[tt + 1][e] + cw[2][e] * xr[tt + 2][e] + cw[3][e] * xr[tt + 3][e];
            v4u o; o.x = pk2(u[0], u[1]); o.y = pk2(u[2], u[3]); o.z = pk2(u[4], u[5]); o.w = pk2(u[6], u[7]);
            const int tl = rg * 8 + tt;
            *(LAS v4u*)(ut + (16 * ((tl >> 2) & 7) + 4 * (tl >> 5) + (tl & 3)) * UT_PITCH + 8 * cg) = o; }
    }
    __syncthreads();
    const bf16* wg = (const bf16*)(F.ws + WS_WG) + (size_t)(layer * LRU_NB + n) * 512 * 256;
#pragma unroll 1
    for (int nf = 0; nf < 2; ++nf) {
        const int chl = 32 * wave + 16 * nf + c;
        const int chn = 256 * n + chl;
        const bf16* const gbase = proj + (mrow + t0) * INC + MAINW + 256 * n;
        bf16* const obase = (bf16*)(F.ws + WS_MIX) + (mrow + t0) * MIXW + 256 * n;
        const unsigned goff = (unsigned)((32 * g) * INC + chl), ooff = (unsigned)((32 * g) * MIXW + chl);
        unsigned short gtv[8][4];
        if (FINAL) {
#pragma unroll
            for (int mf = 0; mf < 8; ++mf)
#pragma unroll
                for (int r = 0; r < 4; ++r) gtv[mf][r] = ((const GAS bf16*)gbase)[(unsigned)((4 * mf + r) * INC) + goff];
        }
        f32x4 acc[8][2];
#pragma unroll
        for (int mf = 0; mf < 8; ++mf) { acc[mf][0] = (f32x4){0.f, 0.f, 0.f, 0.f}; acc[mf][1] = (f32x4){0.f, 0.f, 0.f, 0.f}; }
        bf16x8 bfr[8][2];
#pragma unroll
        for (int kk = 0; kk < 8; ++kk)
#pragma unroll
            for (int ga = 0; ga < 2; ++ga) bfr[kk][ga] = *(const GAS bf16x8*)(wg + (size_t)(ga * 256 + chl) * 256 + 32 * kk + 8 * g);
        bf16x8 afA[4], afB[4];
#pragma unroll
        for (int i = 0; i < 4; ++i) afA[i] = *(const LAS bf16x8*)(ut + (16 * i + c) * UT_PITCH + 8 * g);
#pragma unroll
        for (int kk = 0; kk < 8; ++kk) {
#pragma unroll
            for (int i = 0; i < 4; ++i) afB[i] = *(const LAS bf16x8*)(ut + (16 * (4 + i) + c) * UT_PITCH + 32 * kk + 8 * g);
#pragma unroll
            for (int i = 0; i < 4; ++i) { acc[i][0] = MFMA16(afA[i], bfr[kk][0], acc[i][0]); acc[i][1] = MFMA16(afA[i], bfr[kk][1], acc[i][1]); }
            asm volatile("" ::: "memory");
            if (kk < 7) {
#pragma unroll
                for (int i = 0; i < 4; ++i) afA[i] = *(const LAS bf16x8*)(ut + (16 * i + c) * UT_PITCH + 32 * (kk + 1) + 8 * g); }
#pragma unroll
            for (int i = 0; i < 4; ++i) { acc[4 + i][0] = MFMA16(afB[i], bfr[kk][0], acc[4 + i][0]); acc[4 + i][1] = MFMA16(afB[i], bfr[kk][1], acc[4 + i][1]); }
            asm volatile("" ::: "memory");
        }
        {
            const float L2E = 1.44269504089f;
            const float ban = -L2E * inp(F, I_GATE_A_B)[(size_t)layer * MAINW + chn], bxn = -L2E * inp(F, I_GATE_X_B)[(size_t)layer * MAINW + chn];
            const float c8 = -8.0f * L2E * softplus_f(-inp(F, I_LAM)[(size_t)layer * MAINW + chn]);
#pragma unroll
            for (int mf = 0; mf < 8; ++mf)
#pragma unroll
                for (int r = 0; r < 4; r += 2) {
                    f32x2 xa, xi; xa.x = acc[mf][0][r]; xa.y = acc[mf][0][r + 1]; xi.x = acc[mf][1][r]; xi.y = acc[mf][1][r + 1];
                    const f32x2 ta = __builtin_elementwise_fma(xa, (f32x2){-L2E, -L2E}, (f32x2){ban, ban}), ti = __builtin_elementwise_fma(xi, (f32x2){-L2E, -L2E}, (f32x2){bxn, bxn});
                    f32x2 da, di; da.x = __builtin_amdgcn_exp2f(ta.x); da.y = __builtin_amdgcn_exp2f(ta.y); di.x = __builtin_amdgcn_exp2f(ti.x); di.y = __builtin_amdgcn_exp2f(ti.y);
                    da = da + (f32x2){1.0f, 1.0f}; di = di + (f32x2){1.0f, 1.0f};
                    f32x2 rr, ii; rr.x = __builtin_amdgcn_rcpf(da.x); rr.y = __builtin_amdgcn_rcpf(da.y); ii.x = __builtin_amdgcn_rcpf(di.x); ii.y = __builtin_amdgcn_rcpf(di.y);
                    const f32x2 ca = rr * (f32x2){c8, c8};
                    f32x2 a; a.x = __builtin_amdgcn_exp2f(ca.x); a.y = __builtin_amdgcn_exp2f(ca.y);
                    f32x2 uv; uv.x = bf2f(ut[(16 * mf + 4 * g + r) * UT_PITCH + chl]); uv.y = bf2f(ut[(16 * mf + 4 * g + r + 1) * UT_PITCH + chl]);
                    const f32x2 om = __builtin_elementwise_fma(-a, a, (f32x2){1.0f, 1.0f});
                    f32x2 sq; sq.x = __builtin_amdgcn_sqrtf(fmaxf(om.x, 0.f)); sq.y = __builtin_amdgcn_sqrtf(fmaxf(om.y, 0.f));
                    const f32x2 bb = sq * (ii * uv);
                    acc[mf][0][r] = a.x; acc[mf][0][r + 1] = a.y; acc[mf][1][r] = bb.x; acc[mf][1][r + 1] = bb.y;
                }
        }
        float A = 1.f, B = 0.f;
#pragma unroll
        for (int mf = 0; mf < 8; ++mf)
#pragma unroll
            for (int r = 0; r < 4; ++r) { const float a = acc[mf][0][r]; A *= a; B = a * B + acc[mf][1][r]; }
        float Ae, Be, PT, HT;
        { const float A16 = LRX16(A, g), B16 = LRX16(B, g);
          const bool odd = (g & 1) != 0, hi2 = (g & 2) != 0;
          const float PA = A * A16, PB = odd ? (A * B16 + B) : (A16 * B + B16);
          const float Aw = odd ? A16 : 1.f, Bw = odd ? B16 : 0.f;
          const float PA32 = LRX32(PA, g), PB32 = LRX32(PB, g);
          Ae = hi2 ? PA32 * Aw : Aw; Be = hi2 ? (Aw * PB32 + Bw) : Bw;
          PT = PA * PA32; HT = hi2 ? (PA * PB32 + PB) : (PA32 * PB + PB32); }
        typedef GAS unsigned long long gu64;
        gu64* const gr = (gu64*)(F.ws + WS_GRAN) + (size_t)((b * LRU_NB + n) * LRU_NC) * 512;
        const unsigned long long tagw = (unsigned long long)(layer + 1) << 32;
        if (g == 0 && popt == 0) { __hip_atomic_store(gr + (size_t)ch * 512 + chl * 2, tagw | __builtin_bit_cast(unsigned, PT), __ATOMIC_RELAXED, __HIP_MEMORY_SCOPE_AGENT);
                      __hip_atomic_store(gr + (size_t)ch * 512 + chl * 2 + 1, tagw | __builtin_bit_cast(unsigned, HT), __ATOMIC_RELAXED, __HIP_MEMORY_SCOPE_AGENT); }
        float hc = 0.f;
        if (ch > 0 && popt != 6) {
            const int q = (ch + 3) >> 2, lo = g * q, hi = (lo + q) < ch ? (lo + q) : ch;
            float Pg = 1.f, Hg = 0.f;
#pragma unroll 1
            for (int bs = 0; bs < q; bs += 8) {
                unsigned long long gp[8], gh[8]; unsigned spins = 0;
                for (;;) { bool ok = true;
#pragma unroll
                    for (int i = 0; i < 8; ++i) { const int cc = lo + bs + i; if (cc < hi) {
                        gp[i] = __hip_atomic_load(gr + (size_t)cc * 512 + chl * 2, __ATOMIC_RELAXED, __HIP_MEMORY_SCOPE_AGENT);
                        gh[i] = __hip_atomic_load(gr + (size_t)cc * 512 + chl * 2 + 1, __ATOMIC_RELAXED, __HIP_MEMORY_SCOPE_AGENT);
                        ok = ok && ((gp[i] >> 32) == (unsigned long long)(layer + 1)) && ((gh[i] >> 32) == (unsigned long long)(layer + 1)); } }
                    if (__all(ok)) break;
                    __builtin_amdgcn_s_sleep(2);
                    if (++spins > (1u << 17)) { if (lane == 0) __hip_atomic_store((GAS unsigned*)(F.ws + WS_CTL) + CW_TMO, 1u, __ATOMIC_RELAXED, __HIP_MEMORY_SCOPE_AGENT); break; }
                }
#pragma unroll
                for (int i = 0; i < 8; ++i) { const int cc = lo + bs + i; if (cc < hi) { const float P = __builtin_bit_cast(float, (unsigned)gp[i]), H = __builtin_bit_cast(float, (unsigned)gh[i]); Hg = P * Hg + H; Pg = P * Pg; } }
            }
            const float A16 = LRX16(Pg, g), B16 = LRX16(Hg, g);
            const bool odd = (g & 1) != 0;
            const float PA = Pg * A16, PB = odd ? (Pg * B16 + Hg) : (A16 * Hg + B16);
            const float PA32 = LRX32(PA, g), PB32 = LRX32(PB, g);
            hc = (g & 2) ? (PA * PB32 + PB) : (PA32 * PB + PB32);
        }
        float h = Ae * hc + Be;
#pragma unroll
        for (int mf = 0; mf < 8; ++mf)
#pragma unroll
            for (int r = 0; r < 4; r += 2) {
                f32x2 gt; gt.x = bf2f(gtv[mf][r]); gt.y = bf2f(gtv[mf][r + 1]);
                const f32x2 tg = gt * (f32x2){-1.44269504089f, -1.44269504089f};
                f32x2 dg; dg.x = __builtin_amdgcn_exp2f(tg.x); dg.y = __builtin_amdgcn_exp2f(tg.y); dg = dg + (f32x2){1.0f, 1.0f};
                f32x2 rg; rg.x = __builtin_amdgcn_rcpf(dg.x); rg.y = __builtin_amdgcn_rcpf(dg.y);
                f32x2 hv; h = acc[mf][0][r] * h + acc[mf][1][r]; hv.x = h; h = acc[mf][0][r + 1] * h + acc[mf][1][r + 1]; hv.y = h;
                const f32x2 ov = hv * (gt * rg);
                if (popt == 0) { ((GAS bf16*)obase)[(unsigned)((4 * mf + r) * MIXW) + ooff] = (bf16)f2bf(ov.x); ((GAS bf16*)obase)[(unsigned)((4 * mf + r + 1) * MIXW) + ooff] = (bf16)f2bf(ov.y); }
                else asm volatile("" :: "v"(ov.x), "v"(ov.y)); }
    }
    __syncthreads();
}

#ifndef PROBE_MEMREP
#define PROBE_MEMREP 1
#endif
#ifndef PROBE_SBDUMMY
#define PROBE_SBDUMMY 0
#endif
#ifndef PROBE_OPT
#define PROBE_OPT 0
#endif
#ifndef PROBE_MASK
#define PROBE_MASK 0
#endif
#ifndef PROBE_TAIL
#define PROBE_TAIL 0
#define PROBE_TAIL_T 50.0f
#endif
#ifndef PROBE_CLK
#define PROBE_CLK 0
#define PROBE_LAYER 3
#endif
#ifndef MK_ONE_LAUNCH
#define MK_ONE_LAUNCH 1
#endif
constexpr int NPHASES = 2 + 6 * DEPTH;
struct Args { const float* in[17]; float* out; unsigned char* ws; int ph_lo, ph_hi, opt, pad; };
__global__ void __launch_bounds__(NWAVES * 64, 2) yoco_fwd(Args args) {
    extern __shared__ __attribute__((aligned(16))) unsigned char lds[];
    Frame F;
    F.lds = (LAS unsigned char*)lds;
    volatile LAS unsigned* MISC = (volatile LAS unsigned*)(F.lds + MISC_OFF);
    F.tid = threadIdx.x; F.lane = F.tid & 63; F.wave = __builtin_amdgcn_readfirstlane(F.tid >> 6);
    F.G = gridDim.x; { const int bx = blockIdx.x; F.vcu = (F.G % 8 == 0) ? (bx % 8) * (F.G / 8) + bx / 8 : bx; }
    F.out = args.out; F.ws = args.ws;
    unsigned* ctl = (unsigned*)(F.ws + WS_CTL);
    for (int u = F.tid; u < (LDS_BYTES - LDSCTL_OFF) / 4; u += NWAVES * 64) ((LAS unsigned*)(F.lds + LDSCTL_OFF))[u] = 0u;
    __syncthreads();
    if (F.tid < I_NIN) ((LAS unsigned long long*)(F.lds + PTR_OFF))[F.tid] = (unsigned long long)args.in[F.tid];
    __syncthreads();
    const int lo = args.ph_lo, hi = args.ph_hi;
    XcdBarrier bar; bar.bar = ctl + CW_BAR; bar.x = 0; bar.st = nullptr;
    if (hi - lo > 1) bar = xcd_barrier_post(ctl + CW_BAR, MISC + 8);
    long long pc0 = 0, pc1 = 0, pw0 = 0, pw1 = 0; (void)pc0; (void)pc1; (void)pw0; (void)pw1;
#define IN(k) (lo <= (k) && (k) < hi)
#define SEAM(k) do { if (IN(k) && IN((k) + 1)) xcd_barrier(bar); } while (0)

#define PHASE_PTRS() Frame P = F; P.ws = args.ws; LAUNDER_S(P.ws); P.out = args.out; LAUNDER_S(P.out); \
    { int t_ = threadIdx.x; asm volatile("" : "+v"(t_)); P.tid = t_; P.lane = t_ & 63; P.wave = __builtin_amdgcn_readfirstlane(t_ >> 6); } \
    const int gw = P.vcu * NWAVES + P.wave, NGW = P.G * NWAVES; (void)gw; (void)NGW; \
    bf16* const HB = (bf16*)(P.ws + WS_HB); bf16* const PROJ = (bf16*)(P.ws + WS_PROJ); bf16* const KB = (bf16*)(P.ws + WS_KB); bf16* const VT = (bf16*)(P.ws + WS_VT); \
    bf16* const MIX = (bf16*)(P.ws + WS_MIX); bf16* const OB = (bf16*)(P.ws + WS_OB); bf16* const MEMB = (bf16*)(P.ws + WS_MEMB); bf16* const MEMK = (bf16*)(P.ws + WS_MEMK); bf16* const MEMVT = (bf16*)(P.ws + WS_MEMVT); \
    (void)HB; (void)PROJ; (void)KB; (void)VT; (void)MIX; (void)OB; (void)MEMB; (void)MEMK; (void)MEMVT;

    if (IN(0)) { PHASE_PTRS();
#ifndef DIS_P0
        for (int it = gw; it < PW_MEM; it += NGW) p0_do(P, it);
#endif
 }
    SEAM(0);
    if (IN(1)) { PHASE_PTRS();
#ifndef DIS_GMEM
        { pg8::Gemm g{MEMB, (const bf16*)(P.ws + WS_WMK), BATCH * MEM_T, DEPTH * MEMW, DM}; pg8::StaticOrder S; S.init(BATCH * MEM_T, DEPTH * MEMW, F.G, (int)blockIdx.x);
          pg8::EpiBf16 E{MEMK, DEPTH * MEMW, nullptr, nullptr, 0.0625f * 1.44269504089f};
          pg8::gemm_phase<pg8::EpiBf16, pg8::StaticOrder, true, true>(F.lds + RING_OFF, g, S, E); }
        { pg8::Gemm g{(const bf16*)(P.ws + WS_WMV), MEMB, DEPTH * MEMW, BATCH * MEM_T, DM}; pg8::StaticOrder S; S.init(DEPTH * MEMW, BATCH * MEM_T, F.G, (int)((blockIdx.x + F.G / 2) % F.G));
          pg8::EpiBf16 E{MEMVT, BATCH * MEM_T, nullptr, nullptr, 1.0f};
          pg8::gemm_phase<pg8::EpiBf16, pg8::StaticOrder, true, true>(F.lds + RING_OFF, g, S, E); }
#endif
        {
            const int bx = (int)blockIdx.x; const bool isg = bx < 32 || (bx >= P.G / 2 && bx < P.G / 2 + 32);
            if (!isg && P.G == 256) { const int rank = (bx < 128 ? bx - 32 : bx - 64) * NWAVES + P.wave;
                for (int it = PW_MEM + rank; it < PW_SPLIT; it += 192 * NWAVES) p0_do(P, it); }
            for (int it = (P.G == 256 ? PW_SPLIT : PW_MEM) + gw; it < PW_END; it += NGW) p0_do(P, it);
        }
    }
    SEAM(1);
    { constexpr int l = 0;
        const int pb = 2 + 6 * l;
        if (IN(pb)) { PHASE_PTRS();
#if PROBE_CLK
            if (l == PROBE_LAYER) { pc0 = clock64(); pw0 = wall_clock64(); }
#endif
            { pg8::Gemm g{HB, win_ptr(P.ws, l), M, INC, DM}; pg8::StaticOrder S; S.init(M, INC, F.G, (int)blockIdx.x);
              pg8::EpiBf16 E{PROJ, INC, nullptr, nullptr, 1.0f};
              pg8::gemm_phase<pg8::EpiBf16, pg8::StaticOrder, true, true>(F.lds + RING_OFF, g, S, E); }
#ifndef DIS_GVT
            if (l == N_A) {
              { pg8::Gemm g{HB, (const bf16*)(P.ws + WS_WKV), M, MAINW, DM}; pg8::StaticOrder S; S.init(M, MAINW, F.G, (int)blockIdx.x);
                pg8::EpiKVTile<0, M> E{KB, nullptr, 0.08838834764831845f * 1.44269504089f};
                pg8::gemm_phase<pg8::EpiKVTile<0, M>, pg8::StaticOrder, true, true>(F.lds + RING_OFF, g, S, E); }
              { pg8::Gemm g{(const bf16*)(P.ws + WS_WKV) + (size_t)MAINW * DM, HB, MAINW, M, DM}; pg8::StaticOrder S; S.init(MAINW, M, F.G, (int)blockIdx.x);
                pg8::EpiKVTile<1, M> E{VT, nullptr, 1.0f};
                pg8::gemm_phase<pg8::EpiKVTile<1, M>, pg8::StaticOrder, true, true>(F.lds + RING_OFF, g, S, E); }
            }
#endif
#if PROBE_CLK
            if (l == PROBE_LAYER) { pc1 = clock64(); pw1 = wall_clock64(); }
#endif
#if PROBE_TAIL
            if (l == PROBE_LAYER && threadIdx.x == 0) { const unsigned long long t_ = wall_clock64(); atomicMax((unsigned long long*)(P.ws + WS_CTL) + 20, t_); atomicAdd((unsigned long long*)(P.ws + WS_CTL) + 21, t_); }
#endif
        }
        SEAM(pb);
        if (IN(pb + 1)) { PHASE_PTRS();
#ifndef DIS_MEM
            if (args.opt == 0 || args.opt == 3) for (int rep_ = 0; rep_ < PROBE_MEMREP; ++rep_)
            for (int u = P.vcu; u < BATCH * MEM_H * (SEQ / 256); u += P.G) mem_attn_wg(P, l, u / (MEM_H * (SEQ / 256)), (u / (SEQ / 256)) % MEM_H, u % (SEQ / 256));
#endif
#ifndef DIS_LRU
            if (l < N_A) {
                const int xg = (int)blockIdx.x & 7, jg = (int)blockIdx.x >> 3;
                for (int k = jg; k < 3 * LRU_NC; k += (P.G >> 3)) { const int chain = 3 * xg + k % 3; lru_unit_chain(P, l, chain / LRU_NB, chain % LRU_NB, k / 3, args.opt); }
            }
#endif
#ifndef DIS_SB
            if (l >= N_A) { for (int u = P.vcu; u < (args.opt == 1 ? BATCH * SB_H * (SEQ / 256) / 2 : args.opt == 3 ? 0 : BATCH * SB_H * (SEQ / 256)); u += P.G) {
#if PROBE_SBDUMMY
                sb_attn_wg<true>(P, u / (SB_H * (SEQ / 256)), (u / (SEQ / 256)) % SB_H, u % (SEQ / 256));
#endif
                sb_attn_wg<false>(P, u / (SB_H * (SEQ / 256)), (u / (SEQ / 256)) % SB_H, u % (SEQ / 256), args.opt); } }
#endif
        }
        SEAM(pb + 1);
        if (IN(pb + 4)) { PHASE_PTRS();
#ifndef DIS_G2
            pg8::Gemm g{MIX, (const bf16*)(P.ws + WS_WOUT) + (size_t)l * DM * MIXW, M, DM, MIXW}; pg8::StaticOrder S; S.init(M, DM, F.G, (int)blockIdx.x);
            pg8::EpiBf16SS E{OB, DM, (float*)(P.ws + WS_PART)};
            pg8::gemm_phase<pg8::EpiBf16SS, pg8::StaticOrder, true, true>(F.lds + RING_OFF, g, S, E);
#endif
        }
        SEAM(pb + 4);
#ifndef DIS_NR
        if (IN(pb + 5)) { PHASE_PTRS(); nr_phase<l>(P); }
#endif
        SEAM(pb + 5);
    }
    { constexpr int l = 1;
        const int pb = 2 + 6 * l;
        if (IN(pb)) { PHASE_PTRS();
#if PROBE_CLK
            if (l == PROBE_LAYER) { pc0 = clock64(); pw0 = wall_clock64(); }
#endif
            { pg8::Gemm g{HB, win_ptr(P.ws, l), M, INC, DM}; pg8::StaticOrder S; S.init(M, INC, F.G, (int)blockIdx.x);
              pg8::EpiBf16 E{PROJ, INC, nullptr, nullptr, 1.0f};
              pg8::gemm_phase<pg8::EpiBf16, pg8::StaticOrder, true, true>(F.lds + RING_OFF, g, S, E); }
#ifndef DIS_GVT
            if (l == N_A) {
              { pg8::Gemm g{HB, (const bf16*)(P.ws + WS_WKV), M, MAINW, DM}; pg8::StaticOrder S; S.init(M, MAINW, F.G, (int)blockIdx.x);
                pg8::EpiKVTile<0, M> E{KB, nullptr, 0.08838834764831845f * 1.44269504089f};
                pg8::gemm_phase<pg8::EpiKVTile<0, M>, pg8::StaticOrder, true, true>(F.lds + RING_OFF, g, S, E); }
              { pg8::Gemm g{(const bf16*)(P.ws + WS_WKV) + (size_t)MAINW * DM, HB, MAINW, M, DM}; pg8::StaticOrder S; S.init(MAINW, M, F.G, (int)blockIdx.x);
                pg8::EpiKVTile<1, M> E{VT, nullptr, 1.0f};
                pg8::gemm_phase<pg8::EpiKVTile<1, M>, pg8::StaticOrder, true, true>(F.lds + RING_OFF, g, S, E); }
            }
#endif
#if PROBE_CLK
            if (l == PROBE_LAYER) { pc1 = clock64(); pw1 = wall_clock64(); }
#endif
#if PROBE_TAIL
            if (l == PROBE_LAYER && threadIdx.x == 0) { const unsigned long long t_ = wall_clock64(); atomicMax((unsigned long long*)(P.ws + WS_CTL) + 20, t_); atomicAdd((unsigned long long*)(P.ws + WS_CTL) + 21, t_); }
#endif
        }
        SEAM(pb);
        if (IN(pb + 1)) { PHASE_PTRS();
#ifndef DIS_MEM
            if (args.opt == 0 || args.opt == 3) for (int rep_ = 0; rep_ < PROBE_MEMREP; ++rep_)
            for (int u = P.vcu; u < BATCH * MEM_H * (SEQ / 256); u += P.G) mem_attn_wg(P, l, u / (MEM_H * (SEQ / 256)), (u / (SEQ / 256)) % MEM_H, u % (SEQ / 256));
#endif
#ifndef DIS_LRU
            if (l < N_A) {
                const int xg = (int)blockIdx.x & 7, jg = (int)blockIdx.x >> 3;
                for (int k = jg; k < 3 * LRU_NC; k += (P.G >> 3)) { const int chain = 3 * xg + k % 3; lru_unit_chain(P, l, chain / LRU_NB, chain % LRU_NB, k / 3, args.opt); }
            }
#endif
#ifndef DIS_SB
            if (l >= N_A) { for (int u = P.vcu; u < (args.opt == 1 ? BATCH * SB_H * (SEQ / 256) / 2 : args.opt == 3 ? 0 : BATCH * SB_H * (SEQ / 256)); u += P.G) {
#if PROBE_SBDUMMY
                sb_attn_wg<true>(P, u / (SB_H * (SEQ / 256)), (u / (SEQ / 256)) % SB_H, u % (SEQ / 256));
#endif
                sb_attn_wg<false>(P, u / (SB_H * (SEQ / 256)), (u / (SEQ / 256)) % SB_H, u % (SEQ / 256), args.opt); } }
#endif
        }
        SEAM(pb + 1);
        if (IN(pb + 4)) { PHASE_PTRS();
#ifndef DIS_G2
            pg8::Gemm g{MIX, (const bf16*)(P.ws + WS_WOUT) + (size_t)l * DM * MIXW, M, DM, MIXW}; pg8::StaticOrder S; S.init(M, DM, F.G, (int)blockIdx.x);
            pg8::EpiBf16SS E{OB, DM, (float*)(P.ws + WS_PART)};
            pg8::gemm_phase<pg8::EpiBf16SS, pg8::StaticOrder, true, true>(F.lds + RING_OFF, g, S, E);
#endif
        }
        SEAM(pb + 4);
#ifndef DIS_NR
        if (IN(pb + 5)) { PHASE_PTRS(); nr_phase<l>(P); }
#endif
        SEAM(pb + 5);
    }
    { constexpr int l = 2;
        const int pb = 2 + 6 * l;
        if (IN(pb)) { PHASE_PTRS();
#if PROBE_CLK
            if (l == PROBE_LAYER) { pc0 = clock64(); pw0 = wall_clock64(); }
#endif
            { pg8::Gemm g{HB, win_ptr(P.ws, l), M, INC, DM}; pg8::StaticOrder S; S.init(M, INC, F.G, (int)blockIdx.x);
              pg8::EpiBf16 E{PROJ, INC, nullptr, nullptr, 1.0f};
              pg8::gemm_phase<pg8::EpiBf16, pg8::StaticOrder, true, true>(F.lds + RING_OFF, g, S, E); }
#ifndef DIS_GVT
            if (l == N_A) {
              { pg8::Gemm g{HB, (const bf16*)(P.ws + WS_WKV), M, MAINW, DM}; pg8::StaticOrder S; S.init(M, MAINW, F.G, (int)blockIdx.x);
                pg8::EpiKVTile<0, M> E{KB, nullptr, 0.08838834764831845f * 1.44269504089f};
                pg8::gemm_phase<pg8::EpiKVTile<0, M>, pg8::StaticOrder, true, true>(F.lds + RING_OFF, g, S, E); }
              { pg8::Gemm g{(const bf16*)(P.ws + WS_WKV) + (size_t)MAINW * DM, HB, MAINW, M, DM}; pg8::StaticOrder S; S.init(MAINW, M, F.G, (int)blockIdx.x);
                pg8::EpiKVTile<1, M> E{VT, nullptr, 1.0f};
                pg8::gemm_phase<pg8::EpiKVTile<1, M>, pg8::StaticOrder, true, true>(F.lds + RING_OFF, g, S, E); }
            }
#endif
#if PROBE_CLK
            if (l == PROBE_LAYER) { pc1 = clock64(); pw1 = wall_clock64(); }
#endif
#if PROBE_TAIL
            if (l == PROBE_LAYER && threadIdx.x == 0) { const unsigned long long t_ = wall_clock64(); atomicMax((unsigned long long*)(P.ws + WS_CTL) + 20, t_); atomicAdd((unsigned long long*)(P.ws + WS_CTL) + 21, t_); }
#endif
        }
        SEAM(pb);
        if (IN(pb + 1)) { PHASE_PTRS();
#ifndef DIS_MEM
            if (args.opt == 0 || args.opt == 3) for (int rep_ = 0; rep_ < PROBE_MEMREP; ++rep_)
            for (int u = P.vcu; u < BATCH * MEM_H * (SEQ / 256); u += P.G) mem_attn_wg(P, l, u / (MEM_H * (SEQ / 256)), (u / (SEQ / 256)) % MEM_H, u % (SEQ / 256));
#endif
#ifndef DIS_LRU
            if (l < N_A) {
                const int xg = (int)blockIdx.x & 7, jg = (int)blockIdx.x >> 3;
                for (int k = jg; k < 3 * LRU_NC; k += (P.G >> 3)) { const int chain = 3 * xg + k % 3; lru_unit_chain(P, l, chain / LRU_NB, chain % LRU_NB, k / 3, args.opt); }
            }
#endif
#ifndef DIS_SB
            if (l >= N_A) { for (int u = P.vcu; u < (args.opt == 1 ? BATCH * SB_H * (SEQ / 256) / 2 : args.opt == 3 ? 0 : BATCH * SB_H * (SEQ / 256)); u += P.G) {
#if PROBE_SBDUMMY
                sb_attn_wg<true>(P, u / (SB_H * (SEQ / 256)), (u / (SEQ / 256)) % SB_H, u % (SEQ / 256));
#endif
                sb_attn_wg<false>(P, u / (SB_H * (SEQ / 256)), (u / (SEQ / 256)) % SB_H, u % (SEQ / 256), args.opt); } }
#endif
        }
        SEAM(pb + 1);
        if (IN(pb + 4)) { PHASE_PTRS();
#ifndef DIS_G2
            pg8::Gemm g{MIX, (const bf16*)(P.ws + WS_WOUT) + (size_t)l * DM * MIXW, M, DM, MIXW}; pg8::StaticOrder S; S.init(M, DM, F.G, (int)blockIdx.x);
            pg8::EpiBf16SS E{OB, DM, (float*)(P.ws + WS_PART)};
            pg8::gemm_phase<pg8::EpiBf16SS, pg8::StaticOrder, true, true>(F.lds + RING_OFF, g, S, E);
#endif
        }
        SEAM(pb + 4);
#ifndef DIS_NR
        if (IN(pb + 5)) { PHASE_PTRS(); nr_phase<l>(P); }
#endif
        SEAM(pb + 5);
    }
    { constexpr int l = 3;
        const int pb = 2 + 6 * l;
        if (IN(pb)) { PHASE_PTRS();
#if PROBE_CLK
            if (l == PROBE_LAYER) { pc0 = clock64(); pw0 = wall_clock64(); }
#endif
            { pg8::Gemm g{HB, win_ptr(P.ws, l), M, INC, DM}; pg8::StaticOrder S; S.init(M, INC, F.G, (int)blockIdx.x);
              pg8::EpiBf16 E{PROJ, INC, nullptr, nullptr, 1.0f};
              pg8::gemm_phase<pg8::EpiBf16, pg8::StaticOrder, true, true>(F.lds + RING_OFF, g, S, E); }
#ifndef DIS_GVT
            if (l == N_A) {
              { pg8::Gemm g{HB, (const bf16*)(P.ws + WS_WKV), M, MAINW, DM}; pg8::StaticOrder S; S.init(M, MAINW, F.G, (int)blockIdx.x);
                pg8::EpiKVTile<0, M> E{KB, nullptr, 0.08838834764831845f * 1.44269504089f};
                pg8::gemm_phase<pg8::EpiKVTile<0, M>, pg8::StaticOrder, true, true>(F.lds + RING_OFF, g, S, E); }
              { pg8::Gemm g{(const bf16*)(P.ws + WS_WKV) + (size_t)MAINW * DM, HB, MAINW, M, DM}; pg8::StaticOrder S; S.init(MAINW, M, F.G, (int)blockIdx.x);
                pg8::EpiKVTile<1, M> E{VT, nullptr, 1.0f};
                pg8::gemm_phase<pg8::EpiKVTile<1, M>, pg8::StaticOrder, true, true>(F.lds + RING_OFF, g, S, E); }
            }
#endif
#if PROBE_CLK
            if (l == PROBE_LAYER) { pc1 = clock64(); pw1 = wall_clock64(); }
#endif
#if PROBE_TAIL
            if (l == PROBE_LAYER && threadIdx.x == 0) { const unsigned long long t_ = wall_clock64(); atomicMax((unsigned long long*)(P.ws + WS_CTL) + 20, t_); atomicAdd((unsigned long long*)(P.ws + WS_CTL) + 21, t_); }
#endif
        }
        SEAM(pb);
        if (IN(pb + 1)) { PHASE_PTRS();
#ifndef DIS_MEM
            if (args.opt == 0 || args.opt == 3) for (int rep_ = 0; rep_ < PROBE_MEMREP; ++rep_)
            for (int u = P.vcu; u < BATCH * MEM_H * (SEQ / 256); u += P.G) mem_attn_wg(P, l, u / (MEM_H * (SEQ / 256)), (u / (SEQ / 256)) % MEM_H, u % (SEQ / 256));
#endif
#ifndef DIS_LRU
            if (l < N_A) {
                const int xg = (int)blockIdx.x & 7, jg = (int)blockIdx.x >> 3;
                for (int k = jg; k < 3 * LRU_NC; k += (P.G >> 3)) { const int chain = 3 * xg + k % 3; lru_unit_chain(P, l, chain / LRU_NB, chain % LRU_NB, k / 3, args.opt); }
            }
#endif
#ifndef DIS_SB
            if (l >= N_A) { for (int u = P.vcu; u < (args.opt == 1 ? BATCH * SB_H * (SEQ / 256) / 2 : args.opt == 3 ? 0 : BATCH * SB_H * (SEQ / 256)); u += P.G) {
#if PROBE_SBDUMMY
                sb_attn_wg<true>(P, u / (SB_H * (SEQ / 256)), (u / (SEQ / 256)) % SB_H, u % (SEQ / 256));
#endif
                sb_attn_wg<false>(P, u / (SB_H * (SEQ / 256)), (u / (SEQ / 256)) % SB_H, u % (SEQ / 256), args.opt); } }
#endif
        }
        SEAM(pb + 1);
        if (IN(pb + 4)) { PHASE_PTRS();
#ifndef DIS_G2
            pg8::Gemm g{MIX, (const bf16*)(P.ws + WS_WOUT) + (size_t)l * DM * MIXW, M, DM, MIXW}; pg8::StaticOrder S; S.init(M, DM, F.G, (int)blockIdx.x);
            pg8::EpiBf16SS E{OB, DM, (float*)(P.ws + WS_PART)};
            pg8::gemm_phase<pg8::EpiBf16SS, pg8::StaticOrder, true, true>(F.lds + RING_OFF, g, S, E);
#endif
        }
        SEAM(pb + 4);
#ifndef DIS_NR
        if (IN(pb + 5)) { PHASE_PTRS(); nr_phase<l>(P); }
#endif
        SEAM(pb + 5);
    }
#if PROBE_TAIL
    xcd_barrier(bar);
    if (blockIdx.x == 0 && threadIdx.x == 0) { const unsigned long long mx = ((unsigned long long*)(args.ws + WS_CTL))[20], sm = ((unsigned long long*)(args.ws + WS_CTL))[21]; const float tail_us = ((float)(long long)(mx - sm / 256ull)) * 0.01f; if (tail_us > PROBE_TAIL_T) args.out[0] += 1000.0f; }
#endif
#if PROBE_CLK
    xcd_barrier(bar);
    if (blockIdx.x == 0 && threadIdx.x == 0) { const float ghz = (float)(pc1 - pc0) / ((float)(pw1 - pw0) * 10.0f); args.out[0] += (PROBE_CLK == 1 ? (ghz > PROBE_T ? 1000.0f : 0.0f) : (float)(pw1 - pw0) * 0.01f); }
#endif
#undef IN
#undef SEAM
}

extern "C" void kernel_launch(void* const* d_in, const int* in_sizes, int n_in, void* d_out, int out_size, void* d_ws, size_t ws_size, hipStream_t stream) {
    static int grid = 0;
    if (grid == 0) {
        if (n_in != 17 || in_sizes[0] != M * DM || out_size != M * DM || ws_size < WS_END) { fprintf(stderr, "kernel_launch: unexpected shapes (n_in %d, in0 %d, out %d, ws %zu); nothing launched\n", n_in, n_in > 0 ? in_sizes[0] : -1, out_size, ws_size); grid = -1; return; }
        int dev = 0, cus = 0, per_cu = 0;
        if (hipGetDevice(&dev) != hipSuccess || hipDeviceGetAttribute(&cus, hipDeviceAttributeMultiprocessorCount, dev) != hipSuccess) { grid = -1; return; }
        if (hipFuncSetAttribute((const void*)yoco_fwd, hipFuncAttributeMaxDynamicSharedMemorySize, LDS_BYTES) != hipSuccess) { fprintf(stderr, "kernel_launch: hipFuncSetAttribute failed\n"); grid = -1; return; }
        if (hipOccupancyMaxActiveBlocksPerMultiprocessor(&per_cu, (const void*)yoco_fwd, NWAVES * 64, LDS_BYTES) != hipSuccess || per_cu < 1)
            fprintf(stderr, "kernel_launch: note: occupancy query reports %d workgroups per CU\n", per_cu);
        (void)hipGetLastError();
        grid = cus;
    }
    if (grid < 0) return;
    if (hipMemsetAsync((char*)d_ws + WS_CTL, 0, CTL_ZERO_BYTES, stream) != hipSuccess) return;
    Args a{};
    for (int i = 0; i < 17; ++i) a.in[i] = (const float*)d_in[i];
    a.out = (float*)d_out; a.ws = (unsigned char*)d_ws;
#if MK_ONE_LAUNCH
    a.ph_lo = 0; a.ph_hi = NPHASES;
    hipLaunchKernelGGL(yoco_fwd, dim3(grid), dim3(NWAVES * 64), LDS_BYTES, stream, a);
#else
    for (int ph = 0; ph < NPHASES; ++ph) {
        if (ph >= 2 && ((ph - 2) % 6 == 2 || (ph - 2) % 6 == 3)) continue;
        a.ph_lo = ph; a.ph_hi = ph + 1;
        for (int rep = 0; rep < (((PROBE_MASK >> ph) & 1) ? 2 : 1); ++rep) {
            a.opt = rep ? PROBE_OPT : 0;
            hipLaunchKernelGGL(yoco_fwd, dim3(grid), dim3(NWAVES * 64), LDS_BYTES, stream, a); }
        a.opt = 0;
    }
#endif
}
```

```cpp
#include <hip/hip_runtime.h>
#include <cstdio>
#include <cstdint>
namespace pg8 {
#define PG8_LAS __attribute__((address_space(3)))
typedef unsigned short bf16_t;
typedef short bf16x8 __attribute__((ext_vector_type(8)));
typedef float f32x4 __attribute__((ext_vector_type(4)));
typedef unsigned u32x4 __attribute__((ext_vector_type(4)));
constexpr int BM = 256, BK = 64, HALF = 128, HTB = HALF * BK * 2  , STAGE_BYTES = 8 * HTB, NXCD = 8, WGM = 8;

__host__ __device__ __forceinline__ int lds_byte(int r, int c) { const int st = (r >> 4) * 2 + (c >> 5), rr = r & 15, cc = c & 31, ob = rr * 64 + cc * 2; return st * 1024 + (ob ^ (((ob >> 9) & 1) << 5)); }
__host__ __device__ __forceinline__ void stage_rc(int b, int& R, int& C) { const int st = b / 1024, sb = b % 1024, swz = sb ^ (((sb >> 9) & 1) << 5); R = (st >> 1) * 16 + swz / 64; C = (st & 1) * 32 + (swz % 64) / 2; }
__host__ __device__ __forceinline__ int perm32(int rho) { const int n = rho >> 4, i = rho & 15; return 8 * (i >> 2) + 4 * n + (i & 3); }

struct Unit { int pm, pn; };
struct Gemm { const bf16_t* A; const bf16_t* Bt; int M, N, K; };

struct StaticOrder {
    int nM, nN, nwg, G, c;
    __host__ __device__ void init(int M, int N, int G_, int c_) { nM = M / BM; nN = N / BM; nwg = nM * nN; G = G_; c = c_; }
    __host__ __device__ bool next(int i, Unit& u) const {
        const long L = (long)i * G + c; if (L >= nwg) return false;
        int wgid = (int)L; { const int q = nwg / NXCD, r = nwg % NXCD, xcd = wgid % NXCD, off = wgid / NXCD; wgid = (xcd < r ? xcd * (q + 1) : r * (q + 1) + (xcd - r) * q) + off; }
        const int nig = WGM * nN, gid = wgid / nig, fm = gid * WGM, gsz = (nM - fm) < WGM ? (nM - fm) : WGM;
        u.pm = fm + ((wgid % nig) % gsz); u.pn = (wgid % nig) / gsz; return true;
    }
    __device__ __forceinline__ void a_ready(const Unit&) const {}
    __device__ __forceinline__ void done(const Unit&) const {}
};

__device__ __forceinline__ unsigned cvt_pk_bf16(float lo, float hi) { unsigned r; asm volatile("v_cvt_pk_bf16_f32 %0, %1, %2" : "=v"(r) : "v"(lo), "v"(hi)); return r; }

struct EpiBf16 {
    static constexpr bool PERM = true, AFTER_DRAIN = false;
    bf16_t* O; int ldc; const float* rscale; const float* cscale; float ks;
    __device__ __forceinline__ void operator()(const f32x4 (&acc)[2][2][4][2], const Unit& u, int wr, int wc, int fr, int fq) const {
        const int row0 = u.pm * BM + wr * 64 + fr; const int col0 = u.pn * BM + wc * 32 + 8 * fq;
        f32x4 cs[2][2];
#pragma unroll
        for (int bj = 0; bj < 2; ++bj)
#pragma unroll
            for (int n = 0; n < 2; ++n) cs[bj][n] = cscale ? *(const f32x4*)(cscale + col0 + bj * HALF + 4 * n) : (f32x4){1.f, 1.f, 1.f, 1.f};
#pragma unroll
        for (int ai = 0; ai < 2; ++ai)
#pragma unroll
            for (int m = 0; m < 4; ++m) { const int row = row0 + ai * HALF + m * 16; bf16_t* rowp = O + (size_t)row * ldc + col0; const float rs = (rscale ? rscale[row] : 1.f) * ks;
#pragma unroll
                for (int bj = 0; bj < 2; ++bj) { const f32x4 v0 = acc[ai][bj][m][0] * rs * cs[bj][0], v1 = acc[ai][bj][m][1] * rs * cs[bj][1];
                    u32x4 w; w.x = cvt_pk_bf16(v0[0], v0[1]); w.y = cvt_pk_bf16(v0[2], v0[3]); w.z = cvt_pk_bf16(v1[0], v1[1]); w.w = cvt_pk_bf16(v1[2], v1[3]);
                    *(u32x4*)(rowp + bj * HALF) = w; } }
    }
};
template <int MODE, int M_> struct EpiKVTile {
    static constexpr bool PERM = true, AFTER_DRAIN = false;
    bf16_t* O; const float* scale; float ks;
    __device__ __forceinline__ void operator()(const f32x4 (&acc)[2][2][4][2], const Unit& u, int wr, int wc, int fr, int fq) const {
        const int row0 = u.pm * BM + wr * 64 + fr; const int col0 = u.pn * BM + wc * 32 + 8 * fq;
        f32x4 cs[2][2];
#pragma unroll
        for (int bj = 0; bj < 2; ++bj)
#pragma unroll
            for (int n = 0; n < 2; ++n) cs[bj][n] = (MODE == 1 && scale) ? *(const f32x4*)(scale + col0 + bj * HALF + 4 * n) : (f32x4){1.f, 1.f, 1.f, 1.f};
#pragma unroll
        for (int ai = 0; ai < 2; ++ai)
#pragma unroll
            for (int m = 0; m < 4; ++m) { const int row = row0 + ai * HALF + m * 16; const float rs = ((MODE == 0 && scale) ? scale[row] : 1.f) * ks;
#pragma unroll
                for (int bj = 0; bj < 2; ++bj) { const f32x4 v0 = acc[ai][bj][m][0] * rs * cs[bj][0], v1 = acc[ai][bj][m][1] * rs * cs[bj][1];
                    u32x4 w; w.x = cvt_pk_bf16(v0[0], v0[1]); w.y = cvt_pk_bf16(v0[2], v0[3]); w.z = cvt_pk_bf16(v1[0], v1[1]); w.w = cvt_pk_bf16(v1[2], v1[3]);
                    const int col = col0 + bj * HALF;
                    size_t off;
                    if (MODE == 0) off = ((size_t)(col >> 7) * M_ + row) * 128 + (col & 127);
                    else off = (((size_t)(row >> 7) * (M_ / 64) + (col >> 6)) * 128 + (row & 127)) * 64 + (col & 63);
                    *(u32x4*)(O + off) = w; } }
    }
};
struct EpiBf16SS {
    static constexpr bool PERM = true, AFTER_DRAIN = false;
    bf16_t* O; int ldc; float* part;
    __device__ __forceinline__ void operator()(const f32x4 (&acc)[2][2][4][2], const Unit& u, int wr, int wc, int fr, int fq) const {
        const int row0 = u.pm * BM + wr * 64 + fr; const int col0 = u.pn * BM + wc * 32 + 8 * fq;
#pragma unroll
        for (int ai = 0; ai < 2; ++ai)
#pragma unroll
            for (int m = 0; m < 4; ++m) { const int row = row0 + ai * HALF + m * 16; bf16_t* rowp = O + (size_t)row * ldc + col0; float ss = 0.f;
#pragma unroll
                for (int bj = 0; bj < 2; ++bj) { const f32x4 v0 = acc[ai][bj][m][0], v1 = acc[ai][bj][m][1];
                    ss += (v0[0] * v0[0] + v0[1] * v0[1]) + (v0[2] * v0[2] + v0[3] * v0[3]) + (v1[0] * v1[0] + v1[1] * v1[1]) + (v1[2] * v1[2] + v1[3] * v1[3]);
                    u32x4 w; w.x = cvt_pk_bf16(v0[0], v0[1]); w.y = cvt_pk_bf16(v0[2], v0[3]); w.z = cvt_pk_bf16(v1[0], v1[1]); w.w = cvt_pk_bf16(v1[2], v1[3]);
                    *(u32x4*)(rowp + bj * HALF) = w; }
                ss += __shfl_xor(ss, 16); ss += __shfl_xor(ss, 32);
                if (fq == 0) part[(size_t)row * 64 + u.pn * 4 + wc] = ss; }
    }
};

template <class Epi, class Sched, bool ALIGN_EPI = false, bool SP2 = false>
__device__ __forceinline__ void gemm_phase(PG8_LAS unsigned char* lds, const Gemm g, const Sched& S, const Epi& E) {
    int tid_l = threadIdx.x; asm volatile("" : "+v"(tid_l));
    const int tid = tid_l, wid = __builtin_amdgcn_readfirstlane(tid >> 6), lane = tid & 63, wr = wid >> 2, wc = wid & 3, fr = lane & 15, fq = lane >> 4;
    const int K = g.K, nt = K / BK;
    unsigned voffA[2], voffB[2];
#pragma unroll
    for (int i = 0; i < 2; ++i) { int R, C; stage_rc(tid * 16 + i * 8192, R, C); const int Rb = Epi::PERM ? ((R & ~31) + perm32(R & 31)) : R;
        voffA[i] = (unsigned)(R * K + C) * 2u; voffB[i] = (unsigned)(Rb * K + C) * 2u; }
    const size_t kstep = (size_t)(BK * 2);
    const size_t hstep = (size_t)HALF * K * 2;
    const size_t tstep = 2 * hstep;
    const unsigned ldsw = (unsigned)wid * 1024u;
    const int aoff = lds_byte(wr * 64 + fr, fq * 8), boff = lds_byte(wc * 32 + fr, fq * 8);
#define PG8_SA(b, h) (((b) * 2 + (h)) * HTB)
#define PG8_SB(b, h) ((4 + (b) * 2 + (h)) * HTB)
#define PG8_STAGE(bufoff, gbase, voff) do { _Pragma("unroll") for (int _i = 0; _i < 2; ++_i) \
        __builtin_amdgcn_global_load_lds((const unsigned*)((const char*)(gbase) + (voff)[_i]), (PG8_LAS unsigned*)(lds + (bufoff) + ldsw + _i * 8192), 16, 0, 0); } while (0)
#define PG8_LDA(dst, b, h) do { _Pragma("unroll") for (int m = 0; m < 4; ++m) _Pragma("unroll") for (int k = 0; k < 2; ++k) dst[m][k] = *(const PG8_LAS bf16x8*)(lds + PG8_SA(b, h) + aoff + m * 2048 + k * 1024); } while (0)
#define PG8_LDB(dst, b, h) do { _Pragma("unroll") for (int n = 0; n < 2; ++n) _Pragma("unroll") for (int k = 0; k < 2; ++k) dst[n][k] = *(const PG8_LAS bf16x8*)(lds + PG8_SB(b, h) + boff + n * 2048 + k * 1024); } while (0)
#define PG8_MMA(ai, bj, At, Bt) do { PG8_SCHED; _Pragma("unroll") for (int m = 0; m < 4; ++m) _Pragma("unroll") for (int n = 0; n < 2; ++n) _Pragma("unroll") for (int k = 0; k < 2; ++k) \
        acc[ai][bj][m][n] = __builtin_amdgcn_mfma_f32_16x16x32_bf16(Bt[n][k], At[m][k], acc[ai][bj][m][n], 0, 0, 0); PG8_SCHED; } while (0)
#define PG8_WAIT_V(n) asm volatile("s_waitcnt vmcnt(" #n ")" ::: "memory")
#define PG8_WAIT_L(n) asm volatile("s_waitcnt lgkmcnt(" #n ")" ::: "memory")
#define PG8_BAR __builtin_amdgcn_s_barrier()
#define PG8_SCHED __builtin_amdgcn_sched_barrier(0)
    Unit cur, nxt; int ui = 0;
    if (!S.next(0, cur)) return;
    f32x4 acc[2][2][4][2];
#pragma unroll
    for (int a = 0; a < 2; ++a)
#pragma unroll
        for (int b = 0; b < 2; ++b)
#pragma unroll
            for (int m = 0; m < 4; ++m)
#pragma unroll
                for (int n = 0; n < 2; ++n) acc[a][b][m][n] = (f32x4){0.f, 0.f, 0.f, 0.f};
    bf16x8 At[4][2], B0[2][2], B1[2][2];
    const char* cA = (const char*)g.A + (size_t)cur.pm * tstep; const char* cB = (const char*)g.Bt + (size_t)cur.pn * tstep;
    S.a_ready(cur);
    if constexpr (SP2) {
        PG8_STAGE(PG8_SB(0, 0), cB, voffB); PG8_STAGE(PG8_SB(0, 1), cB + hstep, voffB); PG8_STAGE(PG8_SA(0, 0), cA, voffA); PG8_STAGE(PG8_SA(0, 1), cA + hstep, voffA);
        if (wr == 1) PG8_BAR;
        PG8_WAIT_V(2); PG8_BAR;
        PG8_STAGE(PG8_SB(1, 0), cB + kstep, voffB); PG8_STAGE(PG8_SA(1, 0), cA + kstep, voffA); PG8_STAGE(PG8_SB(1, 1), cB + hstep + kstep, voffB);
        PG8_WAIT_V(6); PG8_BAR;
    } else {
        PG8_STAGE(PG8_SB(0, 0), cB, voffB); PG8_STAGE(PG8_SA(0, 0), cA, voffA); PG8_STAGE(PG8_SB(0, 1), cB + hstep, voffB); PG8_STAGE(PG8_SA(0, 1), cA + hstep, voffA);
        if (wr == 1) PG8_BAR;
        PG8_WAIT_V(4); PG8_BAR;
        PG8_STAGE(PG8_SB(1, 0), cB + kstep, voffB); PG8_STAGE(PG8_SA(1, 0), cA + kstep, voffA); PG8_STAGE(PG8_SB(1, 1), cB + hstep + kstep, voffB);
        PG8_WAIT_V(6); PG8_BAR;
    }
    for (;;) {
        const bool has_next = S.next(ui + 1, nxt);
        const char* nA = has_next ? (const char*)g.A + (size_t)nxt.pm * tstep : cA; const char* nB = has_next ? (const char*)g.Bt + (size_t)nxt.pn * tstep : cB;
        for (int t = 0; t < nt; t += 2) {
            const bool last = (t == nt - 2);
            const char* a1 = cA + (size_t)(t + 1) * kstep;
            const char* a2 = last ? nA : cA + (size_t)(t + 2) * kstep; const char* b2 = last ? nB : cB + (size_t)(t + 2) * kstep;
            const char* a3 = a2 + kstep; const char* b3 = b2 + kstep;
            if (last && has_next) S.a_ready(nxt);
            if constexpr (SP2) {
            PG8_LDB(B0, 0, 0); PG8_LDB(B1, 0, 1); PG8_SCHED; PG8_LDA(At, 0, 0); PG8_STAGE(PG8_SA(1, 1), a1 + hstep, voffA);
            PG8_WAIT_V(8); PG8_WAIT_L(0); PG8_BAR; PG8_MMA(0, 0, At, B0); PG8_MMA(0, 1, At, B1); PG8_BAR; PG8_SCHED;
            PG8_LDA(At, 0, 1); PG8_STAGE(PG8_SB(0, 0), b2, voffB); PG8_STAGE(PG8_SB(0, 1), b2 + hstep, voffB); PG8_STAGE(PG8_SA(0, 0), a2, voffA);
            PG8_WAIT_V(8); PG8_WAIT_L(0); PG8_BAR; PG8_MMA(1, 0, At, B0); PG8_MMA(1, 1, At, B1); PG8_BAR; PG8_SCHED;
            PG8_LDB(B0, 1, 0); PG8_LDB(B1, 1, 1); PG8_SCHED; PG8_LDA(At, 1, 0); PG8_STAGE(PG8_SA(0, 1), a2 + hstep, voffA);
            PG8_WAIT_V(8); PG8_WAIT_L(0); PG8_BAR; PG8_MMA(0, 0, At, B0); PG8_MMA(0, 1, At, B1); PG8_BAR; PG8_SCHED;
            PG8_LDA(At, 1, 1); PG8_STAGE(PG8_SB(1, 0), b3, voffB); PG8_STAGE(PG8_SB(1, 1), b3 + hstep, voffB); PG8_STAGE(PG8_SA(1, 0), a3, voffA);
            PG8_WAIT_V(8); PG8_WAIT_L(0); PG8_BAR; PG8_MMA(1, 0, At, B0); PG8_MMA(1, 1, At, B1); PG8_BAR; PG8_SCHED;
            } else {
            PG8_LDB(B0, 0, 0); PG8_SCHED; PG8_LDA(At, 0, 0); PG8_STAGE(PG8_SA(1, 1), a1 + hstep, voffA);
            PG8_WAIT_L(8); PG8_BAR; PG8_WAIT_L(0); PG8_MMA(0, 0, At, B0); PG8_BAR; PG8_SCHED;
            PG8_LDB(B1, 0, 1); PG8_STAGE(PG8_SB(0, 0), b2, voffB);
            PG8_BAR; PG8_WAIT_L(0); PG8_MMA(0, 1, At, B1); PG8_BAR;
            PG8_LDA(At, 0, 1); PG8_STAGE(PG8_SA(0, 0), a2, voffA);
            PG8_BAR; PG8_WAIT_L(0); PG8_MMA(1, 0, At, B0); PG8_BAR; PG8_SCHED;
            PG8_STAGE(PG8_SB(0, 1), b2 + hstep, voffB);
            PG8_WAIT_V(6); PG8_BAR; PG8_MMA(1, 1, At, B1); PG8_BAR;
            PG8_LDB(B0, 1, 0); PG8_SCHED; PG8_LDA(At, 1, 0); PG8_STAGE(PG8_SA(0, 1), a2 + hstep, voffA);
            PG8_WAIT_L(8); PG8_BAR; PG8_WAIT_L(0); PG8_MMA(0, 0, At, B0); PG8_BAR; PG8_SCHED;
            PG8_LDB(B1, 1, 1); PG8_STAGE(PG8_SB(1, 0), b3, voffB);
            PG8_BAR; PG8_WAIT_L(0); PG8_MMA(0, 1, At, B1); PG8_BAR;
            PG8_LDA(At, 1, 1); PG8_STAGE(PG8_SA(1, 0), a3, voffA);
            PG8_BAR; PG8_WAIT_L(0); PG8_MMA(1, 0, At, B0); PG8_BAR; PG8_SCHED;
            PG8_STAGE(PG8_SB(1, 1), b3 + hstep, voffB);
            PG8_WAIT_V(6); PG8_BAR; PG8_MMA(1, 1, At, B1); PG8_BAR;
            }
        }
        if constexpr (ALIGN_EPI) { if (wr == 0) PG8_BAR; }
        if constexpr (!Epi::AFTER_DRAIN) { E(acc, cur, wr, wc, fr, fq); S.done(cur); }
        if (!has_next) break;
#pragma unroll
        for (int a = 0; a < 2; ++a)
#pragma unroll
            for (int b = 0; b < 2; ++b)
#pragma unroll
                for (int m = 0; m < 4; ++m)
#pragma unroll
                    for (int n = 0; n < 2; ++n) acc[a][b][m][n] = (f32x4){0.f, 0.f, 0.f, 0.f};
        cur = nxt; cA = nA; cB = nB; ++ui;
        if constexpr (ALIGN_EPI) { if (wr == 1) PG8_BAR; }
    }
    PG8_WAIT_V(0);
    if constexpr (!ALIGN_EPI) { if (wr == 0) PG8_BAR; }
    PG8_BAR;
    if constexpr (Epi::AFTER_DRAIN) { E.fused(acc, cur, wr, wc, fr, fq, lds, wid, lane); S.done(cur); }
#undef PG8_SA
#undef PG8_SB
#undef PG8_STAGE
#undef PG8_LDA
#undef PG8_LDB
#undef PG8_MMA
#undef PG8_WAIT_V
#undef PG8_WAIT_L
#undef PG8_BAR
#undef PG8_SCHED
}
}
constexpr int BATCH = 2, SEQ = 8192, DM = 4096, M = BATCH * SEQ, DEPTH = 4, N_A = 2;
constexpr int MAINW = 3072, MEMW = 1024, INC = 8192, MIXW = 4096, KVW = 6144;
constexpr int LRU_NB = 12, SB_H = 24, MEM_T = 256, MEM_H = 4;
constexpr float EPS = 1e-6f;
constexpr int NWAVES = 8;
constexpr int LRU_T = 128, LRU_NC = SEQ / LRU_T;

constexpr size_t MiB = 1u << 20;
constexpr size_t WS_CTL = 0, CTL_ZERO_BYTES = 8 * MiB;
constexpr size_t WS_GRAN = 1 * MiB;
constexpr int CW_TMO = 16;
constexpr size_t WS_WIN0 = 16 * MiB, WS_WKV = 272 * MiB;
constexpr size_t WS_WOUT = 320 * MiB;
constexpr size_t WS_WMK = 448 * MiB, WS_WMV = 480 * MiB;
constexpr size_t WS_WG = 512 * MiB;
constexpr size_t WS_HB = 520 * MiB;
constexpr size_t WS_MEMB = 648 * MiB;
constexpr size_t WS_MEMK = 652 * MiB;
constexpr size_t WS_MEMVT = 656 * MiB;
constexpr size_t WS_PROJ = 660 * MiB;
constexpr size_t WS_KB = 1400 * MiB;
constexpr size_t WS_VT = 1500 * MiB;
constexpr size_t WS_MIX = 1108 * MiB;
constexpr size_t WS_OB = 1236 * MiB;
constexpr size_t WS_PART = 1364 * MiB;
constexpr size_t WS_AGG = 1368 * MiB;
constexpr size_t WS_RSTD = 1372 * MiB + 512 * 1024;
constexpr size_t WS_CARRY = 1371 * MiB;
constexpr size_t WS_END = 1600 * MiB;
constexpr int KPITCH = MAINW + 64, VTPITCH = M + 64;
constexpr int CW_BAR = 4096;

constexpr int RING_OFF = 0, RING_BYTES = 131072;
constexpr int LDSCTL_OFF = RING_BYTES, MISC_OFF = LDSCTL_OFF + 320;
constexpr int LDS_BYTES = 147456;
constexpr int UT_PITCH = 264;

#define GAS __attribute__((address_space(1)))
#define LAS __attribute__((address_space(3)))
typedef unsigned short bf16;
typedef unsigned v4u __attribute__((ext_vector_type(4)));
typedef unsigned v2u __attribute__((ext_vector_type(2)));
typedef float f32x4 __attribute__((ext_vector_type(4)));
typedef short bf16x8 __attribute__((ext_vector_type(8)));
typedef short bf16x4 __attribute__((ext_vector_type(4)));
typedef float f32x2 __attribute__((ext_vector_type(2)));
typedef GAS unsigned gu32;
#define LDS_WAIT() asm volatile("s_waitcnt lgkmcnt(0)" ::: "memory")
#define VM_WAIT() asm volatile("s_waitcnt vmcnt(0)" ::: "memory")
#define MFMA16(a, b, c) __builtin_amdgcn_mfma_f32_16x16x32_bf16((a), (b), (c), 0, 0, 0)
typedef __bf16 bf16x2v __attribute__((ext_vector_type(2)));
__device__ __forceinline__ unsigned pk2(float lo, float hi) { f32x2 v; v.x = lo; v.y = hi; return __builtin_bit_cast(unsigned, __builtin_convertvector(v, bf16x2v)); }
__device__ __forceinline__ unsigned f2bf(float f) { return pk2(f, 0.f) & 0xffffu; }
__device__ __forceinline__ float bf2f(unsigned short h) { return __builtin_bit_cast(float, (unsigned)h << 16); }
__device__ __forceinline__ float bflo(unsigned w) { return __builtin_bit_cast(float, w << 16); }
__device__ __forceinline__ float bfhi(unsigned w) { return __builtin_bit_cast(float, w & 0xffff0000u); }
__device__ __forceinline__ float wave_sum(float v) {
#pragma unroll
    for (int o = 1; o < 64; o <<= 1) v += __shfl_xor(v, o);
    return v;
}
#ifndef PL_SB
#define PL_SB 0
#endif
#ifndef PL_LRU
#define PL_LRU 1
#endif
__device__ __forceinline__ float xor16s(float v, int) { return __shfl_xor(v, 16); }
__device__ __forceinline__ float xor32s(float v, int) { return __shfl_xor(v, 32); }
__device__ __forceinline__ float xor16(float v, int g) { unsigned a = __builtin_bit_cast(unsigned, v), b = a;
    asm volatile("s_nop 1\n\tv_permlane16_swap_b32 %0, %1\n\ts_nop 1" : "+v"(a), "+v"(b)); return __builtin_bit_cast(float, (g & 1) ? a : b); }
__device__ __forceinline__ float xor32(float v, int g) { unsigned a = __builtin_bit_cast(unsigned, v), b = a;
    asm volatile("s_nop 1\n\tv_permlane32_swap_b32 %0, %1\n\ts_nop 1" : "+v"(a), "+v"(b)); return __builtin_bit_cast(float, (g & 2) ? a : b); }
__device__ __forceinline__ float fast_exp(float x) { return __builtin_amdgcn_exp2f(x * 1.44269504089f); }
__device__ __forceinline__ float fast_sigmoid(float x) { return __builtin_amdgcn_rcpf(1.0f + fast_exp(-x)); }
__device__ __forceinline__ float silu_f(float x) { return x * fast_sigmoid(x); }
__device__ __forceinline__ float softplus_f(float z) { return fmaxf(z, 0.f) + __builtin_amdgcn_logf(1.0f + fast_exp(-fabsf(z))) * 0.69314718056f; }

#define XB_TMO      128
#define XB_XCNT(j)  (256  + 64 * (j))
#define XB_XSUB(j)  (1280 + 64 * (j))
#define XB_XGEN(j)  (2304 + 64 * (j))
#define XB_TOP      3328
#define XB_TOPGEN   3392
#define XCD_BAR_WORDS 3456
#define XB_SPIN_CAP (1u << 18)
__device__ __forceinline__ unsigned xb_ld(unsigned* p)              { return __hip_atomic_load(p, __ATOMIC_RELAXED, __HIP_MEMORY_SCOPE_AGENT); }
__device__ __forceinline__ unsigned xb_add(unsigned* p, unsigned v) { return __hip_atomic_fetch_add(p, v, __ATOMIC_RELAXED, __HIP_MEMORY_SCOPE_AGENT); }
__device__ __forceinline__ unsigned xb_xcc_id() { return (unsigned)__builtin_amdgcn_s_getreg((3 << 11) | 20) & 0xFu; }
#define XB_SPIN(cond, bar) do { unsigned _sp = 0; while (cond) { __builtin_amdgcn_s_sleep(1); \
    if ((++_sp & 255u) == 0u) { if (xb_ld(&(bar)[XB_TMO])) break; if (_sp > XB_SPIN_CAP) { atomicAdd(&(bar)[XB_TMO], 1u); break; } } } } while (0)
struct XcdBarrier { unsigned* bar; unsigned x; volatile LAS unsigned* st; };
__device__ __forceinline__ XcdBarrier xcd_barrier_post(unsigned* bar, volatile LAS unsigned* st) {
    XcdBarrier b; b.bar = bar; b.x = xb_xcc_id(); b.st = st;
    if (threadIdx.x == 0) (void)xb_add(&bar[XB_XCNT(b.x)], 1u);
    return b;
}
__device__ __forceinline__ void xcd_barrier_complete(unsigned* bar, unsigned x, unsigned& nloc, unsigned& nx) {
    const unsigned G = gridDim.x * gridDim.y * gridDim.z;
    unsigned sum, cnt, mine, sp = 0u;
    for (;;) {
        sum = 0u; cnt = 0u; mine = 0u;
#pragma unroll
        for (unsigned j = 0; j < 16; ++j) { const unsigned c = xb_ld(&bar[XB_XCNT(j)]); sum += c; cnt += (c > 0u) ? 1u : 0u; mine = (j == x) ? c : mine; }
        if (sum == G) break;
        __builtin_amdgcn_s_sleep(1);
        if ((++sp & 255u) == 0u) { if (xb_ld(&bar[XB_TMO])) break; if (sp > XB_SPIN_CAP) { atomicAdd(&bar[XB_TMO], 1u); break; } }
    }
    nloc = mine > 0u ? mine : 1u; nx = cnt > 0u ? cnt : 1u;
}
__device__ __forceinline__ void xcd_barrier(const XcdBarrier& b) {
    asm volatile("s_waitcnt vmcnt(0)" ::: "memory");
    __syncthreads();
    if (threadIdx.x == 0) {
        unsigned* bar = b.bar;
        __builtin_amdgcn_s_waitcnt(0);
        unsigned nloc = b.st[0], nx = b.st[1];
        if (nloc == 0u) { xcd_barrier_complete(bar, b.x, nloc, nx); b.st[0] = nloc; b.st[1] = nx; }
        const unsigned old = xb_add(&bar[XB_XSUB(b.x)], 1u);
        const unsigned gen = old / nloc;
        if (old + 1u == (gen + 1u) * nloc) {
            __builtin_amdgcn_fence(__ATOMIC_RELEASE, "agent");
            asm volatile("s_waitcnt vmcnt(0)" ::: "memory");
            const unsigned og = xb_add(&bar[XB_TOP], 1u);
            const unsigned tg = og / nx;
            if (og + 1u == (tg + 1u) * nx) xb_add(&bar[XB_TOPGEN], 1u);
            else XB_SPIN(xb_ld(&bar[XB_TOPGEN]) == tg, bar);
            __builtin_amdgcn_fence(__ATOMIC_ACQUIRE, "agent");
            xb_add(&bar[XB_XGEN(b.x)], 1u);
            asm volatile("s_waitcnt vmcnt(0)" ::: "memory");
        } else {
            XB_SPIN(xb_ld(&bar[XB_XGEN(b.x)]) == gen, bar);
            __builtin_amdgcn_fence(__ATOMIC_ACQUIRE, "agent");
            asm volatile("s_waitcnt vmcnt(0)" ::: "memory");
        }
    }
    __syncthreads();
}

struct Frame {
    LAS unsigned char* lds;
    int tid, lane, wave, vcu, G;
    float* out;
    unsigned char* ws;
};
#define LAUNDER_S(p) asm volatile("" : "+s"(p))
enum { I_X = 0, I_MEM, I_PRE_GAIN, I_POST_GAIN, I_W_IN, I_W_OUT, I_W_MEM_KV, I_MEM_GAIN, I_CONV_W, I_CONV_B, I_GATE_A_W, I_GATE_A_B, I_GATE_X_W, I_GATE_X_B, I_LAM, I_KV_GAIN, I_W_KV, I_NIN };
constexpr int PTR_OFF = LDSCTL_OFF + 512;
__device__ __forceinline__ const float* inp(const Frame& F, int i) {
    const unsigned long long v = ((const LAS unsigned long long*)(F.lds + PTR_OFF))[i];
    const unsigned lo = __builtin_amdgcn_readfirstlane((unsigned)v), hi = __builtin_amdgcn_readfirstlane((unsigned)(v >> 32));
    return (const float*)(((unsigned long long)hi << 32) | lo);
}
__device__ __forceinline__ bf16* win_ptr(unsigned char* ws, int l) { return (bf16*)(ws + WS_WIN0) + (size_t)l * INC * DM; }

__device__ __forceinline__ void p0_transpose_item(const float* W, int K, int N, bf16* WT, const float* gain, LAS bf16* scr, int kb, int nb, int dst_row0, int lane) {
    const int k0 = 64 * kb, n0 = 64 * nb;
    const int lr = lane >> 4, lc = lane & 15;
    f32x4 v[16];
#pragma unroll
    for (int i = 0; i < 16; ++i) v[i] = __builtin_nontemporal_load((const GAS f32x4*)(W + (size_t)(k0 + 4 * i + lr) * N + n0 + 4 * lc));
    if (gain) {
#pragma unroll
        for (int i = 0; i < 16; ++i) v[i] = v[i] * gain[k0 + 4 * i + lr];
    }
#pragma unroll
    for (int i = 0; i < 16; ++i) { LAS bf16* d = scr + (4 * i + lr) * 66 + 4 * lc;
        *(LAS unsigned*)(d) = pk2(v[i].x, v[i].y); *(LAS unsigned*)(d + 2) = pk2(v[i].z, v[i].w); }
    LDS_WAIT(); asm volatile("" ::: "memory");
    const int kc = lane & 7, nr = lane >> 3;
#pragma unroll
    for (int j = 0; j < 8; ++j) { const LAS bf16* sp = scr + (8 * kc) * 66 + 8 * j + nr;
        v4u o; o.x = (unsigned)sp[0] | ((unsigned)sp[66] << 16); o.y = (unsigned)sp[2 * 66] | ((unsigned)sp[3 * 66] << 16);
        o.z = (unsigned)sp[4 * 66] | ((unsigned)sp[5 * 66] << 16); o.w = (unsigned)sp[6 * 66] | ((unsigned)sp[7 * 66] << 16);
        *(GAS v4u*)(WT + (size_t)(dst_row0 + 8 * j + nr) * K + k0 + 8 * kc) = o; }
    LDS_WAIT(); asm volatile("" ::: "memory");
}
template <bool NORMALISE>
__device__ __forceinline__ void rms_row_to_bf16(const float* xrow, bf16* orow, float* rstd_out, int lane) {
    const GAS f32x4* xr = (const GAS f32x4*)xrow + lane;
    f32x4 v[16]; float s = 0.f;
#pragma unroll
    for (int j = 0; j < 16; ++j) { v[j] = xr[64 * j]; s += (v[j].x * v[j].x + v[j].y * v[j].y) + (v[j].z * v[j].z + v[j].w * v[j].w); }
    const float nrm = sqrtf(wave_sum(s) * (1.0f / DM) + EPS), rstd = 1.0f / nrm;
    const float sc = rstd;
    if (!NORMALISE && lane == 0) *rstd_out = nrm;
    GAS unsigned long long* o8 = (GAS unsigned long long*)orow + lane;
#pragma unroll
    for (int j = 0; j < 16; ++j) o8[64 * j] = (unsigned long long)pk2(v[j].x * sc, v[j].y * sc) | ((unsigned long long)pk2(v[j].z * sc, v[j].w * sc) << 32);
}
constexpr int PI_MKV = 4 * 64 * 32, PI_IN = 4 * 64 * 128, PI_KV = 64 * 96, PI_OUT = 4 * 64 * 64, PI_G = 48 * 16;
constexpr int PW_MEM = PI_MKV + BATCH * MEM_T, PW_END = PW_MEM + PI_IN + PI_KV + PI_OUT + PI_G + M;
constexpr int PW_SPLIT = PW_MEM + 14336;
__device__ __forceinline__ void p0_do(Frame& F, int idx) {
    LAS bf16* scr = (LAS bf16*)(F.lds + RING_OFF + F.wave * 16384);
    int r = idx;
    if (r < PI_MKV) { const float* const w_mem_kv = inp(F, I_W_MEM_KV); const float* const mem_gain = inp(F, I_MEM_GAIN);
        const int l = r / 2048, rr = r % 2048, kb = rr / 32, nb = rr % 32; const int n0 = 64 * nb;
        bf16* dst = (bf16*)(F.ws + (n0 < MEMW ? WS_WMK : WS_WMV)); const int row0 = l * MEMW + (n0 < MEMW ? n0 : n0 - MEMW);
        p0_transpose_item(w_mem_kv + (size_t)l * DM * 2 * MEMW, DM, 2 * MEMW, dst, mem_gain, scr, kb, nb, row0, F.lane); return; } r -= PI_MKV;
    if (r < BATCH * MEM_T) { rms_row_to_bf16<true>(inp(F, I_MEM) + (size_t)r * DM, (bf16*)(F.ws + WS_MEMB) + (size_t)r * DM, nullptr, F.lane); return; } r -= BATCH * MEM_T;
    if (r < PI_IN) { const float* const w_in = inp(F, I_W_IN); const float* const pre_gain = inp(F, I_PRE_GAIN);
        const int l = r / 8192, rr = r % 8192, kb = rr / 128, nb = rr % 128;
        p0_transpose_item(w_in + (size_t)l * DM * INC, DM, INC, win_ptr(F.ws, l), pre_gain + l * DM, scr, kb, nb, 64 * nb, F.lane); return; } r -= PI_IN;
    if (r < PI_KV) { const int kb = r / 96, nb = r % 96;
        p0_transpose_item(inp(F, I_W_KV), DM, KVW, (bf16*)(F.ws + WS_WKV), inp(F, I_KV_GAIN), scr, kb, nb, 64 * nb, F.lane); return; } r -= PI_KV;
    if (r < PI_OUT) { const int l = r / 4096, rr = r % 4096, kb = rr / 64, nb = rr % 64;
        p0_transpose_item(inp(F, I_W_OUT) + (size_t)l * MIXW * DM, MIXW, DM, (bf16*)(F.ws + WS_WOUT) + (size_t)l * DM * MIXW, nullptr, scr, kb, nb, 64 * nb, F.lane); return; } r -= PI_OUT;
    if (r < PI_G) { const int mat = r / 16, rr = r % 16, kb = rr / 4, nb = rr % 4; const int ln = mat / 2, ga = mat % 2;
        p0_transpose_item(inp(F, ga ? I_GATE_X_W : I_GATE_A_W) + (size_t)ln * 65536, 256, 256, (bf16*)(F.ws + WS_WG) + (size_t)ln * 512 * 256, nullptr, scr, kb, nb, ga * 256 + 64 * nb, F.lane); return; } r -= PI_G;
    rms_row_to_bf16<false>(inp(F, I_X) + (size_t)r * DM, (bf16*)(F.ws + WS_HB) + (size_t)r * DM, (float*)(F.ws + WS_RSTD) + r, F.lane);
}

template <int LAYER>
__device__ __forceinline__ void nr_phase(Frame& F) {
    const int gw = F.vcu * NWAVES + F.wave, NGW = F.G * NWAVES, lane = F.lane;
    const bf16* ob = (const bf16*)(F.ws + WS_OB); const float* part = (const float*)(F.ws + WS_PART); bf16* hb = (bf16*)(F.ws + WS_HB); float* rstd_arr = (float*)(F.ws + WS_RSTD);
    const GAS f32x4* pg = (const GAS f32x4*)(inp(F, I_POST_GAIN) + LAYER * DM) + lane;
    for (int m0 = gw; m0 < M; m0 += 2 * NGW) {
        const int mA = m0, mB = (m0 + NGW < M) ? m0 + NGW : m0;
        const float ssA = part[(size_t)mA * 64 + lane], ssB = part[(size_t)mB * 64 + lane];
        const GAS v2u* oA = (const GAS v2u*)(ob + (size_t)mA * DM) + lane; const GAS v2u* oB = (const GAS v2u*)(ob + (size_t)mB * DM) + lane;
        GAS v2u* hA = (GAS v2u*)(hb + (size_t)mA * DM) + lane; GAS v2u* hB = (GAS v2u*)(hb + (size_t)mB * DM) + lane;
        v2u oa[16], ha[16], obv[16], hbv[16];
#pragma unroll
        for (int j = 0; j < 16; ++j) { oa[j] = __builtin_nontemporal_load(oA + 64 * j); ha[j] = hA[64 * j]; obv[j] = __builtin_nontemporal_load(oB + 64 * j); hbv[j] = hB[64 * j]; }
        const float rsA = 1.0f / sqrtf(wave_sum(ssA) * (1.0f / DM) + EPS), rsB = 1.0f / sqrtf(wave_sum(ssB) * (1.0f / DM) + EPS);
        const float nA = rstd_arr[mA], nB = rstd_arr[mB];
#pragma unroll
        for (int rI = 0; rI < 2; ++rI) {
            const float rs = rI ? rsB : rsA; const float hn = rI ? nB : nA; const int m = rI ? mB : mA; GAS v2u* hrow = rI ? hB : hA;
            if (rI == 1 && mB == mA) break;
            f32x4 v[16]; float s = 0.f;
#pragma unroll
            for (int j = 0; j < 16; ++j) { const v2u o = rI ? obv[j] : oa[j]; const v2u hh = rI ? hbv[j] : ha[j]; const f32x4 g = pg[64 * j];
                f32x4 r; r.x = bflo(hh.x) * hn + bflo(o.x) * rs * g.x; r.y = bfhi(hh.x) * hn + bfhi(o.x) * rs * g.y; r.z = bflo(hh.y) * hn + bflo(o.y) * rs * g.z; r.w = bfhi(hh.y) * hn + bfhi(o.y) * rs * g.w;
                v[j] = r; s += (r.x * r.x + r.y * r.y) + (r.z * r.z + r.w * r.w); }
            if (LAYER < DEPTH - 1) {
                const float nrm = sqrtf(wave_sum(s) * (1.0f / DM) + EPS), rstd = 1.0f / nrm;
                if (lane == 0) rstd_arr[m] = nrm;
#pragma unroll
                for (int j = 0; j < 16; ++j) { v2u w; w.x = pk2(v[j].x * rstd, v[j].y * rstd); w.y = pk2(v[j].z * rstd, v[j].w * rstd); hrow[64 * j] = w; }
            } else {
                GAS f32x4* outr = (GAS f32x4*)(F.out + (size_t)m * DM) + lane;
#pragma unroll
                for (int j = 0; j < 16; ++j) outr[64 * j] = v[j];
            }
        }
    }
}

__device__ __forceinline__ bf16x8 pack8(float a0, float a1, float a2, float a3, float a4, float a5, float a6, float a7) {
    v4u p; p.x = pk2(a0, a1); p.y = pk2(a2, a3); p.z = pk2(a4, a5); p.w = pk2(a6, a7); return __builtin_bit_cast(bf16x8, p);
}
__host__ __device__ __forceinline__ int kperm(int rho) { return (rho & ~31) + 8 * ((rho & 15) >> 2) + 4 * ((rho >> 4) & 1) + (rho & 3); }
__device__ __forceinline__ void glds16(const bf16* g, LAS unsigned char* l) { __builtin_amdgcn_global_load_lds((const unsigned*)g, (LAS unsigned*)l, 16, 0, 0); }
#define WG_BAR() do { asm volatile("s_waitcnt vmcnt(0) lgkmcnt(0)" ::: "memory"); __builtin_amdgcn_s_barrier(); asm volatile("" ::: "memory"); } while (0)

#if PL_SB
#define SBX16 xor16
#define SBX32 xor32
#else
#define SBX16 xor16s
#define SBX32 xor32s
#endif
template <int NP, bool MASK>
__device__ __forceinline__ void sb_tile_weights(const f32x4 (&zt)[2 * NP], float (&w)[NP][8], float& R, int kb, int tq, int g) {
    float bt[NP][8], sp[NP][8], Sp[NP];
#pragma unroll
    for (int p = 0; p < NP; ++p) {
        float om[8];
#pragma unroll
        for (int jj = 0; jj < 8; ++jj) {
            const float t = fmaxf(zt[2 * p + (jj >> 2)][jj & 3], -126.0f);
            const float e = __builtin_amdgcn_exp2f(-t);
            float b = __builtin_amdgcn_rcpf(1.0f + e), o = e * b;
            if (MASK) { const bool valid = (kb + 32 * p + 8 * g + jj) < tq; b = valid ? b : 0.f; o = valid ? o : 1.f; }
            bt[p][jj] = b; om[jj] = o; }
        sp[p][7] = 1.f;
#pragma unroll
        for (int jj = 6; jj >= 0; --jj) sp[p][jj] = sp[p][jj + 1] * om[jj + 1];
        Sp[p] = sp[p][0] * om[0];
    }
    float Gp[NP], Tp[NP];
#pragma unroll
    for (int p = 0; p < NP; ++p) {
        const float p16 = SBX16(Sp[p], g);
        const float Ppair = Sp[p] * p16;
        const float p32 = SBX32(Ppair, g);
        Gp[p] = ((g & 1) ? 1.f : p16) * ((g & 2) ? 1.f : p32);
        Tp[p] = Ppair * p32;
    }
    float Facc = R;
#pragma unroll
    for (int p = NP - 1; p >= 0; --p) {
        const float base = Facc * Gp[p];
#pragma unroll
        for (int jj = 0; jj < 8; ++jj) w[p][jj] = bt[p][jj] * (base * sp[p][jj]);
        Facc *= Tp[p];
    }
    R = Facc;
}
template <bool MASK>
__device__ __forceinline__ void sb_tile_weights2(const f32x4 (&zt)[4], float (&w)[2][8], float& R, int kb, int tq, int g) {
    f32x2 bt[8], sp[8], om[8];
    const int lim = tq - kb - 8 * g;
#pragma unroll
    for (int jj = 0; jj < 8; ++jj) {
        f32x2 e;
        e.x = __builtin_fminf(__builtin_amdgcn_exp2f(-zt[jj >> 2][jj & 3]), 0x1p126f); e.y = __builtin_fminf(__builtin_amdgcn_exp2f(-zt[2 + (jj >> 2)][jj & 3]), 0x1p126f);
        const f32x2 d = e + (f32x2){1.0f, 1.0f};
        f32x2 b; b.x = __builtin_amdgcn_rcpf(d.x); b.y = __builtin_amdgcn_rcpf(d.y);
        f32x2 o = e * b;
        if (MASK) { const bool v0 = jj < lim, v1 = (32 + jj) < lim; b.x = v0 ? b.x : 0.f; o.x = v0 ? o.x : 1.f; b.y = v1 ? b.y : 0.f; o.y = v1 ? o.y : 1.f; }
        bt[jj] = b; om[jj] = o; }
    sp[7] = (f32x2){1.f, 1.f};
#pragma unroll
    for (int jj = 6; jj >= 0; --jj) sp[jj] = sp[jj + 1] * om[jj + 1];
    const f32x2 Sp = sp[0] * om[0];
    f32x2 p16; p16.x = SBX16(Sp.x, g); p16.y = SBX16(Sp.y, g);
    const f32x2 Ppair = Sp * p16;
    f32x2 p32; p32.x = SBX32(Ppair.x, g); p32.y = SBX32(Ppair.y, g);
    f32x2 Gp; Gp.x = ((g & 1) ? 1.f : p16.x) * ((g & 2) ? 1.f : p32.x); Gp.y = ((g & 1) ? 1.f : p16.y) * ((g & 2) ? 1.f : p32.y);
    const f32x2 Tp = Ppair * p32;
    f32x2 base; base.y = R * Gp.y; const float F1 = R * Tp.y; base.x = F1 * Gp.x; R = F1 * Tp.x;
#pragma unroll
    for (int jj = 0; jj < 8; ++jj) { const f32x2 ww = bt[jj] * (base * sp[jj]); w[0][jj] = ww.x; w[1][jj] = ww.y; }
}
template <int NP, int ROW0>
__device__ __forceinline__ void sb_compute(LAS unsigned char* stg, const bf16x8 (&qf)[4], f32x4 (&ot)[8], float& R, int kt, int tq, int tw, int c, int g) {
    f32x4 zt[2 * NP];
#pragma unroll
    for (int f = 0; f < 2 * NP; ++f) zt[f] = (f32x4){0.f, 0.f, 0.f, 0.f};
#pragma unroll
    for (int kk = 0; kk < 4; ++kk)
#pragma unroll
        for (int f = 0; f < 2 * NP; ++f) { const bf16x8 kf = *(const LAS bf16x8*)(stg + (kk >> 1) * 16384 + pg8::lds_byte(ROW0 + 16 * f + c, 32 * (kk & 1) + 8 * g));
            zt[f] = MFMA16(kf, qf[kk], zt[f]); }
    float w[NP][8];
    if constexpr (NP == 2) { if (kt + ROW0 + 63 >= tw) sb_tile_weights2<true>(zt, w, R, kt + ROW0, tq, g); else sb_tile_weights2<false>(zt, w, R, kt + ROW0, tq, g); }
    else { if (kt + ROW0 + 32 * NP - 1 >= tw) sb_tile_weights<NP, true>(zt, w, R, kt + ROW0, tq, g); else sb_tile_weights<NP, false>(zt, w, R, kt + ROW0, tq, g); }
#pragma unroll
    for (int p = 0; p < NP; ++p) {
        const bf16x8 wf = pack8(w[p][0], w[p][1], w[p][2], w[p][3], w[p][4], w[p][5], w[p][6], w[p][7]);
        constexpr int dummy = 0; (void)dummy;
        const int ko = ROW0 + 32 * p;
#pragma unroll
        for (int md = 0; md < 8; ++md) { const bf16x8 vf = *(const LAS bf16x8*)(stg + 32768 + (ko >> 6) * 16384 + pg8::lds_byte(16 * md + c, (ko & 63) + 8 * g)); ot[md] = MFMA16(vf, wf, ot[md]); }
    }
}

template <int ROW0>
__device__ __forceinline__ void sb_compute_joint(LAS unsigned char* stg, const bf16x8 (&qfA)[4], const bf16x8 (&qfB)[4], f32x4 (&otA)[8], f32x4 (&otB)[8], float& RA, float& RB,
                                                 int kt, int tqA, int twA, int tqB, int twB, int c, int g) {
    f32x4 ztA[4], ztB[4];
#pragma unroll
    for (int f = 0; f < 4; ++f) { ztA[f] = (f32x4){0.f, 0.f, 0.f, 0.f}; ztB[f] = (f32x4){0.f, 0.f, 0.f, 0.f}; }
#pragma unroll
    for (int kk = 0; kk < 4; ++kk)
#pragma unroll
        for (int f = 0; f < 4; ++f) { const bf16x8 kf = *(const LAS bf16x8*)(stg + (kk >> 1) * 16384 + pg8::lds_byte(ROW0 + 16 * f + c, 32 * (kk & 1) + 8 * g));
            ztA[f] = MFMA16(kf, qfA[kk], ztA[f]); ztB[f] = MFMA16(kf, qfB[kk], ztB[f]); }
    bf16x8 wfA[2], wfB[2];
    { float w[2][8];
      if (kt + ROW0 + 63 >= twA) sb_tile_weights2<true>(ztA, w, RA, kt + ROW0, tqA, g); else sb_tile_weights2<false>(ztA, w, RA, kt + ROW0, tqA, g);
#pragma unroll
      for (int p = 0; p < 2; ++p) wfA[p] = pack8(w[p][0], w[p][1], w[p][2], w[p][3], w[p][4], w[p][5], w[p][6], w[p][7]); }
    { float w[2][8];
      if (kt + ROW0 + 63 >= twB) sb_tile_weights2<true>(ztB, w, RB, kt + ROW0, tqB, g); else sb_tile_weights2<false>(ztB, w, RB, kt + ROW0, tqB, g);
#pragma unroll
      for (int p = 0; p < 2; ++p) wfB[p] = pack8(w[p][0], w[p][1], w[p][2], w[p][3], w[p][4], w[p][5], w[p][6], w[p][7]); }
#pragma unroll
    for (int p = 0; p < 2; ++p) {
        const int ko = ROW0 + 32 * p;
#pragma unroll
        for (int md = 0; md < 8; ++md) { const bf16x8 vf = *(const LAS bf16x8*)(stg + 32768 + (ko >> 6) * 16384 + pg8::lds_byte(16 * md + c, (ko & 63) + 8 * g));
            otA[md] = MFMA16(vf, wfA[p], otA[md]); otB[md] = MFMA16(vf, wfB[p], otB[md]); }
    }
}

template <bool DUMMY>
__device__ __forceinline__ void sb_attn_wg(Frame& F, int b, int hd, int qb2, int popt = 0) {
    const int tid = F.tid, lane = F.lane, wave = F.wave, c = lane & 15, g = lane >> 4;
    LAS unsigned char* const lds = F.lds + RING_OFF;
    const bf16* const proj = (const bf16*)(F.ws + WS_PROJ); const bf16* const KBp = (const bf16*)(F.ws + WS_KB); const bf16* const VTp = (const bf16*)(F.ws + WS_VT); bf16* const mix = (bf16*)(F.ws + WS_MIX);
    const int t0 = qb2 * 256;
    const int twA = t0 + 128 + 16 * wave, tqA = twA + c, twB = t0 + 16 * wave, tqB = twB + c;
    const size_t mrow = (size_t)b * SEQ;
    int R0, C0, R1, C1; pg8::stage_rc(tid * 16, R0, C0); pg8::stage_rc(tid * 16 + 8192, R1, C1);
    const bf16* const ksrc0 = KBp + ((size_t)hd * M + mrow + kperm(R0)) * 128 + C0;
    const bf16* const ksrc1 = KBp + ((size_t)hd * M + mrow + kperm(R1)) * 128 + C1;
    const bf16* const vsrc0 = VTp + (((size_t)hd * (M / 64) + mrow / 64) * 128 + R0) * 64 + C0;
    const bf16* const vsrc1 = VTp + (((size_t)hd * (M / 64) + mrow / 64) * 128 + R1) * 64 + C1;
    const unsigned ldsw = (unsigned)wave * 1024u;
#define SB_STAGE(s, kt) do { LAS unsigned char* d_ = lds + (s) * 65536 + ldsw; \
        glds16(ksrc0 + (size_t)(kt) * 128, d_); glds16(ksrc1 + (size_t)(kt) * 128, d_ + 8192); glds16(ksrc0 + (size_t)(kt) * 128 + 64, d_ + 16384); glds16(ksrc1 + (size_t)(kt) * 128 + 64, d_ + 24576); \
        glds16(vsrc0 + (size_t)(kt) * 128, d_ + 32768); glds16(vsrc1 + (size_t)(kt) * 128, d_ + 40960); glds16(vsrc0 + (size_t)(kt) * 128 + 8192, d_ + 49152); glds16(vsrc1 + (size_t)(kt) * 128 + 8192, d_ + 57344); } while (0)
    volatile LAS unsigned* const flg = (volatile LAS unsigned*)(F.lds + LDSCTL_OFF + 1024);
    bf16x8 qfA[4], qfB[4];
    { const bf16* qp = proj + (mrow + tqA) * INC + hd * 128 + 8 * g;
#pragma unroll
      for (int kk = 0; kk < 4; ++kk) qfA[kk] = *(const GAS bf16x8*)(qp + 32 * kk); }
    { const bf16* qp = proj + (mrow + tqB) * INC + hd * 128 + 8 * g;
#pragma unroll
      for (int kk = 0; kk < 4; ++kk) qfB[kk] = *(const GAS bf16x8*)(qp + 32 * kk); }
    f32x4 otA[8], otB[8];
#pragma unroll
    for (int md = 0; md < 8; ++md) { otA[md] = (f32x4){0.f, 0.f, 0.f, 0.f}; otB[md] = (f32x4){0.f, 0.f, 0.f, 0.f}; }
    float RA = 1.f, RB = 1.f;
    bool doneA = false, doneB = false;
    int kt = t0 + 128, j = 0;
    SB_STAGE(0, kt);
#define SB_TILE_STEP(S) { \
        WG_BAR();                                    \
        if (j > 0) { unsigned nd = 0; \
            _Pragma("unroll") for (int w = 0; w < 8; ++w) nd += flg[(j & 1) * 8 + w]; \
            if (nd == 8u) break; } \
        if (kt < 0) break; \
        const int ktn = kt - 128; \
        if (ktn >= 0 && popt != 5) SB_STAGE((S) ^ 1, ktn); \
        if (popt >= 4) { if (j >= 3) { doneA = true; doneB = true; } } \
        if (popt != 4) { \
        { const bool bIn = !doneB && kt < twB + 15;                       \
          const bool a64 = !doneA && (kt + 64 < twA + 15), b64 = bIn && (kt + 64 < twB + 15); \
          if (a64 && b64) sb_compute_joint<64>(lds + (S) * 65536, qfA, qfB, otA, otB, RA, RB, kt, tqA, twA, tqB, twB, c, g); \
          else if (a64) sb_compute<2, 64>(lds + (S) * 65536, qfA, otA, RA, kt, tqA, twA, c, g); \
          else if (b64) sb_compute<2, 64>(lds + (S) * 65536, qfB, otB, RB, kt, tqB, twB, c, g); \
          if (a64 && __all(RA == 0.0f)) doneA = true; \
          if (b64 && __all(RB == 0.0f)) doneB = true; \
          const bool a0 = !doneA, b0 = bIn && !doneB; \
          if (a0 && b0) sb_compute_joint<0>(lds + (S) * 65536, qfA, qfB, otA, otB, RA, RB, kt, tqA, twA, tqB, twB, c, g); \
          else if (a0) sb_compute<2, 0>(lds + (S) * 65536, qfA, otA, RA, kt, tqA, twA, c, g); \
          else if (b0) sb_compute<2, 0>(lds + (S) * 65536, qfB, otB, RB, kt, tqB, twB, c, g); \
          if (a0 && __all(RA == 0.0f)) doneA = true; \
          if (b0 && __all(RB == 0.0f)) doneB = true; } \
        } \
        if (popt >= 4 && j < 3) { doneA = false; doneB = false; } \
        if (lane == 0) flg[((j + 1) & 1) * 8 + wave] = (doneA && doneB) ? 1u : 0u; \
        kt = ktn; ++j; }
    if (DUMMY) { WG_BAR(); } else
    for (;;) { SB_TILE_STEP(0) SB_TILE_STEP(1) }
#undef SB_TILE_STEP
#undef SB_STAGE
    if (popt < 4)
#pragma unroll
    for (int q = 0; q < 2; ++q) { const size_t row = mrow + (q == 0 ? tqA : tqB);
#pragma unroll
        for (int md = 0; md < 8; ++md) { const int d0 = hd * 128 + 16 * md + 4 * g;
            const v2u gt = *(const GAS v2u*)(proj + row * INC + MAINW + d0);
            const f32x4 o4 = q == 0 ? otA[md] : otB[md];
            v2u o; o.x = pk2(o4[0] * silu_f(bflo(gt.x)), o4[1] * silu_f(bfhi(gt.x))); o.y = pk2(o4[2] * silu_f(bflo(gt.y)), o4[3] * silu_f(bfhi(gt.y)));
            *(GAS v2u*)(mix + row * MIXW + d0) = o; } }
    asm volatile("s_waitcnt lgkmcnt(0)" ::: "memory"); __builtin_amdgcn_s_barrier(); asm volatile("" ::: "memory");
}

__device__ __forceinline__ void mem_attn_wg(Frame& F, int layer, int b, int mh, int qb) {
    const int tid = F.tid, lane = F.lane, wave = F.wave, c = lane & 15, g = lane >> 4;
    LAS unsigned char* const lds = F.lds + RING_OFF;
    const bf16* const proj = (const bf16*)(F.ws + WS_PROJ); const bf16* const memk = (const bf16*)(F.ws + WS_MEMK); const bf16* const memvt = (const bf16*)(F.ws + WS_MEMVT); bf16* const mix = (bf16*)(F.ws + WS_MIX);
    const size_t row0 = (size_t)b * SEQ + qb * 256 + 32 * wave + c;
    const int fbase = layer * MEMW + mh * 256;
    const unsigned ldsw = (unsigned)wave * 1024u;
    int Rr[2], Cc[2]; pg8::stage_rc(tid * 16, Rr[0], Cc[0]); pg8::stage_rc(tid * 16 + 8192, Rr[1], Cc[1]);
#pragma unroll
    for (int kh = 0; kh < 2; ++kh)
#pragma unroll
        for (int dq = 0; dq < 4; ++dq)
#pragma unroll
            for (int i = 0; i < 2; ++i) glds16(memk + (size_t)(b * MEM_T + 128 * kh + kperm(Rr[i])) * (DEPTH * MEMW) + fbase + 64 * dq + Cc[i], lds + kh * 65536 + dq * 16384 + i * 8192 + ldsw);
    bf16x8 qf[2][8];
#pragma unroll
    for (int q = 0; q < 2; ++q) { const bf16* qp = proj + (row0 + 16 * q) * INC + 2 * MAINW + mh * 256 + 8 * g;
#pragma unroll
      for (int kk = 0; kk < 8; ++kk) qf[q][kk] = *(const GAS bf16x8*)(qp + 32 * kk); }
    WG_BAR();
    f32x4 st[2][16];
#pragma unroll
    for (int fg = 0; fg < 16; ++fg) { st[0][fg] = (f32x4){0.f, 0.f, 0.f, 0.f}; st[1][fg] = (f32x4){0.f, 0.f, 0.f, 0.f}; }
#pragma unroll
    for (int kh = 0; kh < 2; ++kh)
#pragma unroll
        for (int kk = 0; kk < 8; ++kk)
#pragma unroll
            for (int f = 0; f < 8; ++f) { const bf16x8 kf = *(const LAS bf16x8*)(lds + kh * 65536 + (kk >> 1) * 16384 + pg8::lds_byte(16 * f + c, 32 * (kk & 1) + 8 * g));
                st[0][8 * kh + f] = MFMA16(kf, qf[0][kk], st[0][8 * kh + f]); st[1][8 * kh + f] = MFMA16(kf, qf[1][kk], st[1][8 * kh + f]); }
    float inv[2];
    bf16x8 pf[2][8];
#pragma unroll
    for (int q = 0; q < 2; ++q) {
        float mx = -3.0e38f;
#pragma unroll
        for (int f = 0; f < 16; ++f)
#pragma unroll
            for (int r = 0; r < 4; ++r) mx = fmaxf(mx, st[q][f][r]);
        mx = fmaxf(mx, __shfl_xor(mx, 16)); mx = fmaxf(mx, __shfl_xor(mx, 32));
        float den = 0.f;
#pragma unroll
        for (int f = 0; f < 16; ++f)
#pragma unroll
            for (int r = 0; r < 4; ++r) { const float p = __builtin_amdgcn_exp2f(st[q][f][r] - mx); st[q][f][r] = p; den += p; }
        den += __shfl_xor(den, 16); den += __shfl_xor(den, 32);
        inv[q] = 1.0f / den;
#pragma unroll
        for (int pg = 0; pg < 8; ++pg) { const int fa = 8 * (pg >> 2) + 2 * (pg & 3); pf[q][pg] = pack8(st[q][fa][0], st[q][fa][1], st[q][fa][2], st[q][fa][3], st[q][fa + 1][0], st[q][fa + 1][1], st[q][fa + 1][2], st[q][fa + 1][3]); }
    }
    WG_BAR();
#pragma unroll
    for (int kh = 0; kh < 2; ++kh)
#pragma unroll
        for (int dh = 0; dh < 2; ++dh)
#pragma unroll
            for (int kq = 0; kq < 2; ++kq)
#pragma unroll
                for (int i = 0; i < 2; ++i) glds16(memvt + (size_t)(fbase + 128 * dh + Rr[i]) * (BATCH * MEM_T) + b * MEM_T + 128 * kh + 64 * kq + Cc[i], lds + kh * 65536 + (dh * 2 + kq) * 16384 + i * 8192 + ldsw);
    v2u gtm[2][2][8];
#pragma unroll
    for (int half = 0; half < 2; ++half)
#pragma unroll
        for (int q = 0; q < 2; ++q)
#pragma unroll
            for (int md = 0; md < 8; ++md) gtm[half][q][md] = *(const GAS v2u*)(proj + (row0 + 16 * q) * INC + 2 * MAINW + MEMW + mh * 256 + 128 * half + 16 * md + 4 * g);
    WG_BAR();
#pragma unroll
    for (int half = 0; half < 2; ++half) {
        f32x4 ot[2][8];
#pragma unroll
        for (int md = 0; md < 8; ++md) { ot[0][md] = (f32x4){0.f, 0.f, 0.f, 0.f}; ot[1][md] = (f32x4){0.f, 0.f, 0.f, 0.f}; }
#pragma unroll
        for (int pg = 0; pg < 8; ++pg) { const int kh = pg >> 2, p = pg & 3;
#pragma unroll
            for (int md = 0; md < 8; ++md) { const bf16x8 vf = *(const LAS bf16x8*)(lds + kh * 65536 + (half * 2 + (p >> 1)) * 16384 + pg8::lds_byte(16 * md + c, 32 * (p & 1) + 8 * g));
                ot[0][md] = MFMA16(vf, pf[0][pg], ot[0][md]); ot[1][md] = MFMA16(vf, pf[1][pg], ot[1][md]); } }
#pragma unroll
        for (int q = 0; q < 2; ++q)
#pragma unroll
            for (int md = 0; md < 8; ++md) { const int d0 = mh * 256 + 128 * half + 16 * md + 4 * g; const size_t row = row0 + 16 * q;
                const v2u gt = gtm[half][q][md];
                v2u o; o.x = pk2(ot[q][md][0] * inv[q] * silu_f(bflo(gt.x)), ot[q][md][1] * inv[q] * silu_f(bfhi(gt.x))); o.y = pk2(ot[q][md][2] * inv[q] * silu_f(bflo(gt.y)), ot[q][md][3] * inv[q] * silu_f(bfhi(gt.y)));
                *(GAS v2u*)(mix + row * MIXW + MAINW + d0) = o; }
    }
    WG_BAR();
}

__device__ __forceinline__ void lru_carry_phase(Frame& F) {
    const int gw = F.vcu * NWAVES + F.wave, NGW = F.G * NWAVES;
    const float* agg = (const float*)(F.ws + WS_AGG); float* carry = (float*)(F.ws + WS_CARRY);
    for (int u = gw; u < BATCH * (MAINW / 64); u += NGW) {
        const int b = u / (MAINW / 64), chn = (u % (MAINW / 64)) * 64 + F.lane;
        float hc = 0.f;
#pragma unroll 1
        for (int c0 = 0; c0 < LRU_NC; c0 += 16) {
            f32x2 ag[16];
#pragma unroll
            for (int i = 0; i < 16; ++i) ag[i] = *(const GAS f32x2*)(agg + ((size_t)(b * LRU_NC + c0 + i) * MAINW + chn) * 2);
#pragma unroll
            for (int i = 0; i < 16; ++i) { *(GAS float*)(carry + (size_t)(b * LRU_NC + c0 + i) * MAINW + chn) = hc; hc = ag[i].x * hc + ag[i].y; }
        }
    }
}

template <bool FINAL>
__device__ __forceinline__ void lru_unit(Frame& F, int layer, int b, int n, int ch) {
    const int tid = F.tid, lane = F.lane, wave = F.wave, c = lane & 15, g = lane >> 4;
    const bf16* proj = (const bf16*)(F.ws + WS_PROJ);
    const float* const conv_w = inp(F, I_CONV_W); const float* const conv_b = inp(F, I_CONV_B);
    LAS bf16* ut = (LAS bf16*)(F.lds + RING_OFF);
    const int t0 = ch * LRU_T; const size_t mrow = (size_t)b * SEQ;
    {
        const int cg = tid & 31, rg = tid >> 5;
        const int col = 256 * n + 8 * cg;
        float cw[4][8], cb[8];
#pragma unroll
        for (int k = 0; k < 4; ++k) { const f32x4 a = *(const GAS f32x4*)(conv_w + ((size_t)layer * 4 + k) * MAINW + col), bb = *(const GAS f32x4*)(conv_w + ((size_t)layer * 4 + k) * MAINW + col + 4);
            cw[k][0] = a.x; cw[k][1] = a.y; cw[k][2] = a.z; cw[k][3] = a.w; cw[k][4] = bb.x; cw[k][5] = bb.y; cw[k][6] = bb.z; cw[k][7] = bb.w; }
        { const f32x4 a = *(const GAS f32x4*)(conv_b + (size_t)layer * MAINW + col), bb = *(const GAS f32x4*)(conv_b + (size_t)layer * MAINW + col + 4);
            cb[0] = a.x; cb[1] = a.y; cb[2] = a.z; cb[3] = a.w; cb[4] = bb.x; cb[5] = bb.y; cb[6] = bb.z; cb[7] = bb.w; }
        float xr[11][8];
#pragma unroll
        for (int i = 0; i < 11; ++i) { const int t = t0 + rg * 8 - 3 + i;
            v4u raw = (v4u){0u, 0u, 0u, 0u};
            if (t >= 0) raw = *(const GAS v4u*)(proj + (mrow + t) * INC + col);
            xr[i][0] = bflo(raw.x); xr[i][1] = bfhi(raw.x); xr[i][2] = bflo(raw.y); xr[i][3] = bfhi(raw.y); xr[i][4] = bflo(raw.z); xr[i][5] = bfhi(raw.z); xr[i][6] = bflo(raw.w); xr[i][7] = bfhi(raw.w); }
#pragma unroll
        for (int tt = 0; tt < 8; ++tt) { float u[8];
#pragma unroll
            for (int e = 0; e < 8; ++e) u[e] = cb[e] + cw[0][e] * xr[tt][e] + cw[1][e] * xr[tt + 1][e] + cw[2][e] * xr[tt + 2][e] + cw[3][e] * xr[tt + 3][e];
            v4u o; o.x = pk2(u[0], u[1]); o.y = pk2(u[2], u[3]); o.z = pk2(u[4], u[5]); o.w = pk2(u[6], u[7]);
            *(LAS v4u*)(ut + (rg * 8 + tt) * UT_PITCH + 8 * cg) = o; }
    }
    __syncthreads();
    float* agg = (float*)(F.ws + WS_AGG);
    const bf16* wg = (const bf16*)(F.ws + WS_WG) + (size_t)(layer * LRU_NB + n) * 512 * 256;
#pragma unroll 1
    for (int nf = 0; nf < 2; ++nf) {
        const int chl = 32 * wave + 16 * nf + c;
        const int chn = 256 * n + chl;
        const bf16* const gbase = proj + (mrow + t0) * INC + MAINW + 256 * n;
        bf16* const obase = (bf16*)(F.ws + WS_MIX) + (mrow + t0) * MIXW + 256 * n;
        const int goff = (4 * g) * INC + chl, ooff = (4 * g) * MIXW + chl;
        unsigned short gtv[8][4];
        if (FINAL) {
#pragma unroll
            for (int mf = 0; mf < 8; ++mf)
#pragma unroll
                for (int r = 0; r < 4; ++r) gtv[mf][r] = *(const GAS bf16*)(gbase + (16 * mf + r) * INC + goff);
        }
        f32x4 acc[8][2];
#pragma unroll
        for (int mf = 0; mf < 8; ++mf) { acc[mf][0] = (f32x4){0.f, 0.f, 0.f, 0.f}; acc[mf][1] = (f32x4){0.f, 0.f, 0.f, 0.f}; }
        bf16x8 bfr[8][2];
#pragma unroll
        for (int kk = 0; kk < 8; ++kk)
#pragma unroll
            for (int ga = 0; ga < 2; ++ga) bfr[kk][ga] = *(const GAS bf16x8*)(wg + (size_t)(ga * 256 + chl) * 256 + 32 * kk + 8 * g);
#pragma unroll
        for (int kk = 0; kk < 8; ++kk) {
            bf16x8 afr[8];
#pragma unroll
            for (int mf = 0; mf < 8; ++mf) afr[mf] = *(const LAS bf16x8*)(ut + (16 * mf + c) * UT_PITCH + 32 * kk + 8 * g);
#pragma unroll
            for (int mf = 0; mf < 8; ++mf) { acc[mf][0] = MFMA16(afr[mf], bfr[kk][0], acc[mf][0]); acc[mf][1] = MFMA16(afr[mf], bfr[kk][1], acc[mf][1]); }
            asm volatile("" ::: "memory");
        }
        {
            const float ba = inp(F, I_GATE_A_B)[(size_t)layer * MAINW + chn], bx = inp(F, I_GATE_X_B)[(size_t)layer * MAINW + chn];
            const float c8 = -8.0f * softplus_f(-inp(F, I_LAM)[(size_t)layer * MAINW + chn]);
#pragma unroll
            for (int mf = 0; mf < 8; ++mf)
#pragma unroll
                for (int r = 0; r < 4; ++r) {
                    const float rr = fast_sigmoid(acc[mf][0][r] + ba), ii = fast_sigmoid(acc[mf][1][r] + bx);
                    const float a = fast_exp(c8 * rr);
                    const float uval = bf2f(ut[(16 * mf + 4 * g + r) * UT_PITCH + chl]);
                    const float om = fmaxf(1.0f - a * a, 0.f);
                    acc[mf][0][r] = a; acc[mf][1][r] = __builtin_amdgcn_sqrtf(om) * (ii * uval);
                }
        }
        float hc = 0.f;
        float PT = 1.f;
        if (FINAL) {
            hc = *(const GAS float*)((const float*)(F.ws + WS_CARRY) + (size_t)(b * LRU_NC + ch) * MAINW + chn);
        }
#pragma unroll
        for (int mf = 0; mf < 8; ++mf) {
            float A = 1.f, B = 0.f;
#pragma unroll
            for (int r = 0; r < 4; ++r) { const float a = acc[mf][0][r]; A *= a; B = a * B + acc[mf][1][r]; }
            float Ai = A, Bi = B;
            { const float Ap = __shfl_up(Ai, 16), Bp = __shfl_up(Bi, 16); if (g >= 1) { Bi = Ai * Bp + Bi; Ai = Ap * Ai; } }
            { const float Ap = __shfl_up(Ai, 32), Bp = __shfl_up(Bi, 32); if (g >= 2) { Bi = Ai * Bp + Bi; Ai = Ap * Ai; } }
            const float Af = __shfl(Ai, 48 + c), Bf = __shfl(Bi, 48 + c);
            if (FINAL) {
                float Ae = __shfl_up(Ai, 16), Be = __shfl_up(Bi, 16); if (g == 0) { Ae = 1.f; Be = 0.f; }
                float h = Ae * hc + Be;
#pragma unroll
                for (int r = 0; r < 4; ++r) { h = acc[mf][0][r] * h + acc[mf][1][r];
                    const float gt = bf2f(gtv[mf][r]);
                    *(GAS bf16*)(obase + (16 * mf + r) * MIXW + ooff) = (bf16)f2bf(h * silu_f(gt)); }
                hc = Af * hc + Bf;
            } else { hc = Af * hc + Bf; PT *= Af; }
        }
        if (!FINAL && g == 0) { f32x2 o; o.x = PT; o.y = hc; *(GAS f32x2*)(agg + ((size_t)(b * LRU_NC + ch) * MAINW + chn) * 2) = o; }
    }
    __syncthreads();
}

#if PL_LRU
#define LRX16 xor16
#define LRX32 xor32
#else
#define LRX16 xor16s
#define LRX32 xor32s
#endif
__device__ __forceinline__ void lru_unit_chain(Frame& F, int layer, int b, int n, int ch, int popt = 0) {
    constexpr bool FINAL = true;
    const int tid = F.tid, lane = F.lane, wave = F.wave, c = lane & 15, g = lane >> 4;
    const bf16* proj = (const bf16*)(F.ws + WS_PROJ);
    const float* const conv_w = inp(F, I_CONV_W); const float* const conv_b = inp(F, I_CONV_B);
    LAS bf16* ut = (LAS bf16*)(F.lds + RING_OFF);
    const int t0 = ch * LRU_T; const size_t mrow = (size_t)b * SEQ;
    {
        const int cg = tid & 31, rg = tid >> 5;
        const int col = 256 * n + 8 * cg;
        float cw[4][8], cb[8];
#pragma unroll
        for (int k = 0; k < 4; ++k) { const f32x4 a = *(const GAS f32x4*)(conv_w + ((size_t)layer * 4 + k) * MAINW + col), bb = *(const GAS f32x4*)(conv_w + ((size_t)layer * 4 + k) * MAINW + col + 4);
            cw[k][0] = a.x; cw[k][1] = a.y; cw[k][2] = a.z; cw[k][3] = a.w; cw[k][4] = bb.x; cw[k][5] = bb.y; cw[k][6] = bb.z; cw[k][7] = bb.w; }
        { const f32x4 a = *(const GAS f32x4*)(conv_b + (size_t)layer * MAINW + col), bb = *(const GAS f32x4*)(conv_b + (size_t)layer * MAINW + col + 4);
            cb[0] = a.x; cb[1] = a.y; cb[2] = a.z; cb[3] = a.w; cb[4] = bb.x; cb[5] = bb.y; cb[6] = bb.z; cb[7] = bb.w; }
        float xr[11][8];
#pragma unroll
        for (int i = 0; i < 11; ++i) { const int t = t0 + rg * 8 - 3 + i;
            v4u raw = (v4u){0u, 0u, 0u, 0u};
            if (t >= 0) raw = *(const GAS v4u*)(proj + (mrow + t) * INC + col);
            xr[i][0] = bflo(raw.x); xr[i][1] = bfhi(raw.x); xr[i][2] = bflo(raw.y); xr[i][3] = bfhi(raw.y); xr[i][4] = bflo(raw.z); xr[i][5] = bfhi(raw.z); xr[i][6] = bflo(raw.w); xr[i][7] = bfhi(raw.w); }
#pragma unroll
        for (int tt = 0; tt < 8; ++tt) { float u[8];
#pragma unroll
            for (int e = 0; e < 8; ++e) u[e] = cb[e] + cw[0][e] * xr[tt][e] + cw[1][e] * xr[tt + 1][e] + cw[2][e] * xr[tt + 2][e] + cw[3][e] * xr[tt + 3][e];
            v4u o; o.x = pk2(u[0], u[1]); o.y = pk2(u[2], u[3]); o.z = pk2(u[4], u[5]); o.w = pk2(u[6], u[7]);
            const int tl = rg * 8 + tt;
            *(LAS v4u*)(ut + (16 * ((tl >> 2) & 7) + 4 * (tl >> 5) + (tl & 3)) * UT_PITCH + 8 * cg) = o; }
    }
    __syncthreads();
    const bf16* wg = (const bf16*)(F.ws + WS_WG) + (size_t)(layer * LRU_NB + n) * 512 * 256;
#pragma unroll 1
    for (int nf = 0; nf < 2; ++nf) {
        const int chl = 32 * wave + 16 * nf + c;
        const int chn = 256 * n + chl;
        const bf16* const gbase = proj + (mrow + t0) * INC + MAINW + 256 * n;
        bf16* const obase = (bf16*)(F.ws + WS_MIX) + (mrow + t0) * MIXW + 256 * n;
        const unsigned goff = (unsigned)((32 * g) * INC + chl), ooff = (unsigned)((32 * g) * MIXW + chl);
        unsigned short gtv[8][4];
        if (FINAL) {
#pragma unroll
            for (int mf = 0; mf < 8; ++mf)
#pragma unroll
                for (int r = 0; r < 4; ++r) gtv[mf][r] = ((const GAS bf16*)gbase)[(unsigned)((4 * mf + r) * INC) + goff];
        }
        f32x4 acc[8][2];
#pragma unroll
        for (int mf = 0; mf < 8; ++mf) { acc[mf][0] = (f32x4){0.f, 0.f, 0.f, 0.f}; acc[mf][1] = (f32x4){0.f, 0.f, 0.f, 0.f}; }
        bf16x8 bfr[8][2];
#pragma unroll
        for (int kk = 0; kk < 8; ++kk)
#pragma unroll
            for (int ga = 0; ga < 2; ++ga) bfr[kk][ga] = *(const GAS bf16x8*)(wg + (size_t)(ga * 256 + chl) * 256 + 32 * kk + 8 * g);
        bf16x8 afA[4], afB[4];
#pragma unroll
        for (int i = 0; i < 4; ++i) afA[i] = *(const LAS bf16x8*)(ut + (16 * i + c) * UT_PITCH + 8 * g);
#pragma unroll
        for (int kk = 0; kk < 8; ++kk) {
#pragma unroll
            for (int i = 0; i < 4; ++i) afB[i] = *(const LAS bf16x8*)(ut + (16 * (4 + i) + c) * UT_PITCH + 32 * kk + 8 * g);
#pragma unroll
            for (int i = 0; i < 4; ++i) { acc[i][0] = MFMA16(afA[i], bfr[kk][0], acc[i][0]); acc[i][1] = MFMA16(afA[i], bfr[kk][1], acc[i][1]); }
            asm volatile("" ::: "memory");
            if (kk < 7) {
#pragma unroll
                for (int i = 0; i < 4; ++i) afA[i] = *(const LAS bf16x8*)(ut + (16 * i + c) * UT_PITCH + 32 * (kk + 1) + 8 * g); }
#pragma unroll
            for (int i = 0; i < 4; ++i) { acc[4 + i][0] = MFMA16(afB[i], bfr[kk][0], acc[4 + i][0]); acc[4 + i][1] = MFMA16(afB[i], bfr[kk][1], acc[4 + i][1]); }
            asm volatile("" ::: "memory");
        }
        {
            const float L2E = 1.44269504089f;
            const float ban = -L2E * inp(F, I_GATE_A_B)[(size_t)layer * MAINW + chn], bxn = -L2E * inp(F, I_GATE_X_B)[(size_t)layer * MAINW + chn];
            const float c8 = -8.0f * L2E * softplus_f(-inp(F, I_LAM)[(size_t)layer * MAINW + chn]);
#pragma unroll
            for (int mf = 0; mf < 8; ++mf)
#pragma unroll
                for (int r = 0; r < 4; r += 2) {
                    f32x2 xa, xi; xa.x = acc[mf][0][r]; xa.y = acc[mf][0][r + 1]; xi.x = acc[mf][1][r]; xi.y = acc[mf][1][r + 1];
                    const f32x2 ta = __builtin_elementwise_fma(xa, (f32x2){-L2E, -L2E}, (f32x2){ban, ban}), ti = __builtin_elementwise_fma(xi, (f32x2){-L2E, -L2E}, (f32x2){bxn, bxn});
                    f32x2 da, di; da.x = __builtin_amdgcn_exp2f(ta.x); da.y = __builtin_amdgcn_exp2f(ta.y); di.x = __builtin_amdgcn_exp2f(ti.x); di.y = __builtin_amdgcn_exp2f(ti.y);
                    da = da + (f32x2){1.0f, 1.0f}; di = di + (f32x2){1.0f, 1.0f};
                    f32x2 rr, ii; rr.x = __builtin_amdgcn_rcpf(da.x); rr.y = __builtin_amdgcn_rcpf(da.y); ii.x = __builtin_amdgcn_rcpf(di.x); ii.y = __builtin_amdgcn_rcpf(di.y);
                    const f32x2 ca = rr * (f32x2){c8, c8};
                    f32x2 a; a.x = __builtin_amdgcn_exp2f(ca.x); a.y = __builtin_amdgcn_exp2f(ca.y);
                    f32x2 uv; uv.x = bf2f(ut[(16 * mf + 4 * g + r) * UT_PITCH + chl]); uv.y = bf2f(ut[(16 * mf + 4 * g + r + 1) * UT_PITCH + chl]);
                    const f32x2 om = __builtin_elementwise_fma(-a, a, (f32x2){1.0f, 1.0f});
                    f32x2 sq; sq.x = __builtin_amdgcn_sqrtf(fmaxf(om.x, 0.f)); sq.y = __builtin_amdgcn_sqrtf(fmaxf(om.y, 0.f));
                    const f32x2 bb = sq * (ii * uv);
                    acc[mf][0][r] = a.x; acc[mf][0][r + 1] = a.y; acc[mf][1][r] = bb.x; acc[mf][1][r + 1] = bb.y;
                }
        }
        float A = 1.f, B = 0.f;
#pragma unroll
        for (int mf = 0; mf < 8; ++mf)
#pragma unroll
            for (int r = 0; r < 4; ++r) { const float a = acc[mf][0][r]; A *= a; B = a * B + acc[mf][1][r]; }
        float Ae, Be, PT, HT;
        { const float A16 = LRX16(A, g), B16 = LRX16(B, g);
          const bool odd = (g & 1) != 0, hi2 = (g & 2) != 0;
          const float PA = A * A16, PB = odd ? (A * B16 + B) : (A16 * B + B16);
          const float Aw = odd ? A16 : 1.f, Bw = odd ? B16 : 0.f;
          const float PA32 = LRX32(PA, g), PB32 = LRX32(PB, g);
          Ae = hi2 ? PA32 * Aw : Aw; Be = hi2 ? (Aw * PB32 + Bw) : Bw;
          PT = PA * PA32; HT = hi2 ? (PA * PB32 + PB) : (PA32 * PB + PB32); }
        typedef GAS unsigned long long gu64;
        gu64* const gr = (gu64*)(F.ws + WS_GRAN) + (size_t)((b * LRU_NB + n) * LRU_NC) * 512;
        const unsigned long long tagw = (unsigned long long)(layer + 1) << 32;
        if (g == 0 && popt == 0) { __hip_atomic_store(gr + (size_t)ch * 512 + chl * 2, tagw | __builtin_bit_cast(unsigned, PT), __ATOMIC_RELAXED, __HIP_MEMORY_SCOPE_AGENT);
                      __hip_atomic_store(gr + (size_t)ch * 512 + chl * 2 + 1, tagw | __builtin_bit_cast(unsigned, HT), __ATOMIC_RELAXED, __HIP_MEMORY_SCOPE_AGENT); }
        float hc = 0.f;
        if (ch > 0 && popt != 6) {
            const int q = (ch + 3) >> 2, lo = g * q, hi = (lo + q) < ch ? (lo + q) : ch;
            float Pg = 1.f, Hg = 0.f;
#pragma unroll 1
            for (int bs = 0; bs < q; bs += 8) {
                unsigned long long gp[8], gh[8]; unsigned spins = 0;
                for (;;) { bool ok = true;
#pragma unroll
                    for (int i = 0; i < 8; ++i) { const int cc = lo + bs + i; if (cc < hi) {
                        gp[i] = __hip_atomic_load(gr + (size_t)cc * 512 + chl * 2, __ATOMIC_RELAXED, __HIP_MEMORY_SCOPE_AGENT);
                        gh[i] = __hip_atomic_load(gr + (size_t)cc * 512 + chl * 2 + 1, __ATOMIC_RELAXED, __HIP_MEMORY_SCOPE_AGENT);
                        ok = ok && ((gp[i] >> 32) == (unsigned long long)(layer + 1)) && ((gh[i] >> 32) == (unsigned long long)(layer + 1)); } }
                    if (__all(ok)) break;
                    __builtin_amdgcn_s_sleep(2);
                    if (++spins > (1u << 17)) { if (lane == 0) __hip_atomic_store((GAS unsigned*)(F.ws + WS_CTL) + CW_TMO, 1u, __ATOMIC_RELAXED, __HIP_MEMORY_SCOPE_AGENT); break; }
                }
#pragma unroll
                for (int i = 0; i < 8; ++i) { const int cc = lo + bs + i; if (cc < hi) { const float P = __builtin_bit_cast(float, (unsigned)gp[i]), H = __builtin_bit_cast(float, (unsigned)gh[i]); Hg = P * Hg + H; Pg = P * Pg; } }
            }
            const float A16 = LRX16(Pg, g), B16 = LRX16(Hg, g);
            const bool odd = (g & 1) != 0;
            const float PA = Pg * A16, PB = odd ? (Pg * B16 + Hg) : (A16 * Hg + B16);
            const float PA32 = LRX32(PA, g), PB32 = LRX32(PB, g);
            hc = (g & 2) ? (PA * PB32 + PB) : (PA32 * PB + PB32);
        }
        float h = Ae * hc + Be;
#pragma unroll
        for (int mf = 0; mf < 8; ++mf)
#pragma unroll
            for (int r = 0; r < 4; r += 2) {
                f32x2 gt; gt.x = bf2f(gtv[mf][r]); gt.y = bf2f(gtv[mf][r + 1]);
                const f32x2 tg = gt * (f32x2){-1.44269504089f, -1.44269504089f};
                f32x2 dg; dg.x = __builtin_amdgcn_exp2f(tg.x); dg.y = __builtin_amdgcn_exp2f(tg.y); dg = dg + (f32x2){1.0f, 1.0f};
                f32x2 rg; rg.x = __builtin_amdgcn_rcpf(dg.x); rg.y = __builtin_amdgcn_rcpf(dg.y);
                f32x2 hv; h = acc[mf][0][r] * h + acc[mf][1][r]; hv.x = h; h = acc[mf][0][r + 1] * h + acc[mf][1][r + 1]; hv.y = h;
                const f32x2 ov = hv * (gt * rg);
                if (popt == 0) { ((GAS bf16*)obase)[(unsigned)((4 * mf + r) * MIXW) + ooff] = (bf16)f2bf(ov.x); ((GAS bf16*)obase)[(unsigned)((4 * mf + r + 1) * MIXW) + ooff] = (bf16)f2bf(ov.y); }
                else asm volatile("" :: "v"(ov.x), "v"(ov.y)); }
    }
    __syncthreads();
}

#ifndef PROBE_MEMREP
#define PROBE_MEMREP 1
#endif
#ifndef PROBE_SBDUMMY
#define PROBE_SBDUMMY 0
#endif
#ifndef PROBE_OPT
#define PROBE_OPT 0
#endif
#ifndef PROBE_MASK
#define PROBE_MASK 0
#endif
#ifndef PROBE_TAIL
#define PROBE_TAIL 0
#define PROBE_TAIL_T 50.0f
#endif
#ifndef PROBE_CLK
#define PROBE_CLK 0
#define PROBE_LAYER 3
#endif
#ifndef MK_ONE_LAUNCH
#define MK_ONE_LAUNCH 1
#endif
constexpr int NPHASES = 2 + 6 * DEPTH;
struct Args { const float* in[17]; float* out; unsigned char* ws; int ph_lo, ph_hi, opt, pad; };
__global__ void __launch_bounds__(NWAVES * 64, 2) yoco_fwd(Args args) {
    extern __shared__ __attribute__((aligned(16))) unsigned char lds[];
    Frame F;
    F.lds = (LAS unsigned char*)lds;
    volatile LAS unsigned* MISC = (volatile LAS unsigned*)(F.lds + MISC_OFF);
    F.tid = threadIdx.x; F.lane = F.tid & 63; F.wave = __builtin_amdgcn_readfirstlane(F.tid >> 6);
    F.G = gridDim.x; { const int bx = blockIdx.x; F.vcu = (F.G % 8 == 0) ? (bx % 8) * (F.G / 8) + bx / 8 : bx; }
    F.out = args.out; F.ws = args.ws;
    unsigned* ctl = (unsigned*)(F.ws + WS_CTL);
    for (int u = F.tid; u < (LDS_BYTES - LDSCTL_OFF) / 4; u += NWAVES * 64) ((LAS unsigned*)(F.lds + LDSCTL_OFF))[u] = 0u;
    __syncthreads();
    if (F.tid < I_NIN) ((LAS unsigned long long*)(F.lds + PTR_OFF))[F.tid] = (unsigned long long)args.in[F.tid];
    __syncthreads();
    const int lo = args.ph_lo, hi = args.ph_hi;
    XcdBarrier bar; bar.bar = ctl + CW_BAR; bar.x = 0; bar.st = nullptr;
    if (hi - lo > 1) bar = xcd_barrier_post(ctl + CW_BAR, MISC + 8);
    long long pc0 = 0, pc1 = 0, pw0 = 0, pw1 = 0; (void)pc0; (void)pc1; (void)pw0; (void)pw1;
#define IN(k) (lo <= (k) && (k) < hi)
#define SEAM(k) do { if (IN(k) && IN((k) + 1)) xcd_barrier(bar); } while (0)

#define PHASE_PTRS() Frame P = F; P.ws = args.ws; LAUNDER_S(P.ws); P.out = args.out; LAUNDER_S(P.out); \
    { int t_ = threadIdx.x; asm volatile("" : "+v"(t_)); P.tid = t_; P.lane = t_ & 63; P.wave = __builtin_amdgcn_readfirstlane(t_ >> 6); } \
    const int gw = P.vcu * NWAVES + P.wave, NGW = P.G * NWAVES; (void)gw; (void)NGW; \
    bf16* const HB = (bf16*)(P.ws + WS_HB); bf16* const PROJ = (bf16*)(P.ws + WS_PROJ); bf16* const KB = (bf16*)(P.ws + WS_KB); bf16* const VT = (bf16*)(P.ws + WS_VT); \
    bf16* const MIX = (bf16*)(P.ws + WS_MIX); bf16* const OB = (bf16*)(P.ws + WS_OB); bf16* const MEMB = (bf16*)(P.ws + WS_MEMB); bf16* const MEMK = (bf16*)(P.ws + WS_MEMK); bf16* const MEMVT = (bf16*)(P.ws + WS_MEMVT); \
    (void)HB; (void)PROJ; (void)KB; (void)VT; (void)MIX; (void)OB; (void)MEMB; (void)MEMK; (void)MEMVT;

    if (IN(0)) { PHASE_PTRS();
#ifndef DIS_P0
        for (int it = gw; it < PW_MEM; it += NGW) p0_do(P, it);
#endif
 }
    SEAM(0);
    if (IN(1)) { PHASE_PTRS();
#ifndef DIS_GMEM
        { pg8::Gemm g{MEMB, (const bf16*)(P.ws + WS_WMK), BATCH * MEM_T, DEPTH * MEMW, DM}; pg8::StaticOrder S; S.init(BATCH * MEM_T, DEPTH * MEMW, F.G, (int)blockIdx.x);
          pg8::EpiBf16 E{MEMK, DEPTH * MEMW, nullptr, nullptr, 0.0625f * 1.44269504089f};
          pg8::gemm_phase<pg8::EpiBf16, pg8::StaticOrder, true, true>(F.lds + RING_OFF, g, S, E); }
        { pg8::Gemm g{(const bf16*)(P.ws + WS_WMV), MEMB, DEPTH * MEMW, BATCH * MEM_T, DM}; pg8::StaticOrder S; S.init(DEPTH * MEMW, BATCH * MEM_T, F.G, (int)((blockIdx.x + F.G / 2) % F.G));
          pg8::EpiBf16 E{MEMVT, BATCH * MEM_T, nullptr, nullptr, 1.0f};
          pg8::gemm_phase<pg8::EpiBf16, pg8::StaticOrder, true, true>(F.lds + RING_OFF, g, S, E); }
#endif
        {
            const int bx = (int)blockIdx.x; const bool isg = bx < 32 || (bx >= P.G / 2 && bx < P.G / 2 + 32);
            if (!isg && P.G == 256) { const int rank = (bx < 128 ? bx - 32 : bx - 64) * NWAVES + P.wave;
                for (int it = PW_MEM + rank; it < PW_SPLIT; it += 192 * NWAVES) p0_do(P, it); }
            for (int it = (P.G == 256 ? PW_SPLIT : PW_MEM) + gw; it < PW_END; it += NGW) p0_do(P, it);
        }
    }
    SEAM(1);
    { constexpr int l = 0;
        const int pb = 2 + 6 * l;
        if (IN(pb)) { PHASE_PTRS();
#if PROBE_CLK
            if (l == PROBE_LAYER) { pc0 = clock64(); pw0 = wall_clock64(); }
#endif
            { pg8::Gemm g{HB, win_ptr(P.ws, l), M, INC, DM}; pg8::StaticOrder S; S.init(M, INC, F.G, (int)blockIdx.x);
              pg8::EpiBf16 E{PROJ, INC, nullptr, nullptr, 1.0f};
              pg8::gemm_phase<pg8::EpiBf16, pg8::StaticOrder, true, true>(F.lds + RING_OFF, g, S, E); }
#ifndef DIS_GVT
            if (l == N_A) {
              { pg8::Gemm g{HB, (const bf16*)(P.ws + WS_WKV), M, MAINW, DM}; pg8::StaticOrder S; S.init(M, MAINW, F.G, (int)blockIdx.x);
                pg8::EpiKVTile<0, M> E{KB, nullptr, 0.08838834764831845f * 1.44269504089f};
                pg8::gemm_phase<pg8::EpiKVTile<0, M>, pg8::StaticOrder, true, true>(F.lds + RING_OFF, g, S, E); }
              { pg8::Gemm g{(const bf16*)(P.ws + WS_WKV) + (size_t)MAINW * DM, HB, MAINW, M, DM}; pg8::StaticOrder S; S.init(MAINW, M, F.G, (int)blockIdx.x);
                pg8::EpiKVTile<1, M> E{VT, nullptr, 1.0f};
                pg8::gemm_phase<pg8::EpiKVTile<1, M>, pg8::StaticOrder, true, true>(F.lds + RING_OFF, g, S, E); }
            }
#endif
#if PROBE_CLK
            if (l == PROBE_LAYER) { pc1 = clock64(); pw1 = wall_clock64(); }
#endif
#if PROBE_TAIL
            if (l == PROBE_LAYER && threadIdx.x == 0) { const unsigned long long t_ = wall_clock64(); atomicMax((unsigned long long*)(P.ws + WS_CTL) + 20, t_); atomicAdd((unsigned long long*)(P.ws + WS_CTL) + 21, t_); }
#endif
        }
        SEAM(pb);
        if (IN(pb + 1)) { PHASE_PTRS();
#ifndef DIS_LRU
            if (l < N_A) {
                const int xg = (int)blockIdx.x & 7, jg = (int)blockIdx.x >> 3;
                for (int k = jg; k < 3 * LRU_NC; k += (P.G >> 3)) { const int chain = 3 * xg + k % 3; lru_unit_chain(P, l, chain / LRU_NB, chain % LRU_NB, k / 3, args.opt); }
            }
#endif
#ifndef DIS_SB
            if (l >= N_A) { for (int u = P.vcu; u < (args.opt == 1 ? BATCH * SB_H * (SEQ / 256) / 2 : args.opt == 3 ? 0 : BATCH * SB_H * (SEQ / 256)); u += P.G) {
#if PROBE_SBDUMMY
                sb_attn_wg<true>(P, u / (SB_H * (SEQ / 256)), (u / (SEQ / 256)) % SB_H, u % (SEQ / 256));
#endif
                sb_attn_wg<false>(P, u / (SB_H * (SEQ / 256)), (u / (SEQ / 256)) % SB_H, u % (SEQ / 256), args.opt); } }
#endif
#ifndef DIS_MEM
            if (args.opt == 0 || args.opt == 3) for (int rep_ = 0; rep_ < PROBE_MEMREP; ++rep_)
            for (int u = P.vcu; u < BATCH * MEM_H * (SEQ / 256); u += P.G) mem_attn_wg(P, l, u / (MEM_H * (SEQ / 256)), (u / (SEQ / 256)) % MEM_H, u % (SEQ / 256));
#endif
        }
        SEAM(pb + 1);
        if (IN(pb + 4)) { PHASE_PTRS();
#ifndef DIS_G2
            pg8::Gemm g{MIX, (const bf16*)(P.ws + WS_WOUT) + (size_t)l * DM * MIXW, M, DM, MIXW}; pg8::StaticOrder S; S.init(M, DM, F.G, (int)blockIdx.x);
            pg8::EpiBf16SS E{OB, DM, (float*)(P.ws + WS_PART)};
            pg8::gemm_phase<pg8::EpiBf16SS, pg8::StaticOrder, true, true>(F.lds + RING_OFF, g, S, E);
#endif
        }
        SEAM(pb + 4);
#ifndef DIS_NR
        if (IN(pb + 5)) { PHASE_PTRS(); nr_phase<l>(P); }
#endif
        SEAM(pb + 5);
    }
    { constexpr int l = 1;
        const int pb = 2 + 6 * l;
        if (IN(pb)) { PHASE_PTRS();
#if PROBE_CLK
            if (l == PROBE_LAYER) { pc0 = clock64(); pw0 = wall_clock64(); }
#endif
            { pg8::Gemm g{HB, win_ptr(P.ws, l), M, INC, DM}; pg8::StaticOrder S; S.init(M, INC, F.G, (int)blockIdx.x);
              pg8::EpiBf16 E{PROJ, INC, nullptr, nullptr, 1.0f};
              pg8::gemm_phase<pg8::EpiBf16, pg8::StaticOrder, true, true>(F.lds + RING_OFF, g, S, E); }
#ifndef DIS_GVT
            if (l == N_A) {
              { pg8::Gemm g{HB, (const bf16*)(P.ws + WS_WKV), M, MAINW, DM}; pg8::StaticOrder S; S.init(M, MAINW, F.G, (int)blockIdx.x);
                pg8::EpiKVTile<0, M> E{KB, nullptr, 0.08838834764831845f * 1.44269504089f};
                pg8::gemm_phase<pg8::EpiKVTile<0, M>, pg8::StaticOrder, true, true>(F.lds + RING_OFF, g, S, E); }
              { pg8::Gemm g{(const bf16*)(P.ws + WS_WKV) + (size_t)MAINW * DM, HB, MAINW, M, DM}; pg8::StaticOrder S; S.init(MAINW, M, F.G, (int)blockIdx.x);
                pg8::EpiKVTile<1, M> E{VT, nullptr, 1.0f};
                pg8::gemm_phase<pg8::EpiKVTile<1, M>, pg8::StaticOrder, true, true>(F.lds + RING_OFF, g, S, E); }
            }
#endif
#if PROBE_CLK
            if (l == PROBE_LAYER) { pc1 = clock64(); pw1 = wall_clock64(); }
#endif
#if PROBE_TAIL
            if (l == PROBE_LAYER && threadIdx.x == 0) { const unsigned long long t_ = wall_clock64(); atomicMax((unsigned long long*)(P.ws + WS_CTL) + 20, t_); atomicAdd((unsigned long long*)(P.ws + WS_CTL) + 21, t_); }
#endif
        }
        SEAM(pb);
        if (IN(pb + 1)) { PHASE_PTRS();
#ifndef DIS_LRU
            if (l < N_A) {
                const int xg = (int)blockIdx.x & 7, jg = (int)blockIdx.x >> 3;
                for (int k = jg; k < 3 * LRU_NC; k += (P.G >> 3)) { const int chain = 3 * xg + k % 3; lru_unit_chain(P, l, chain / LRU_NB, chain % LRU_NB, k / 3, args.opt); }
            }
#endif
#ifndef DIS_SB
            if (l >= N_A) { for (int u = P.vcu; u < (args.opt == 1 ? BATCH * SB_H * (SEQ / 256) / 2 : args.opt == 3 ? 0 : BATCH * SB_H * (SEQ / 256)); u += P.G) {
#if PROBE_SBDUMMY
                sb_attn_wg<true>(P, u / (SB_H * (SEQ / 256)), (u / (SEQ / 256)) % SB_H, u % (SEQ / 256));
#endif
                sb_attn_wg<false>(P, u / (SB_H * (SEQ / 256)), (u / (SEQ / 256)) % SB_H, u % (SEQ / 256), args.opt); } }
#endif
#ifndef DIS_MEM
            if (args.opt == 0 || args.opt == 3) for (int rep_ = 0; rep_ < PROBE_MEMREP; ++rep_)
            for (int u = P.vcu; u < BATCH * MEM_H * (SEQ / 256); u += P.G) mem_attn_wg(P, l, u / (MEM_H * (SEQ / 256)), (u / (SEQ / 256)) % MEM_H, u % (SEQ / 256));
#endif
        }
        SEAM(pb + 1);
        if (IN(pb + 4)) { PHASE_PTRS();
#ifndef DIS_G2
            pg8::Gemm g{MIX, (const bf16*)(P.ws + WS_WOUT) + (size_t)l * DM * MIXW, M, DM, MIXW}; pg8::StaticOrder S; S.init(M, DM, F.G, (int)blockIdx.x);
            pg8::EpiBf16SS E{OB, DM, (float*)(P.ws + WS_PART)};
            pg8::gemm_phase<pg8::EpiBf16SS, pg8::StaticOrder, true, true>(F.lds + RING_OFF, g, S, E);
#endif
        }
        SEAM(pb + 4);
#ifndef DIS_NR
        if (IN(pb + 5)) { PHASE_PTRS(); nr_phase<l>(P); }
#endif
        SEAM(pb + 5);
    }
    { constexpr int l = 2;
        const int pb = 2 + 6 * l;
        if (IN(pb)) { PHASE_PTRS();
#if PROBE_CLK
            if (l == PROBE_LAYER) { pc0 = clock64(); pw0 = wall_clock64(); }
#endif
            { pg8::Gemm g{HB, win_ptr(P.ws, l), M, INC, DM}; pg8::StaticOrder S; S.init(M, INC, F.G, (int)blockIdx.x);
              pg8::EpiBf16 E{PROJ, INC, nullptr, nullptr, 1.0f};
              pg8::gemm_phase<pg8::EpiBf16, pg8::StaticOrder, true, true>(F.lds + RING_OFF, g, S, E); }
#ifndef DIS_GVT
            if (l == N_A) {
              { pg8::Gemm g{HB, (const bf16*)(P.ws + WS_WKV), M, MAINW, DM}; pg8::StaticOrder S; S.init(M, MAINW, F.G, (int)blockIdx.x);
                pg8::EpiKVTile<0, M> E{KB, nullptr, 0.08838834764831845f * 1.44269504089f};
                pg8::gemm_phase<pg8::EpiKVTile<0, M>, pg8::StaticOrder, true, true>(F.lds + RING_OFF, g, S, E); }
              { pg8::Gemm g{(const bf16*)(P.ws + WS_WKV) + (size_t)MAINW * DM, HB, MAINW, M, DM}; pg8::StaticOrder S; S.init(MAINW, M, F.G, (int)blockIdx.x);
                pg8::EpiKVTile<1, M> E{VT, nullptr, 1.0f};
                pg8::gemm_phase<pg8::EpiKVTile<1, M>, pg8::StaticOrder, true, true>(F.lds + RING_OFF, g, S, E); }
            }
#endif
#if PROBE_CLK
            if (l == PROBE_LAYER) { pc1 = clock64(); pw1 = wall_clock64(); }
#endif
#if PROBE_TAIL
            if (l == PROBE_LAYER && threadIdx.x == 0) { const unsigned long long t_ = wall_clock64(); atomicMax((unsigned long long*)(P.ws + WS_CTL) + 20, t_); atomicAdd((unsigned long long*)(P.ws + WS_CTL) + 21, t_); }
#endif
        }
        SEAM(pb);
        if (IN(pb + 1)) { PHASE_PTRS();
#ifndef DIS_LRU
            if (l < N_A) {
                const int xg = (int)blockIdx.x & 7, jg = (int)blockIdx.x >> 3;
                for (int k = jg; k < 3 * LRU_NC; k += (P.G >> 3)) { const int chain = 3 * xg + k % 3; lru_unit_chain(P, l, chain / LRU_NB, chain % LRU_NB, k / 3, args.opt); }
            }
#endif
#ifndef DIS_SB
            if (l >= N_A) { for (int u = P.vcu; u < (args.opt == 1 ? BATCH * SB_H * (SEQ / 256) / 2 : args.opt == 3 ? 0 : BATCH * SB_H * (SEQ / 256)); u += P.G) {
#if PROBE_SBDUMMY
                sb_attn_wg<true>(P, u / (SB_H * (SEQ / 256)), (u / (SEQ / 256)) % SB_H, u % (SEQ / 256));
#endif
                sb_attn_wg<false>(P, u / (SB_H * (SEQ / 256)), (u / (SEQ / 256)) % SB_H, u % (SEQ / 256), args.opt); } }
#endif
#ifndef DIS_MEM
            if (args.opt == 0 || args.opt == 3) for (int rep_ = 0; rep_ < PROBE_MEMREP; ++rep_)
            for (int u = P.vcu; u < BATCH * MEM_H * (SEQ / 256); u += P.G) mem_attn_wg(P, l, u / (MEM_H * (SEQ / 256)), (u / (SEQ / 256)) % MEM_H, u % (SEQ / 256));
#endif
        }
        SEAM(pb + 1);
        if (IN(pb + 4)) { PHASE_PTRS();
#ifndef DIS_G2
            pg8::Gemm g{MIX, (const bf16*)(P.ws + WS_WOUT) + (size_t)l * DM * MIXW, M, DM, MIXW}; pg8::StaticOrder S; S.init(M, DM, F.G, (int)blockIdx.x);
            pg8::EpiBf16SS E{OB, DM, (float*)(P.ws + WS_PART)};
            pg8::gemm_phase<pg8::EpiBf16SS, pg8::StaticOrder, true, true>(F.lds + RING_OFF, g, S, E);
#endif
        }
        SEAM(pb + 4);
#ifndef DIS_NR
        if (IN(pb + 5)) { PHASE_PTRS(); nr_phase<l>(P); }
#endif
        SEAM(pb + 5);
    }
    { constexpr int l = 3;
        const int pb = 2 + 6 * l;
        if (IN(pb)) { PHASE_PTRS();
#if PROBE_CLK
            if (l == PROBE_LAYER) { pc0 = clock64(); pw0 = wall_clock64(); }
#endif
            { pg8::Gemm g{HB, win_ptr(P.ws, l), M, INC, DM}; pg8::StaticOrder S; S.init(M, INC, F.G, (int)blockIdx.x);
              pg8::EpiBf16 E{PROJ, INC, nullptr, nullptr, 1.0f};
              pg8::gemm_phase<pg8::EpiBf16, pg8::StaticOrder, true, true>(F.lds + RING_OFF, g, S, E); }
#ifndef DIS_GVT
            if (l == N_A) {
              { pg8::Gemm g{HB, (const bf16*)(P.ws + WS_WKV), M, MAINW, DM}; pg8::StaticOrder S; S.init(M, MAINW, F.G, (int)blockIdx.x);
                pg8::EpiKVTile<0, M> E{KB, nullptr, 0.08838834764831845f * 1.44269504089f};
                pg8::gemm_phase<pg8::EpiKVTile<0, M>, pg8::StaticOrder, true, true>(F.lds + RING_OFF, g, S, E); }
              { pg8::Gemm g{(const bf16*)(P.ws + WS_WKV) + (size_t)MAINW * DM, HB, MAINW, M, DM}; pg8::StaticOrder S; S.init(MAINW, M, F.G, (int)blockIdx.x);
                pg8::EpiKVTile<1, M> E{VT, nullptr, 1.0f};
                pg8::gemm_phase<pg8::EpiKVTile<1, M>, pg8::StaticOrder, true, true>(F.lds + RING_OFF, g, S, E); }
            }
#endif
#if PROBE_CLK
            if (l == PROBE_LAYER) { pc1 = clock64(); pw1 = wall_clock64(); }
#endif
#if PROBE_TAIL
            if (l == PROBE_LAYER && threadIdx.x == 0) { const unsigned long long t_ = wall_clock64(); atomicMax((unsigned long long*)(P.ws + WS_CTL) + 20, t_); atomicAdd((unsigned long long*)(P.ws + WS_CTL) + 21, t_); }
#endif
        }
        SEAM(pb);
        if (IN(pb + 1)) { PHASE_PTRS();
#ifndef DIS_LRU
            if (l < N_A) {
                const int xg = (int)blockIdx.x & 7, jg = (int)blockIdx.x >> 3;
                for (int k = jg; k < 3 * LRU_NC; k += (P.G >> 3)) { const int chain = 3 * xg + k % 3; lru_unit_chain(P, l, chain / LRU_NB, chain % LRU_NB, k / 3, args.opt); }
            }
#endif
#ifndef DIS_SB
            if (l >= N_A) { for (int u = P.vcu; u < (args.opt == 1 ? BATCH * SB_H * (SEQ / 256) / 2 : args.opt == 3 ? 0 : BATCH * SB_H * (SEQ / 256)); u += P.G) {
#if PROBE_SBDUMMY
                sb_attn_wg<true>(P, u / (SB_H * (SEQ / 256)), (u / (SEQ / 256)) % SB_H, u % (SEQ / 256));
#endif
                sb_attn_wg<false>(P, u / (SB_H * (SEQ / 256)), (u / (SEQ / 256)) % SB_H, u % (SEQ / 256), args.opt); } }
#endif
#ifndef DIS_MEM
            if (args.opt == 0 || args.opt == 3) for (int rep_ = 0; rep_ < PROBE_MEMREP; ++rep_)
            for (int u = P.vcu; u < BATCH * MEM_H * (SEQ / 256); u += P.G) mem_attn_wg(P, l, u / (MEM_H * (SEQ / 256)), (u / (SEQ / 256)) % MEM_H, u % (SEQ / 256));
#endif
        }
        SEAM(pb + 1);
        if (IN(pb + 4)) { PHASE_PTRS();
#ifndef DIS_G2
            pg8::Gemm g{MIX, (const bf16*)(P.ws + WS_WOUT) + (size_t)l * DM * MIXW, M, DM, MIXW}; pg8::StaticOrder S; S.init(M, DM, F.G, (int)blockIdx.x);
            pg8::EpiBf16SS E{OB, DM, (float*)(P.ws + WS_PART)};
            pg8::gemm_phase<pg8::EpiBf16SS, pg8::StaticOrder, true, true>(F.lds + RING_OFF, g, S, E);
#endif
        }
        SEAM(pb + 4);
#ifndef DIS_NR
        if (IN(pb + 5)) { PHASE_PTRS(); nr_phase<l>(P); }
#endif
        SEAM(pb + 5);
    }
#if PROBE_TAIL
    xcd_barrier(bar);
    if (blockIdx.x == 0 && threadIdx.x == 0) { const unsigned long long mx = ((unsigned long long*)(args.ws + WS_CTL))[20], sm = ((unsigned long long*)(args.ws + WS_CTL))[21]; const float tail_us = ((float)(long long)(mx - sm / 256ull)) * 0.01f; if (tail_us > PROBE_TAIL_T) args.out[0] += 1000.0f; }
#endif
#if PROBE_CLK
    xcd_barrier(bar);
    if (blockIdx.x == 0 && threadIdx.x == 0) { const float ghz = (float)(pc1 - pc0) / ((float)(pw1 - pw0) * 10.0f); args.out[0] += (PROBE_CLK == 1 ? (ghz > PROBE_T ? 1000.0f : 0.0f) : (float)(pw1 - pw0) * 0.01f); }
#endif
#undef IN
#undef SEAM
}

extern "C" void kernel_launch(void* const* d_in, const int* in_sizes, int n_in, void* d_out, int out_size, void* d_ws, size_t ws_size, hipStream_t stream) {
    static int grid = 0;
    if (grid == 0) {
        if (n_in != 17 || in_sizes[0] != M * DM || out_size != M * DM || ws_size < WS_END) { fprintf(stderr, "kernel_launch: unexpected shapes (n_in %d, in0 %d, out %d, ws %zu); nothing launched\n", n_in, n_in > 0 ? in_sizes[0] : -1, out_size, ws_size); grid = -1; return; }
        int dev = 0, cus = 0, per_cu = 0;
        if (hipGetDevice(&dev) != hipSuccess || hipDeviceGetAttribute(&cus, hipDeviceAttributeMultiprocessorCount, dev) != hipSuccess) { grid = -1; return; }
        if (hipFuncSetAttribute((const void*)yoco_fwd, hipFuncAttributeMaxDynamicSharedMemorySize, LDS_BYTES) != hipSuccess) { fprintf(stderr, "kernel_launch: hipFuncSetAttribute failed\n"); grid = -1; return; }
        if (hipOccupancyMaxActiveBlocksPerMultiprocessor(&per_cu, (const void*)yoco_fwd, NWAVES * 64, LDS_BYTES) != hipSuccess || per_cu < 1)
            fprintf(stderr, "kernel_launch: note: occupancy query reports %d workgroups per CU\n", per_cu);
        (void)hipGetLastError();
        grid = cus;
    }
    if (grid < 0) return;
    if (hipMemsetAsync((char*)d_ws + WS_CTL, 0, CTL_ZERO_BYTES, stream) != hipSuccess) return;
    Args a{};
    for (int i = 0; i < 17; ++i) a.in[i] = (const float*)d_in[i];
    a.out = (float*)d_out; a.ws = (unsigned char*)d_ws;
#if MK_ONE_LAUNCH
    a.ph_lo = 0; a.ph_hi = NPHASES;
    hipLaunchKernelGGL(yoco_fwd, dim3(grid), dim3(NWAVES * 64), LDS_BYTES, stream, a);
#else
    for (int ph = 0; ph < NPHASES; ++ph) {
        if (ph >= 2 && ((ph - 2) % 6 == 2 || (ph - 2) % 6 == 3)) continue;
        a.ph_lo = ph; a.ph_hi = ph + 1;
        for (int rep = 0; rep < (((PROBE_MASK >> ph) & 1) ? 2 : 1); ++rep) {
            a.opt = rep ? PROBE_OPT : 0;
            hipLaunchKernelGGL(yoco_fwd, dim3(grid), dim3(NWAVES * 64), LDS_BYTES, stream, a); }
        a.opt = 0;
    }
#endif
}
```
